# Optimizing an MI355X kernel written in HIP

```python
import jax, jax.numpy as jnp
from jax import lax
import numpy as np

D_MODEL = 1024
BATCH = 8
SEQ = 2048
DEPTH = 1

CHUNK = 64
QUERY_BLOCK = 128
FOX_HEAD_DIM = 64
N_FOX_HEADS = (D_MODEL // 2) // FOX_HEAD_DIM
D_FOX = N_FOX_HEADS * FOX_HEAD_DIM
GDN_HEAD_DIM = 128
N_GDN_HEADS = (D_MODEL // 2) // GDN_HEAD_DIM
D_GDN = N_GDN_HEADS * GDN_HEAD_DIM
D_MIX = D_FOX + D_GDN
CONV_K = 4
D_FF = 4 * D_MODEL
EPS = 1e-6
PROJ_SIZES = (D_FOX, D_FOX, D_FOX, N_FOX_HEADS, D_GDN, D_GDN, D_GDN, N_GDN_HEADS, N_GDN_HEADS, D_GDN)
D_PROJ = sum(PROJ_SIZES)

kernel_name = "fox_gdn_hymba_sandwich_block"


def rms_norm(x, w):
    xf = x.astype(jnp.float32)
    y = xf * lax.rsqrt(jnp.mean(xf * xf, axis=-1, keepdims=True) + EPS)
    return (y * w.astype(jnp.float32)).astype(x.dtype)


def causal_depthwise_conv(x, w):
    k, c = w.shape
    return lax.conv_general_dilated(
        x, w[:, None, :].astype(x.dtype), window_strides=(1,), padding=[(k - 1, 0)],
        dimension_numbers=("NWC", "WIO", "NWC"), feature_group_count=c)


def forgetting_attention(q, k, v, log_f):
    b, s, h, d = q.shape
    scale = d ** -0.5
    cum = jnp.cumsum(log_f, axis=1).transpose(0, 2, 1)
    outs = []
    for i in range(s // QUERY_BLOCK):
        qs, qe = i * QUERY_BLOCK, (i + 1) * QUERY_BLOCK
        qb = q[:, qs:qe]
        kb = k[:, :qe]
        vb = v[:, :qe]
        logits = jnp.einsum("bqhd,bkhd->bhqk", qb, kb).astype(jnp.float32) * scale
        logits = logits + cum[:, :, qs:qe, None] - cum[:, :, None, :qe]
        mask = jnp.arange(qe)[None, :] <= (qs + jnp.arange(QUERY_BLOCK))[:, None]
        logits = jnp.where(mask, logits, -jnp.inf)
        p = jax.nn.softmax(logits, axis=-1)
        outs.append(jnp.einsum("bhqk,bkhd->bqhd", p.astype(v.dtype), vb))
    return jnp.concatenate(outs, axis=1)


def gated_delta_chunked(q, k, v, g, beta):
    b, s, h, dk = q.shape
    dv = v.shape[-1]
    n = s // CHUNK

    def to_chunks(t):
        return t.reshape(b, n, CHUNK, h, t.shape[-1]).transpose(0, 3, 1, 2, 4)

    q, k, v = to_chunks(q), to_chunks(k), to_chunks(v)
    g = g.reshape(b, n, CHUNK, h).transpose(0, 3, 1, 2)
    beta = beta.reshape(b, n, CHUNK, h).transpose(0, 3, 1, 2)
    gc = jnp.cumsum(g, axis=-1)
    incl = jnp.tril(jnp.ones((CHUNK, CHUNK), dtype=bool))
    strict = jnp.tril(jnp.ones((CHUNK, CHUNK), dtype=bool), k=-1)
    decay = jnp.exp(jnp.where(incl, gc[..., :, None] - gc[..., None, :], -jnp.inf))
    k_beta = k * beta[..., None]
    v_beta = v * beta[..., None]
    m = jnp.where(strict, jnp.einsum("bhncd,bhnkd->bhnck", k_beta, k) * decay, 0.0)
    eye = jnp.broadcast_to(jnp.eye(CHUNK, dtype=m.dtype), m.shape)
    t_inv = lax.linalg.triangular_solve(eye + m, eye, left_side=True, lower=True,
                                        unit_diagonal=True)
    u = jnp.einsum("bhnck,bhnkv->bhncv", t_inv, v_beta)
    w = jnp.einsum("bhnck,bhnkd->bhncd", t_inv, k_beta * jnp.exp(gc)[..., None])
    a_intra = jnp.einsum("bhncd,bhnkd->bhnck", q, k) * decay
    q_dec = q * jnp.exp(gc)[..., None]
    k_dec = k * jnp.exp(gc[..., -1:] - gc)[..., None]
    g_last = jnp.exp(gc[..., -1])

    def step(state, inp):
        qd, kd, uc, wc, ac, gl = inp
        v_new = uc - jnp.einsum("bhcd,bhdv->bhcv", wc, state)
        o = jnp.einsum("bhcd,bhdv->bhcv", qd, state) + jnp.einsum("bhck,bhkv->bhcv", ac, v_new)
        state = state * gl[..., None, None] + jnp.einsum("bhcd,bhcv->bhdv", kd, v_new)
        return state, o

    def chunk_major(t):
        return jnp.moveaxis(t, 2, 0)

    state0 = jnp.zeros((b, h, dk, dv), dtype=jnp.float32)
    _, o = lax.scan(step, state0, (chunk_major(q_dec), chunk_major(k_dec), chunk_major(u),
                                   chunk_major(w), chunk_major(a_intra), chunk_major(g_last)))
    return o.transpose(1, 0, 3, 2, 4).reshape(b, s, h, dv)


def setup_inputs(seed: int = 0) -> dict:
    key = jax.random.key(seed)
    ks = jax.random.split(key, 16)
    f32 = jnp.float32

    def gain(k, n):
        return 1.0 + 0.1 * jax.random.normal(k, (n,), f32)

    x = jax.random.normal(ks[0], (BATCH, SEQ, D_MODEL), f32)
    pre_mix_norm = gain(ks[1], D_MODEL)
    w_in = jax.random.normal(ks[2], (D_MODEL, D_PROJ), f32) * D_MODEL ** -0.5
    fox_f_bias = 3.0 + 0.5 * jax.random.normal(ks[3], (N_FOX_HEADS,), f32)
    fox_out_norm = gain(ks[4], FOX_HEAD_DIM)
    gdn_conv_w = jax.random.normal(ks[5], (CONV_K, 3 * D_GDN), f32) * CONV_K ** -0.5
    gdn_a_log = jnp.log(jax.random.uniform(ks[6], (N_GDN_HEADS,), f32, 1.0, 16.0))
    dt = jnp.exp(jax.random.uniform(ks[7], (N_GDN_HEADS,), f32, np.log(1e-3), np.log(1e-1)))
    gdn_dt_bias = dt + jnp.log(-jnp.expm1(-dt))
    gdn_out_norm = gain(ks[8], GDN_HEAD_DIM)
    w_out = jax.random.normal(ks[9], (D_MIX, D_MODEL), f32) * D_MIX ** -0.5
    post_mix_norm = gain(ks[10], D_MODEL)
    pre_mlp_norm = gain(ks[11], D_MODEL)
    w_up = jax.random.normal(ks[12], (D_MODEL, D_FF), f32) * D_MODEL ** -0.5
    w_down = jax.random.normal(ks[13], (D_FF, D_MODEL), f32) * D_FF ** -0.5
    post_mlp_norm = gain(ks[14], D_MODEL)
    return {"x": x, "pre_mix_norm": pre_mix_norm, "w_in": w_in, "fox_f_bias": fox_f_bias,
            "fox_out_norm": fox_out_norm, "gdn_conv_w": gdn_conv_w, "gdn_a_log": gdn_a_log,
            "gdn_dt_bias": gdn_dt_bias, "gdn_out_norm": gdn_out_norm, "w_out": w_out,
            "post_mix_norm": post_mix_norm, "pre_mlp_norm": pre_mlp_norm, "w_up": w_up,
            "w_down": w_down, "post_mlp_norm": post_mlp_norm}


def reference(x, pre_mix_norm, w_in, fox_f_bias, fox_out_norm, gdn_conv_w, gdn_a_log,
              gdn_dt_bias, gdn_out_norm, w_out, post_mix_norm, pre_mlp_norm, w_up, w_down,
              post_mlp_norm):
    b, s, _ = x.shape
    split_at = [int(v) for v in np.cumsum(PROJ_SIZES)[:-1]]
    for _layer in range(DEPTH):
        h = rms_norm(x, pre_mix_norm)
        proj = h @ w_in
        fq, fk, fv, ff, gq, gk, gv, gb, ga, gz = jnp.split(proj, split_at, axis=-1)

        fq = fq.reshape(b, s, N_FOX_HEADS, FOX_HEAD_DIM)
        fk = fk.reshape(b, s, N_FOX_HEADS, FOX_HEAD_DIM)
        fv = fv.reshape(b, s, N_FOX_HEADS, FOX_HEAD_DIM)
        log_f = jax.nn.log_sigmoid(ff.astype(jnp.float32) + fox_f_bias.astype(jnp.float32))
        fox_o = forgetting_attention(fq, fk, fv, log_f)
        fox_o = rms_norm(fox_o, fox_out_norm).reshape(b, s, D_FOX)

        qkv = jax.nn.silu(causal_depthwise_conv(jnp.concatenate([gq, gk, gv], axis=-1), gdn_conv_w))
        qkv = qkv.astype(jnp.float32)
        cq, ck, cv = jnp.split(qkv, [D_GDN, 2 * D_GDN], axis=-1)
        cq = cq.reshape(b, s, N_GDN_HEADS, GDN_HEAD_DIM)
        ck = ck.reshape(b, s, N_GDN_HEADS, GDN_HEAD_DIM)
        cv = cv.reshape(b, s, N_GDN_HEADS, GDN_HEAD_DIM)
        cq = cq * lax.rsqrt(jnp.sum(cq * cq, axis=-1, keepdims=True) + EPS) * GDN_HEAD_DIM ** -0.5
        ck = ck * lax.rsqrt(jnp.sum(ck * ck, axis=-1, keepdims=True) + EPS)
        beta = jax.nn.sigmoid(gb.astype(jnp.float32))
        g = -jnp.exp(gdn_a_log.astype(jnp.float32)) * jax.nn.softplus(
            ga.astype(jnp.float32) + gdn_dt_bias.astype(jnp.float32))
        gdn_o = gated_delta_chunked(cq, ck, cv, g, beta)
        gate = jax.nn.silu(gz.astype(jnp.float32)).reshape(b, s, N_GDN_HEADS, GDN_HEAD_DIM)
        gdn_o = (rms_norm(gdn_o, gdn_out_norm) * gate).astype(x.dtype).reshape(b, s, D_GDN)

        mixed = jnp.concatenate([fox_o, gdn_o], axis=-1) @ w_out
        x = x + rms_norm(mixed, post_mix_norm)

        h = rms_norm(x, pre_mlp_norm)
        y = jnp.square(jax.nn.relu(h @ w_up)) @ w_down
        x = x + rms_norm(y, post_mlp_norm)
    return x
```

```cpp
#include <hip/hip_runtime.h>
#include <cstdint>
#include <cstdio>

constexpr int NB = 8, S = 2048, D = 1024, M = NB * S, DP = 3600, DFF = 4096;
constexpr int HF = 8, DH = 64, HG = 4, DG = 128;
constexpr float EPS = 1e-6f;
constexpr int C_FQ = 0, C_FK = 512, C_FV = 1024, C_FF = 1536, C_GQ = 1544, C_GK = 2056, C_GV = 2568, C_GB = 3080, C_GA = 3084, C_GZ = 3088;

__device__ __forceinline__ float wave_sum(float v) {
#pragma unroll
    for (int o = 1; o < 64; o <<= 1) v += __shfl_xor(v, o);
    return v;
}
__device__ __forceinline__ float wave_max(float v) {
#pragma unroll
    for (int o = 1; o < 64; o <<= 1) v = fmaxf(v, __shfl_xor(v, o));
    return v;
}
__device__ __forceinline__ float softplus_f(float x) { return fmaxf(x, 0.f) + log1pf(expf(-fabsf(x))); }
__device__ __forceinline__ float sigmoid_f(float x) { return 1.f / (1.f + expf(-x)); }

__global__ void k_rmsnorm(const float* __restrict__ x, const float* __restrict__ g, const float* __restrict__ res, float* __restrict__ out, int rows) {
    const int lane = threadIdx.x & 63, row = blockIdx.x * 4 + (threadIdx.x >> 6);
    if (row >= rows) return;
    const float4* xr = (const float4*)(x + (size_t)row * D);
    float4 v[4]; float s = 0.f;
#pragma unroll
    for (int j = 0; j < 4; ++j) { v[j] = xr[lane + 64 * j]; s += v[j].x * v[j].x + v[j].y * v[j].y + v[j].z * v[j].z + v[j].w * v[j].w; }
    const float r = rsqrtf(wave_sum(s) * (1.f / D) + EPS);
#pragma unroll
    for (int j = 0; j < 4; ++j) {
        const float4 gg = ((const float4*)g)[lane + 64 * j];
        float4 o; o.x = v[j].x * r * gg.x; o.y = v[j].y * r * gg.y; o.z = v[j].z * r * gg.z; o.w = v[j].w * r * gg.w;
        if (res) { const float4 rr = ((const float4*)(res + (size_t)row * D))[lane + 64 * j]; o.x += rr.x; o.y += rr.y; o.z += rr.z; o.w += rr.w; }
        ((float4*)(out + (size_t)row * D))[lane + 64 * j] = o;
    }
}

template <int ACT>
__global__ void __launch_bounds__(256) k_gemm(const float* __restrict__ A, int lda, const float* __restrict__ B, int ldb, float* __restrict__ C, int ldc, int N, int K) {
    __shared__ float As[16][68];
    __shared__ float Bs[16][68];
    const int tid = threadIdx.x, tx = tid & 15, ty = tid >> 4;
    const int m0 = blockIdx.y * 64, n0 = blockIdx.x * 64;
    float acc[4][4];
#pragma unroll
    for (int i = 0; i < 4; ++i)
#pragma unroll
        for (int j = 0; j < 4; ++j) acc[i][j] = 0.f;
    for (int k0 = 0; k0 < K; k0 += 16) {
        {
            const int r = tid >> 2, c = (tid & 3) * 4;
            const float4 v = *(const float4*)(A + (size_t)(m0 + r) * lda + k0 + c);
            As[c][r] = v.x; As[c + 1][r] = v.y; As[c + 2][r] = v.z; As[c + 3][r] = v.w;
        }
        {
            const int r = tid >> 4, c = (tid & 15) * 4, n = n0 + c;
            float4 v = make_float4(0.f, 0.f, 0.f, 0.f);
            if (n < N) v = *(const float4*)(B + (size_t)(k0 + r) * ldb + n);
            Bs[r][c] = v.x; Bs[r][c + 1] = v.y; Bs[r][c + 2] = v.z; Bs[r][c + 3] = v.w;
        }
        __syncthreads();
#pragma unroll
        for (int kk = 0; kk < 16; ++kk) {
            const float4 a = *(const float4*)&As[kk][ty * 4];
            const float4 b = *(const float4*)&Bs[kk][tx * 4];
            const float av[4] = {a.x, a.y, a.z, a.w}, bv[4] = {b.x, b.y, b.z, b.w};
#pragma unroll
            for (int i = 0; i < 4; ++i)
#pragma unroll
                for (int j = 0; j < 4; ++j) acc[i][j] += av[i] * bv[j];
        }
        __syncthreads();
    }
    const int n = n0 + tx * 4;
    if (n < N) {
#pragma unroll
        for (int i = 0; i < 4; ++i) {
            float4 o;
            o.x = acc[i][0]; o.y = acc[i][1]; o.z = acc[i][2]; o.w = acc[i][3];
            if (ACT == 1) { o.x = fmaxf(o.x, 0.f); o.x *= o.x; o.y = fmaxf(o.y, 0.f); o.y *= o.y; o.z = fmaxf(o.z, 0.f); o.z *= o.z; o.w = fmaxf(o.w, 0.f); o.w *= o.w; }
            *(float4*)(C + (size_t)(m0 + ty * 4 + i) * ldc + n) = o;
        }
    }
}

__global__ void k_cum(const float* __restrict__ P, const float* __restrict__ fbias, float* __restrict__ cum) {
    __shared__ float part[256];
    const int h = blockIdx.x, tid = threadIdx.x;
    float loc[8]; float s = 0.f;
    const float bz = fbias[h];
#pragma unroll
    for (int i = 0; i < 8; ++i) {
        const float z = P[(size_t)(tid * 8 + i) * DP + C_FF + h] + bz;
        const float lf = fminf(z, 0.f) - log1pf(expf(-fabsf(z)));
        s += lf; loc[i] = s;
    }
    part[tid] = s;
    __syncthreads();
    if (tid == 0) { float run = 0.f; for (int i = 0; i < 256; ++i) { const float t = part[i]; part[i] = run; run += t; } }
    __syncthreads();
    const float off = part[tid];
#pragma unroll
    for (int i = 0; i < 8; ++i) cum[h * S + tid * 8 + i] = loc[i] + off;
}

__global__ void __launch_bounds__(256) k_fox(const float* __restrict__ P, const float* __restrict__ cum, const float* __restrict__ gnorm, float* __restrict__ mixed) {
    __shared__ float lg[4][S];
    __shared__ float qs[4][64];
    const int w = threadIdx.x >> 6, lane = threadIdx.x & 63;
    const int t = blockIdx.x * 4 + w, h = blockIdx.y;
    qs[w][lane] = P[(size_t)t * DP + C_FQ + h * 64 + lane];
    __syncthreads();
    const float ct = cum[h * S + t];
    float mx = -INFINITY;
    for (int s = lane; s <= t; s += 64) {
        const float4* kr = (const float4*)(P + (size_t)s * DP + C_FK + h * 64);
        float dot = 0.f;
#pragma unroll
        for (int j = 0; j < 16; ++j) { const float4 kv = kr[j]; dot += qs[w][4 * j] * kv.x + qs[w][4 * j + 1] * kv.y + qs[w][4 * j + 2] * kv.z + qs[w][4 * j + 3] * kv.w; }
        const float l = dot * 0.125f + ct - cum[h * S + s];
        lg[w][s] = l; mx = fmaxf(mx, l);
    }
    mx = wave_max(mx);
    float sum = 0.f;
    for (int s = lane; s <= t; s += 64) { const float p = expf(lg[w][s] - mx); lg[w][s] = p; sum += p; }
    sum = wave_sum(sum);
    __syncthreads();
    float o = 0.f;
    for (int s = 0; s <= t; ++s) o += lg[w][s] * P[(size_t)s * DP + C_FV + h * 64 + lane];
    o /= sum;
    const float r = rsqrtf(wave_sum(o * o) * (1.f / 64.f) + EPS);
    mixed[(size_t)t * D + h * 64 + lane] = o * r * gnorm[lane];
}

__global__ void k_conv(const float* __restrict__ P, const float* __restrict__ cw, const float* __restrict__ a_log, const float* __restrict__ dt_bias,
                       float* __restrict__ qkv, float* __restrict__ beta, float* __restrict__ gdec, float* __restrict__ mixed) {
    const int t = blockIdx.x;
    for (int c = threadIdx.x; c < 1536; c += blockDim.x) {
        const int col = c < 512 ? C_GQ + c : (c < 1024 ? C_GK + (c - 512) : C_GV + (c - 1024));
        float y = 0.f;
#pragma unroll
        for (int j = 0; j < 4; ++j) { const int tt = t - 3 + j; if (tt >= 0) y += cw[j * 1536 + c] * P[(size_t)tt * DP + col]; }
        qkv[(size_t)t * 1536 + c] = y * sigmoid_f(y);
    }
    for (int c = threadIdx.x; c < 512; c += blockDim.x) { const float z = P[(size_t)t * DP + C_GZ + c]; mixed[(size_t)t * D + 512 + c] = z * sigmoid_f(z); }
    if (threadIdx.x < 4) {
        const int h = threadIdx.x;
        beta[t * 4 + h] = sigmoid_f(P[(size_t)t * DP + C_GB + h]);
        gdec[t * 4 + h] = -expf(a_log[h]) * softplus_f(P[(size_t)t * DP + C_GA + h] + dt_bias[h]);
    }
}
__global__ void k_l2(float* __restrict__ qkv, int rows) {
    const int lane = threadIdx.x & 63, item = blockIdx.x * 4 + (threadIdx.x >> 6);
    if (item >= rows * 8) return;
    const int h = item & 3, which = (item >> 2) & 1, t = item >> 3;
    float* p = qkv + (size_t)t * 1536 + which * 512 + h * 128;
    const float a = p[lane], b = p[lane + 64];
    const float r = rsqrtf(wave_sum(a * a + b * b) + EPS) * (which == 0 ? 0.08838834764831845f : 1.f);
    p[lane] = a * r; p[lane + 64] = b * r;
}
__global__ void __launch_bounds__(128) k_gdn_rec(float* __restrict__ qkv, const float* __restrict__ beta, const float* __restrict__ gdec) {
    __shared__ float ks[2][128];
    __shared__ float qsh[2][128];
    const int b = blockIdx.x >> 2, h = blockIdx.x & 3, v = threadIdx.x;
    float Sd[128];
#pragma unroll
    for (int d = 0; d < 128; ++d) Sd[d] = 0.f;
    float* base = qkv + (size_t)b * S * 1536;
    const float* bb = beta + (size_t)b * S * 4;
    const float* gg = gdec + (size_t)b * S * 4;
    float qn = base[h * 128 + v], kn = base[512 + h * 128 + v], vn = base[1024 + h * 128 + v], an = expf(gg[h]), bn = bb[h];
    for (int t = 0; t < S; ++t) {
        const int bufi = t & 1;
        ks[bufi][v] = kn; qsh[bufi][v] = qn;
        const float vt = vn, at = an, bt = bn;
        if (t + 1 < S) {
            const float* r = base + (size_t)(t + 1) * 1536;
            qn = r[h * 128 + v]; kn = r[512 + h * 128 + v]; vn = r[1024 + h * 128 + v]; an = expf(gg[(t + 1) * 4 + h]); bn = bb[(t + 1) * 4 + h];
        }
        __syncthreads();
        float kS = 0.f;
#pragma unroll
        for (int d = 0; d < 128; ++d) kS += ks[bufi][d] * Sd[d];
        const float coef = bt * (vt - at * kS);
        float o = 0.f;
#pragma unroll
        for (int d = 0; d < 128; ++d) { Sd[d] = at * Sd[d] + ks[bufi][d] * coef; o += qsh[bufi][d] * Sd[d]; }
        base[(size_t)t * 1536 + h * 128 + v] = o;
    }
}
__global__ void k_gdn_post(const float* __restrict__ qkv, const float* __restrict__ gnorm, float* __restrict__ mixed) {
    const int lane = threadIdx.x & 63, item = blockIdx.x * 4 + (threadIdx.x >> 6);
    const int h = item & 3, t = item >> 2;
    const float* p = qkv + (size_t)t * 1536 + h * 128;
    const float a = p[lane], b = p[lane + 64];
    const float r = rsqrtf(wave_sum(a * a + b * b) * (1.f / 128.f) + EPS);
    float* m = mixed + (size_t)t * D + 512 + h * 128;
    m[lane] = a * r * gnorm[lane] * m[lane];
    m[lane + 64] = b * r * gnorm[lane + 64] * m[lane + 64];
}

extern "C" void kernel_launch(void* const* d_in, const int* in_sizes, int n_in, void* d_out, int out_size, void* d_ws, size_t ws_size, hipStream_t stream) {
    const float* x = (const float*)d_in[0];
    const float* pre_mix = (const float*)d_in[1];
    const float* w_in = (const float*)d_in[2];
    const float* fbias = (const float*)d_in[3];
    const float* fox_norm = (const float*)d_in[4];
    const float* conv_w = (const float*)d_in[5];
    const float* a_log = (const float*)d_in[6];
    const float* dt_bias = (const float*)d_in[7];
    const float* gdn_norm = (const float*)d_in[8];
    const float* w_out = (const float*)d_in[9];
    const float* post_mix = (const float*)d_in[10];
    const float* pre_mlp = (const float*)d_in[11];
    const float* w_up = (const float*)d_in[12];
    const float* w_down = (const float*)d_in[13];
    const float* post_mlp = (const float*)d_in[14];
    float* out = (float*)d_out;
    char* ws = (char*)d_ws;
    const size_t MiB = 1u << 20;
    float* Hn = (float*)(ws);
    float* Pslab = (float*)(ws + 64 * MiB);
    float* cum = (float*)(ws + 94 * MiB);
    float* beta = (float*)(ws + 95 * MiB);
    float* gdec = (float*)(ws + 95 * MiB + 512 * 1024);
    float* qkv = (float*)(ws + 96 * MiB);
    float* mixed = (float*)(ws + 192 * MiB);
    float* mixout = (float*)(ws + 64 * MiB);
    float* X1 = (float*)(ws);
    float* H2 = (float*)(ws + 128 * MiB);
    float* hid = (float*)(ws + 192 * MiB);
    float* Y = (float*)(ws + 64 * MiB);

    k_rmsnorm<<<M / 4, 256, 0, stream>>>(x, pre_mix, nullptr, Hn, M);
    for (int b = 0; b < NB; ++b) {
        k_gemm<0><<<dim3((DP + 63) / 64, S / 64), 256, 0, stream>>>(Hn + (size_t)b * S * D, D, w_in, DP, Pslab, DP, DP, D);
        k_cum<<<HF, 256, 0, stream>>>(Pslab, fbias, cum);
        k_fox<<<dim3(S / 4, HF), 256, 0, stream>>>(Pslab, cum, fox_norm, mixed + (size_t)b * S * D);
        k_conv<<<S, 256, 0, stream>>>(Pslab, conv_w, a_log, dt_bias, qkv + (size_t)b * S * 1536, beta + (size_t)b * S * 4, gdec + (size_t)b * S * 4, mixed + (size_t)b * S * D);
    }
    k_l2<<<M * 8 / 4, 256, 0, stream>>>(qkv, M);
    k_gdn_rec<<<NB * HG, 128, 0, stream>>>(qkv, beta, gdec);
    k_gdn_post<<<M * 4 / 4, 256, 0, stream>>>(qkv, gdn_norm, mixed);
    k_gemm<0><<<dim3(D / 64, M / 64), 256, 0, stream>>>(mixed, D, w_out, D, mixout, D, D, D);
    k_rmsnorm<<<M / 4, 256, 0, stream>>>(mixout, post_mix, x, X1, M);
    k_rmsnorm<<<M / 4, 256, 0, stream>>>(X1, pre_mlp, nullptr, H2, M);
    for (int sl = 0; sl < 4; ++sl) {
        k_gemm<1><<<dim3(DFF / 64, 4096 / 64), 256, 0, stream>>>(H2 + (size_t)sl * 4096 * D, D, w_up, DFF, hid, DFF, DFF, D);
        k_gemm<0><<<dim3(D / 64, 4096 / 64), 256, 0, stream>>>(hid, DFF, w_down, D, Y + (size_t)sl * 4096 * D, D, D, DFF);
    }
    k_rmsnorm<<<M / 4, 256, 0, stream>>>(Y, post_mlp, X1, out, M);
}
```

```cpp
#include <hip/hip_runtime.h>
#include <cstdio>
#include <cstdint>
#define MIXER_PHASE_BODY
#define HOST_LAUNCH_PROGRAM \
    launch_skel(grid, stream, a, PH_PRO, PH_MIX, 0); \
    { unsigned char* ws = (unsigned char*)d_ws; float* outp = (float*)d_out; \
      const bf16* FQ = (const bf16*)(ws + WS_FQ); const bf16* FK = FQ + WS_G512 / 2; const bf16* FV = FK + WS_G512 / 2; const bf16* GQ = FV + WS_G512 / 2; \
      const bf16* GK = GQ + WS_G512 / 2; const bf16* GV = GK + WS_G512 / 2; const bf16* GZ = GV + WS_G512 / 2; \
      float* SMALL = (float*)(ws + WS_SMALL); float* CUM = (float*)(ws + WS_CUM); float* BETA = (float*)(ws + WS_BETA); float* GDEC = (float*)(ws + WS_GDEC); \
      bf16* MIXED = (bf16*)(ws + WS_MIXED); float* qf = outp; float* kf = outp + (size_t)M * 512; float* vf = (float*)(ws + 224 * MiB); \
      k_cum<<<NB * HF, 256, 0, stream>>>(SMALL, a.in[3], CUM); \
      k_fox<<<dim3(SEQ / 4, HF, NB), 256, 0, stream>>>(FQ, FK, FV, CUM, a.in[4], MIXED); \
      k_conv<<<M, 256, 0, stream>>>(GQ, GK, GV, SMALL, a.in[5], a.in[6], a.in[7], qf, kf, vf, BETA, GDEC); \
      k_l2<<<M * 8 / 4, 256, 0, stream>>>(qf, kf); \
      k_gdn_rec<<<NB * HG, 128, 0, stream>>>(qf, kf, vf, BETA, GDEC); \
      k_gdn_post<<<M * 4 / 4, 256, 0, stream>>>(qf, GZ, a.in[8], MIXED); } \
    launch_skel(grid, stream, a, PH_WO, PH_END, 1);
namespace pg8 {
#define PG8_LAS __attribute__((address_space(3)))
typedef unsigned short bf16_t;
typedef short bf16x8 __attribute__((ext_vector_type(8)));
typedef float f32x4 __attribute__((ext_vector_type(4)));
typedef unsigned u32x4 __attribute__((ext_vector_type(4)));
constexpr int BM = 256, BK = 64, HALF = 128, HTB = HALF * BK * 2  , STAGE_BYTES = 8 * HTB, NXCD = 8, WGM = 8;

__host__ __device__ __forceinline__ int lds_byte(int r, int c) { const int st = (r >> 4) * 2 + (c >> 5), rr = r & 15, cc = c & 31, ob = rr * 64 + cc * 2; return st * 1024 + (ob ^ (((ob >> 9) & 1) << 5)); }
__host__ __device__ __forceinline__ void stage_rc(int b, int& R, int& C) { const int st = b / 1024, sb = b % 1024, swz = sb ^ (((sb >> 9) & 1) << 5); R = (st >> 1) * 16 + swz / 64; C = (st & 1) * 32 + (swz % 64) / 2; }
__host__ __device__ __forceinline__ int perm32(int rho) { const int n = rho >> 4, i = rho & 15; return 8 * (i >> 2) + 4 * n + (i & 3); }

struct Unit { int pm, pn; };
struct Gemm { const bf16_t* A; const bf16_t* Bt; int M, N, K; };

struct StaticOrder {
    int nM, nN, nwg, G, c;
    __host__ __device__ void init(int M, int N, int G_, int c_) { nM = M / BM; nN = N / BM; nwg = nM * nN; G = G_; c = c_; }
    __host__ __device__ bool next(int i, Unit& u) const {
        const long L = (long)i * G + c; if (L >= nwg) return false;
        int wgid = (int)L; { const int q = nwg / NXCD, r = nwg % NXCD, xcd = wgid % NXCD, off = wgid / NXCD; wgid = (xcd < r ? xcd * (q + 1) : r * (q + 1) + (xcd - r) * q) + off; }
        const int nig = WGM * nN, gid = wgid / nig, fm = gid * WGM, gsz = (nM - fm) < WGM ? (nM - fm) : WGM;
        u.pm = fm + ((wgid % nig) % gsz); u.pn = (wgid % nig) / gsz; return true;
    }
    __device__ __forceinline__ void a_ready(const Unit&) const {}
    __device__ __forceinline__ void done(const Unit&) const {}
};

__device__ __forceinline__ unsigned cvt_pk_bf16(float lo, float hi) { unsigned r; asm volatile("v_cvt_pk_bf16_f32 %0, %1, %2" : "=v"(r) : "v"(lo), "v"(hi)); return r; }
typedef float f32x2 __attribute__((ext_vector_type(2)));
struct EpiProj {
    static constexpr bool PERM = true, AFTER_DRAIN = false;
    bf16_t* O; size_t gstride; float* small; float qscale;
    __device__ __forceinline__ void operator()(const f32x4 (&acc)[2][2][4][2], const Unit& u, int wr, int wc, int fr, int fq) const {
        const int row0 = u.pm * BM + wr * 64 + fr;
        if (u.pn < 14) {
            const int t = u.pn >> 1; bf16_t* base = O + (size_t)t * gstride; const float sc = (t == 0) ? qscale : 1.f;
            const int col0 = (u.pn & 1) * 256 + wc * 32 + 8 * fq;
#pragma unroll
            for (int ai = 0; ai < 2; ++ai)
#pragma unroll
                for (int m = 0; m < 4; ++m) { bf16_t* rowp = base + (size_t)(row0 + ai * HALF + m * 16) * 512 + col0;
#pragma unroll
                    for (int bj = 0; bj < 2; ++bj) { const f32x4 v0 = acc[ai][bj][m][0] * sc, v1 = acc[ai][bj][m][1] * sc;
                        u32x4 w; w.x = cvt_pk_bf16(v0[0], v0[1]); w.y = cvt_pk_bf16(v0[2], v0[3]); w.z = cvt_pk_bf16(v1[0], v1[1]); w.w = cvt_pk_bf16(v1[2], v1[3]);
                        *(u32x4*)(rowp + bj * HALF) = w; } }
        } else {
            if (wc == 0 && fq < 2) {
#pragma unroll
                for (int ai = 0; ai < 2; ++ai)
#pragma unroll
                    for (int m = 0; m < 4; ++m) { float* rowp = small + (size_t)(row0 + ai * HALF + m * 16) * 16 + 8 * fq;
                        *(f32x4*)(rowp) = acc[ai][0][m][0]; *(f32x4*)(rowp + 4) = acc[ai][0][m][1]; }
            }
        }
    }
};
struct EpiRelu2 {
    static constexpr bool PERM = true, AFTER_DRAIN = false;
    bf16_t* O; int ldc;
    __device__ __forceinline__ void operator()(const f32x4 (&acc)[2][2][4][2], const Unit& u, int wr, int wc, int fr, int fq) const {
        const int row0 = u.pm * BM + wr * 64 + fr, col0 = u.pn * BM + wc * 32 + 8 * fq;
#pragma unroll
        for (int ai = 0; ai < 2; ++ai)
#pragma unroll
            for (int m = 0; m < 4; ++m) { bf16_t* rowp = O + (size_t)(row0 + ai * HALF + m * 16) * ldc + col0;
#pragma unroll
                for (int bj = 0; bj < 2; ++bj) { f32x4 v0 = acc[ai][bj][m][0], v1 = acc[ai][bj][m][1];
#pragma unroll
                    for (int e = 0; e < 4; ++e) { const float a = fmaxf(v0[e], 0.f), b = fmaxf(v1[e], 0.f); v0[e] = a * a; v1[e] = b * b; }
                    u32x4 w; w.x = cvt_pk_bf16(v0[0], v0[1]); w.y = cvt_pk_bf16(v0[2], v0[3]); w.z = cvt_pk_bf16(v1[0], v1[1]); w.w = cvt_pk_bf16(v1[2], v1[3]);
                    *(u32x4*)(rowp + bj * HALF) = w; } }
    }
};
struct EpiF32 {
    static constexpr bool PERM = false, AFTER_DRAIN = false;
    float* O; int ldc;
    __device__ __forceinline__ void operator()(const f32x4 (&acc)[2][2][4][2], const Unit& u, int wr, int wc, int fr, int fq) const {
        const int row0 = u.pm * BM + wr * 64 + fr, col0 = u.pn * BM + wc * 32 + 4 * fq;
#pragma unroll
        for (int ai = 0; ai < 2; ++ai)
#pragma unroll
            for (int m = 0; m < 4; ++m) { float* rowp = O + (size_t)(row0 + ai * HALF + m * 16) * ldc + col0;
#pragma unroll
                for (int bj = 0; bj < 2; ++bj)
#pragma unroll
                    for (int n = 0; n < 2; ++n) *(f32x4*)(rowp + bj * HALF + n * 16) = acc[ai][bj][m][n]; }
    }
};
template <class Epi, class Sched, bool ALIGN_EPI = false, bool SP2 = false>
__device__ __forceinline__ void gemm_phase(PG8_LAS unsigned char* lds, const Gemm g, const Sched& S, const Epi& E) {
    const int tid = threadIdx.x, wid = __builtin_amdgcn_readfirstlane(tid >> 6), lane = tid & 63, wr = wid >> 2, wc = wid & 3, fr = lane & 15, fq = lane >> 4;
    const int K = g.K, nt = K / BK;
    unsigned voffA[2], voffB[2];
#pragma unroll
    for (int i = 0; i < 2; ++i) { int R, C; stage_rc(tid * 16 + i * 8192, R, C); const int Rb = Epi::PERM ? ((R & ~31) + perm32(R & 31)) : R;
        voffA[i] = (unsigned)(R * K + C) * 2u; voffB[i] = (unsigned)(Rb * K + C) * 2u; }
    const size_t kstep = (size_t)(BK * 2);
    const size_t hstep = (size_t)HALF * K * 2;
    const size_t tstep = 2 * hstep;
    const unsigned ldsw = (unsigned)wid * 1024u;
    const int aoff = lds_byte(wr * 64 + fr, fq * 8), boff = lds_byte(wc * 32 + fr, fq * 8);
#define PG8_SA(b, h) (((b) * 2 + (h)) * HTB)
#define PG8_SB(b, h) ((4 + (b) * 2 + (h)) * HTB)
#define PG8_STAGE(bufoff, gbase, voff) do { _Pragma("unroll") for (int _i = 0; _i < 2; ++_i) \
        __builtin_amdgcn_global_load_lds((const unsigned*)((const char*)(gbase) + (voff)[_i]), (PG8_LAS unsigned*)(lds + (bufoff) + ldsw + _i * 8192), 16, 0, 0); } while (0)
#define PG8_LDA(dst, b, h) do { _Pragma("unroll") for (int m = 0; m < 4; ++m) _Pragma("unroll") for (int k = 0; k < 2; ++k) dst[m][k] = *(const PG8_LAS bf16x8*)(lds + PG8_SA(b, h) + aoff + m * 2048 + k * 1024); } while (0)
#define PG8_LDB(dst, b, h) do { _Pragma("unroll") for (int n = 0; n < 2; ++n) _Pragma("unroll") for (int k = 0; k < 2; ++k) dst[n][k] = *(const PG8_LAS bf16x8*)(lds + PG8_SB(b, h) + boff + n * 2048 + k * 1024); } while (0)
#define PG8_MMA(ai, bj, At, Bt) do { __builtin_amdgcn_s_setprio(1); _Pragma("unroll") for (int m = 0; m < 4; ++m) _Pragma("unroll") for (int n = 0; n < 2; ++n) _Pragma("unroll") for (int k = 0; k < 2; ++k) \
        acc[ai][bj][m][n] = __builtin_amdgcn_mfma_f32_16x16x32_bf16(Bt[n][k], At[m][k], acc[ai][bj][m][n], 0, 0, 0); __builtin_amdgcn_s_setprio(0); } while (0)
#define PG8_WAIT_V(n) asm volatile("s_waitcnt vmcnt(" #n ")" ::: "memory")
#define PG8_WAIT_L(n) asm volatile("s_waitcnt lgkmcnt(" #n ")" ::: "memory")
#define PG8_BAR __builtin_amdgcn_s_barrier()
#define PG8_SCHED __builtin_amdgcn_sched_barrier(0)
    Unit cur, nxt; int ui = 0;
    if (!S.next(0, cur)) return;
    f32x4 acc[2][2][4][2];
#pragma unroll
    for (int a = 0; a < 2; ++a)
#pragma unroll
        for (int b = 0; b < 2; ++b)
#pragma unroll
            for (int m = 0; m < 4; ++m)
#pragma unroll
                for (int n = 0; n < 2; ++n) acc[a][b][m][n] = (f32x4){0.f, 0.f, 0.f, 0.f};
    bf16x8 At[4][2], B0[2][2], B1[2][2];
    const char* cA = (const char*)g.A + (size_t)cur.pm * tstep; const char* cB = (const char*)g.Bt + (size_t)cur.pn * tstep;
    S.a_ready(cur);
    if constexpr (SP2) {
        PG8_STAGE(PG8_SB(0, 0), cB, voffB); PG8_STAGE(PG8_SB(0, 1), cB + hstep, voffB); PG8_STAGE(PG8_SA(0, 0), cA, voffA); PG8_STAGE(PG8_SA(0, 1), cA + hstep, voffA);
        if (wr == 1) PG8_BAR;
        PG8_WAIT_V(2); PG8_BAR;
        PG8_STAGE(PG8_SB(1, 0), cB + kstep, voffB); PG8_STAGE(PG8_SA(1, 0), cA + kstep, voffA); PG8_STAGE(PG8_SB(1, 1), cB + hstep + kstep, voffB);
        PG8_WAIT_V(6); PG8_BAR;
    } else {
        PG8_STAGE(PG8_SB(0, 0), cB, voffB); PG8_STAGE(PG8_SA(0, 0), cA, voffA); PG8_STAGE(PG8_SB(0, 1), cB + hstep, voffB); PG8_STAGE(PG8_SA(0, 1), cA + hstep, voffA);
        if (wr == 1) PG8_BAR;
        PG8_WAIT_V(4); PG8_BAR;
        PG8_STAGE(PG8_SB(1, 0), cB + kstep, voffB); PG8_STAGE(PG8_SA(1, 0), cA + kstep, voffA); PG8_STAGE(PG8_SB(1, 1), cB + hstep + kstep, voffB);
        PG8_WAIT_V(6); PG8_BAR;
    }
    for (;;) {
        const bool has_next = S.next(ui + 1, nxt);
        const char* nA = has_next ? (const char*)g.A + (size_t)nxt.pm * tstep : cA; const char* nB = has_next ? (const char*)g.Bt + (size_t)nxt.pn * tstep : cB;
        for (int t = 0; t < nt; t += 2) {
            const bool last = (t == nt - 2);
            const char* a1 = cA + (size_t)(t + 1) * kstep;
            const char* a2 = last ? nA : cA + (size_t)(t + 2) * kstep; const char* b2 = last ? nB : cB + (size_t)(t + 2) * kstep;
            const char* a3 = a2 + kstep; const char* b3 = b2 + kstep;
            if (last && has_next) S.a_ready(nxt);
            if constexpr (SP2) {
            PG8_LDB(B0, 0, 0); PG8_LDB(B1, 0, 1); PG8_SCHED; PG8_LDA(At, 0, 0); PG8_STAGE(PG8_SA(1, 1), a1 + hstep, voffA);
            PG8_WAIT_V(8); PG8_WAIT_L(0); PG8_BAR; PG8_MMA(0, 0, At, B0); PG8_MMA(0, 1, At, B1); PG8_BAR; PG8_SCHED;
            PG8_LDA(At, 0, 1); PG8_STAGE(PG8_SB(0, 0), b2, voffB); PG8_STAGE(PG8_SB(0, 1), b2 + hstep, voffB); PG8_STAGE(PG8_SA(0, 0), a2, voffA);
            PG8_WAIT_V(8); PG8_WAIT_L(0); PG8_BAR; PG8_MMA(1, 0, At, B0); PG8_MMA(1, 1, At, B1); PG8_BAR; PG8_SCHED;
            PG8_LDB(B0, 1, 0); PG8_LDB(B1, 1, 1); PG8_SCHED; PG8_LDA(At, 1, 0); PG8_STAGE(PG8_SA(0, 1), a2 + hstep, voffA);
            PG8_WAIT_V(8); PG8_WAIT_L(0); PG8_BAR; PG8_MMA(0, 0, At, B0); PG8_MMA(0, 1, At, B1); PG8_BAR; PG8_SCHED;
            PG8_LDA(At, 1, 1); PG8_STAGE(PG8_SB(1, 0), b3, voffB); PG8_STAGE(PG8_SB(1, 1), b3 + hstep, voffB); PG8_STAGE(PG8_SA(1, 0), a3, voffA);
            PG8_WAIT_V(8); PG8_WAIT_L(0); PG8_BAR; PG8_MMA(1, 0, At, B0); PG8_MMA(1, 1, At, B1); PG8_BAR; PG8_SCHED;
            } else {
            PG8_LDB(B0, 0, 0); PG8_SCHED; PG8_LDA(At, 0, 0); PG8_STAGE(PG8_SA(1, 1), a1 + hstep, voffA);
            PG8_WAIT_L(8); PG8_BAR; PG8_WAIT_L(0); PG8_MMA(0, 0, At, B0); PG8_BAR; PG8_SCHED;
            PG8_LDB(B1, 0, 1); PG8_STAGE(PG8_SB(0, 0), b2, voffB);
            PG8_BAR; PG8_WAIT_L(0); PG8_MMA(0, 1, At, B1); PG8_BAR;
            PG8_LDA(At, 0, 1); PG8_STAGE(PG8_SA(0, 0), a2, voffA);
            PG8_BAR; PG8_WAIT_L(0); PG8_MMA(1, 0, At, B0); PG8_BAR; PG8_SCHED;
            PG8_STAGE(PG8_SB(0, 1), b2 + hstep, voffB);
            PG8_WAIT_V(6); PG8_BAR; PG8_MMA(1, 1, At, B1); PG8_BAR;
            PG8_LDB(B0, 1, 0); PG8_SCHED; PG8_LDA(At, 1, 0); PG8_STAGE(PG8_SA(0, 1), a2 + hstep, voffA);
            PG8_WAIT_L(8); PG8_BAR; PG8_WAIT_L(0); PG8_MMA(0, 0, At, B0); PG8_BAR; PG8_SCHED;
            PG8_LDB(B1, 1, 1); PG8_STAGE(PG8_SB(1, 0), b3, voffB);
            PG8_BAR; PG8_WAIT_L(0); PG8_MMA(0, 1, At, B1); PG8_BAR;
            PG8_LDA(At, 1, 1); PG8_STAGE(PG8_SA(1, 0), a3, voffA);
            PG8_BAR; PG8_WAIT_L(0); PG8_MMA(1, 0, At, B0); PG8_BAR; PG8_SCHED;
            PG8_STAGE(PG8_SB(1, 1), b3 + hstep, voffB);
            PG8_WAIT_V(6); PG8_BAR; PG8_MMA(1, 1, At, B1); PG8_BAR;
            }
        }
        if constexpr (ALIGN_EPI) { if (wr == 0) PG8_BAR; }
        if constexpr (!Epi::AFTER_DRAIN) { E(acc, cur, wr, wc, fr, fq); S.done(cur); }
        if (!has_next) break;
#pragma unroll
        for (int a = 0; a < 2; ++a)
#pragma unroll
            for (int b = 0; b < 2; ++b)
#pragma unroll
                for (int m = 0; m < 4; ++m)
#pragma unroll
                    for (int n = 0; n < 2; ++n) acc[a][b][m][n] = (f32x4){0.f, 0.f, 0.f, 0.f};
        cur = nxt; cA = nA; cB = nB; ++ui;
        if constexpr (ALIGN_EPI) { if (wr == 1) PG8_BAR; }
    }
    PG8_WAIT_V(0);
    if constexpr (!ALIGN_EPI) { if (wr == 0) PG8_BAR; }
    PG8_BAR;
    if constexpr (Epi::AFTER_DRAIN) { E.fused(acc, cur, wr, wc, fr, fq, lds, wid, lane); S.done(cur); }
#undef PG8_SA
#undef PG8_SB
#undef PG8_STAGE
#undef PG8_LDA
#undef PG8_LDB
#undef PG8_MMA
#undef PG8_WAIT_V
#undef PG8_WAIT_L
#undef PG8_BAR
#undef PG8_SCHED
}
}
#ifndef PG8_SP2
#define PG8_SP2 true
#endif
#ifndef PG8_ALIGN
#define PG8_ALIGN true
#endif
constexpr int NWAVES = 8;
constexpr int NB = 8, SEQ = 2048, D = 1024, M = NB * SEQ, FF = 4096;
constexpr int HF = 8, HG = 4;
constexpr int DPROJ = 3600, NPROJ = 3840;
constexpr float EPS = 1e-6f;
constexpr float LOG2E = 1.4426950408889634f;
constexpr float QSCALE = 0.125f * LOG2E;
constexpr int C_FF = 1536, C_GQ = 1544, C_GB = 3080, C_GA = 3084, C_GZ = 3088;
constexpr size_t MiB = 1u << 20;
constexpr size_t WS_CTL = 0, CTL_ZERO_BYTES = 1 * MiB;
constexpr size_t WS_WIN = 2 * MiB, WS_WOUT = 10 * MiB, WS_WUP = 12 * MiB, WS_WDN = 20 * MiB;
constexpr size_t WS_X = 28 * MiB;
constexpr size_t WS_XN = 32 * MiB;
constexpr size_t WS_FQ = 64 * MiB, WS_G512 = 16 * MiB;
constexpr size_t WS_SMALL = 176 * MiB;
constexpr size_t WS_CUM = 177 * MiB;
constexpr size_t WS_BETA = 178 * MiB, WS_GDEC = 178 * MiB + 512 * 1024;
constexpr size_t WS_MIXED = 192 * MiB;
constexpr size_t WS_H = 64 * MiB;
constexpr size_t WS_MIXOUT = 64 * MiB;
constexpr size_t WS_Y = 192 * MiB;
constexpr size_t WS_END = 256 * MiB;
constexpr int CW_TMO = 0, CW_CODE = 1;
constexpr int CW_BAR = 4096;
constexpr int CW_SEAM = 16384, SEAM_BANK = 128 * 64;
constexpr int RING_OFF = 0, RING_BYTES = 131072;
constexpr int LDSCTL_OFF = RING_BYTES, MISC_OFF = LDSCTL_OFF + 320;
constexpr int LDS_BYTES = 147456;
#define GAS __attribute__((address_space(1)))
#define LAS __attribute__((address_space(3)))
typedef unsigned short bf16;
typedef unsigned v4u __attribute__((ext_vector_type(4)));
typedef float f32x4 __attribute__((ext_vector_type(4)));
typedef short bf16x8 __attribute__((ext_vector_type(8)));
typedef GAS unsigned gu32;
typedef GAS unsigned long long gu64;
#define RLX_AGENT __ATOMIC_RELAXED, __HIP_MEMORY_SCOPE_AGENT
#define LDS_WAIT() asm volatile("s_waitcnt lgkmcnt(0)" ::: "memory")
#define VM_WAIT() asm volatile("s_waitcnt vmcnt(0)" ::: "memory")
__device__ __forceinline__ unsigned long long rt() { return __builtin_amdgcn_s_memrealtime(); }
__device__ __forceinline__ unsigned f2bf(float f) { unsigned u = __builtin_bit_cast(unsigned, f); return (u + 0x7fffu + ((u >> 16) & 1u)) >> 16; }
__device__ __forceinline__ unsigned pk2(float lo, float hi) { return f2bf(lo) | (f2bf(hi) << 16); }

#define XB_TMO      128
#define XB_XCNT(j)  (256  + 64 * (j))
#define XB_XSUB(j)  (1280 + 64 * (j))
#define XB_XGEN(j)  (2304 + 64 * (j))
#define XB_TOP      3328
#define XB_TOPGEN   3392
#define XCD_BAR_WORDS 3456
#define XB_SPIN_CAP (1u << 18)

__device__ __forceinline__ unsigned xb_ld(unsigned* p)              { return __hip_atomic_load(p, __ATOMIC_RELAXED, __HIP_MEMORY_SCOPE_AGENT); }
__device__ __forceinline__ unsigned xb_add(unsigned* p, unsigned v) { return __hip_atomic_fetch_add(p, v, __ATOMIC_RELAXED, __HIP_MEMORY_SCOPE_AGENT); }
__device__ __forceinline__ unsigned xb_xcc_id() { return (unsigned)__builtin_amdgcn_s_getreg((3 << 11) | 20) & 0xFu; }
#define XB_SPIN(cond, bar) do { unsigned _sp = 0; while (cond) { __builtin_amdgcn_s_sleep(1); \
    if ((++_sp & 255u) == 0u) { if (xb_ld(&(bar)[XB_TMO])) break; if (_sp > XB_SPIN_CAP) { atomicAdd(&(bar)[XB_TMO], 1u); break; } } } } while (0)

struct XcdBarrier {
    unsigned* bar; unsigned x;
    volatile LAS unsigned* st;
};

__device__ __forceinline__ XcdBarrier xcd_barrier_post(unsigned* bar, volatile LAS unsigned* st) {
    XcdBarrier b; b.bar = bar; b.x = xb_xcc_id(); b.st = st;
    if (threadIdx.x == 0) (void)xb_add(&bar[XB_XCNT(b.x)], 1u);
    return b;
}
__device__ __forceinline__ void xcd_barrier_complete(unsigned* bar, unsigned x, unsigned& nloc, unsigned& nx) {
    const unsigned G = gridDim.x * gridDim.y * gridDim.z;
    unsigned sum, cnt, mine, sp = 0u;
    for (;;) {
        sum = 0u; cnt = 0u; mine = 0u;
#pragma unroll
        for (unsigned j = 0; j < 16; ++j) { const unsigned c = xb_ld(&bar[XB_XCNT(j)]); sum += c; cnt += (c > 0u) ? 1u : 0u; mine = (j == x) ? c : mine; }
        if (sum == G) break;
        __builtin_amdgcn_s_sleep(1);
        if ((++sp & 255u) == 0u) { if (xb_ld(&bar[XB_TMO])) break; if (sp > XB_SPIN_CAP) { atomicAdd(&bar[XB_TMO], 1u); break; } }
    }
    nloc = mine > 0u ? mine : 1u; nx = cnt > 0u ? cnt : 1u;
}

__device__ __forceinline__ void xcd_barrier(const XcdBarrier& b) {
    asm volatile("s_waitcnt vmcnt(0)" ::: "memory");
    __syncthreads();
    if (threadIdx.x == 0) {
        unsigned* bar = b.bar;
        __builtin_amdgcn_s_waitcnt(0);
        unsigned nloc = b.st[0], nx = b.st[1];
        if (nloc == 0u) { xcd_barrier_complete(bar, b.x, nloc, nx); b.st[0] = nloc; b.st[1] = nx; }
        const unsigned old = xb_add(&bar[XB_XSUB(b.x)], 1u);
        const unsigned gen = old / nloc;
        if (old + 1u == (gen + 1u) * nloc) {
            __builtin_amdgcn_fence(__ATOMIC_RELEASE, "agent");
            asm volatile("s_waitcnt vmcnt(0)" ::: "memory");
            const unsigned og = xb_add(&bar[XB_TOP], 1u);
            const unsigned tg = og / nx;
            if (og + 1u == (tg + 1u) * nx) xb_add(&bar[XB_TOPGEN], 1u);
            else XB_SPIN(xb_ld(&bar[XB_TOPGEN]) == tg, bar);
            __builtin_amdgcn_fence(__ATOMIC_ACQUIRE, "agent");
            xb_add(&bar[XB_XGEN(b.x)], 1u);
            asm volatile("s_waitcnt vmcnt(0)" ::: "memory");
        } else {
            XB_SPIN(xb_ld(&bar[XB_XGEN(b.x)]) == gen, bar);
            __builtin_amdgcn_fence(__ATOMIC_ACQUIRE, "agent");
            asm volatile("s_waitcnt vmcnt(0)" ::: "memory");
        }
    }
    __syncthreads();
}
struct Frame {
    LAS unsigned char* lds;
    volatile LAS unsigned* MISC;
    gu32* ctl;
    int tid, lane, wave;
    int vcu, G;
};
__device__ __forceinline__ float wave_sum(float v) {
#pragma unroll
    for (int o = 1; o < 64; o <<= 1) v += __shfl_xor(v, o);
    return v;
}
__device__ __forceinline__ float bf2f(unsigned short u) { return __uint_as_float((unsigned)u << 16); }
__device__ __forceinline__ int proj_src_col(int n) {
    if (n < 1536) return n;
    if (n < 3072) return n + 8;
    if (n < 3584) return n + 16;
    if (n < 3592) return C_FF + (n - 3584);
    if (n < 3596) return C_GB + (n - 3592);
    if (n < 3600) return C_GA + (n - 3596);
    return -1;
}
template <bool REMAP>
__device__ __forceinline__ void p0_transpose_item(const float* W, int K, int N, int Ndst, bf16* WT, LAS float* scr, int item, int lane) {
    const int nblk = Ndst / 32, kb = item / nblk, nb = item % nblk, k0 = 64 * kb, n0 = 32 * nb;
    const int sc = REMAP ? proj_src_col(n0 + (lane & 31)) : n0 + (lane & 31);
#pragma unroll 8
    for (int i = 0; i < 32; ++i) { const int kk = 2 * i + (lane >> 5); scr[kk * 33 + (lane & 31)] = (sc >= 0) ? W[(size_t)(k0 + kk) * N + sc] : 0.f; }
    LDS_WAIT(); asm volatile("" ::: "memory");
    const int c = lane & 7;
#pragma unroll
    for (int j = 0; j < 4; ++j) { const int n = (lane >> 3) + 8 * j; const LAS float* s = scr + (8 * c) * 33 + n;
        v4u o; o.x = pk2(s[0 * 33], s[1 * 33]); o.y = pk2(s[2 * 33], s[3 * 33]); o.z = pk2(s[4 * 33], s[5 * 33]); o.w = pk2(s[6 * 33], s[7 * 33]);
        *(GAS v4u*)(WT + (size_t)(n0 + n) * K + k0 + 8 * c) = o; }
    LDS_WAIT(); asm volatile("" ::: "memory");
}
__device__ __forceinline__ void rms_row_to_bf16(int lane, const float* xrow, const float* g, bf16* orow) {
    const GAS f32x4* xr = (const GAS f32x4*)xrow + lane; const GAS f32x4* gr = (const GAS f32x4*)g + lane;
    f32x4 v[4]; float s = 0.f;
#pragma unroll
    for (int j = 0; j < 4; ++j) { v[j] = xr[64 * j]; s += (v[j].x * v[j].x + v[j].y * v[j].y) + (v[j].z * v[j].z + v[j].w * v[j].w); }
    const float r = rsqrtf(wave_sum(s) * (1.f / D) + EPS);
    GAS unsigned long long* o8 = (GAS unsigned long long*)orow + lane;
#pragma unroll
    for (int j = 0; j < 4; ++j) { const f32x4 gg = gr[64 * j];
        o8[64 * j] = (unsigned long long)pk2(v[j].x * r * gg.x, v[j].y * r * gg.y) | ((unsigned long long)pk2(v[j].z * r * gg.z, v[j].w * r * gg.w) << 32); }
}
__device__ __forceinline__ void resnorm_row(int lane, const float* yrow, const float* g1, const float* baserow, float* outrow, const float* g2, bf16* xnrow) {
    const GAS f32x4* yr = (const GAS f32x4*)yrow + lane; const GAS f32x4* gr = (const GAS f32x4*)g1 + lane; const GAS f32x4* br = (const GAS f32x4*)baserow + lane;
    f32x4 v[4]; float s = 0.f;
#pragma unroll
    for (int j = 0; j < 4; ++j) { v[j] = yr[64 * j]; s += (v[j].x * v[j].x + v[j].y * v[j].y) + (v[j].z * v[j].z + v[j].w * v[j].w); }
    const float r = rsqrtf(wave_sum(s) * (1.f / D) + EPS);
    float s2 = 0.f;
#pragma unroll
    for (int j = 0; j < 4; ++j) { const f32x4 gg = gr[64 * j], bb = br[64 * j]; v[j] = bb + v[j] * r * gg; s2 += (v[j].x * v[j].x + v[j].y * v[j].y) + (v[j].z * v[j].z + v[j].w * v[j].w);
        ((GAS f32x4*)outrow + lane)[64 * j] = v[j]; }
    if (xnrow) {
        const float r2 = rsqrtf(wave_sum(s2) * (1.f / D) + EPS); const GAS f32x4* g2r = (const GAS f32x4*)g2 + lane;
        GAS unsigned long long* o8 = (GAS unsigned long long*)xnrow + lane;
#pragma unroll
        for (int j = 0; j < 4; ++j) { const f32x4 gg = g2r[64 * j];
            o8[64 * j] = (unsigned long long)pk2(v[j].x * r2 * gg.x, v[j].y * r2 * gg.y) | ((unsigned long long)pk2(v[j].z * r2 * gg.z, v[j].w * r2 * gg.w) << 32); }
    }
}

struct Args { const float* in[15]; float* out; unsigned char* ws; int ph_lo, ph_hi, li, pad; };
enum { PH_PRO = 0, PH_PROJ = 1, PH_MIX = 2, PH_WO = 3, PH_N1 = 4, PH_UP = 5, PH_DOWN = 6, PH_N2 = 7, PH_END = 8 };

__global__ void __launch_bounds__(NWAVES * 64, 2) skel_fwd(Args args) {
    extern __shared__ __attribute__((aligned(16))) unsigned char lds[];
    Frame F;
    F.lds = (LAS unsigned char*)lds;
    F.MISC = (volatile LAS unsigned*)(F.lds + MISC_OFF);
    F.tid = threadIdx.x; F.lane = F.tid & 63; F.wave = __builtin_amdgcn_readfirstlane(F.tid >> 6);
    F.G = gridDim.x; { const int bx = blockIdx.x; F.vcu = (F.G % 8 == 0) ? (bx % 8) * (F.G / 8) + bx / 8 : bx; }
    unsigned char* ws = args.ws;
    F.ctl = (gu32*)(ws + WS_CTL);
    const float* x = args.in[0]; const float* g_premix = args.in[1]; const float* w_in = args.in[2];
    const float* w_out = args.in[9]; const float* g_postmix = args.in[10]; const float* g_premlp = args.in[11];
    const float* w_up = args.in[12]; const float* w_down = args.in[13]; const float* g_postmlp = args.in[14];
    bf16* Win_t = (bf16*)(ws + WS_WIN); bf16* Wout_t = (bf16*)(ws + WS_WOUT); bf16* Wup_t = (bf16*)(ws + WS_WUP); bf16* Wdn_t = (bf16*)(ws + WS_WDN);
    bf16* XN = (bf16*)(ws + WS_XN); bf16* FQ = (bf16*)(ws + WS_FQ); bf16* MIXED = (bf16*)(ws + WS_MIXED); bf16* HB = (bf16*)(ws + WS_H);
    float* SMALL = (float*)(ws + WS_SMALL); float* MIXOUT = (float*)(ws + WS_MIXOUT); float* Y = (float*)(ws + WS_Y);
    for (int u = F.tid; u < (LDS_BYTES - LDSCTL_OFF) / 4; u += NWAVES * 64) ((LAS unsigned*)(F.lds + LDSCTL_OFF))[u] = 0u;
    __syncthreads();
    XcdBarrier bar = xcd_barrier_post((unsigned*)(F.ctl + CW_BAR) + args.li * XCD_BAR_WORDS, F.MISC + 8);
    const int lo = args.ph_lo, hi = args.ph_hi;
#define IN(k) (lo <= (k) && (k) < hi)
#define BOTH(k) (IN(k) && IN((k) + 1))
#define GRID_BAR() xcd_barrier(bar)
    const int gw = F.vcu * NWAVES + F.wave, NGW = F.G * NWAVES;

    if (IN(PH_PRO)) {
        LAS float* scr = (LAS float*)(F.lds + RING_OFF + F.wave * 16384);
        constexpr int I_IN = (D / 64) * (NPROJ / 32), I_O = (D / 64) * (D / 32), I_1 = (D / 64) * (FF / 32), I_2 = (FF / 64) * (D / 32);
        constexpr int NITEMS = I_IN + I_O + I_1 + I_2;
        for (int it = gw; it < NITEMS; it += NGW) {
            int r = it;
            if (r < I_IN) { p0_transpose_item<true>(w_in, D, DPROJ, NPROJ, Win_t, scr, r, F.lane); continue; } r -= I_IN;
            if (r < I_O) { p0_transpose_item<false>(w_out, D, D, D, Wout_t, scr, r, F.lane); continue; } r -= I_O;
            if (r < I_1) { p0_transpose_item<false>(w_up, D, FF, FF, Wup_t, scr, r, F.lane); continue; } r -= I_1;
            p0_transpose_item<false>(w_down, FF, D, D, Wdn_t, scr, r, F.lane);
        }
        for (int m = gw; m < M; m += NGW) rms_row_to_bf16(F.lane, x + (size_t)m * D, g_premix, XN + (size_t)m * D);
        if (BOTH(PH_PRO)) GRID_BAR();
    }
    if (IN(PH_PROJ)) {
        pg8::Gemm g{XN, Win_t, M, NPROJ, D}; pg8::StaticOrder S; S.init(M, NPROJ, F.G, (int)blockIdx.x);
        pg8::EpiProj E{FQ, (size_t)(WS_G512 / 2), SMALL, QSCALE};
        pg8::gemm_phase<pg8::EpiProj, pg8::StaticOrder, PG8_ALIGN, PG8_SP2>(F.lds + RING_OFF, g, S, E);
        if (BOTH(PH_PROJ)) GRID_BAR();
    }
    if (IN(PH_MIX)) {
        MIXER_PHASE_BODY
        if (BOTH(PH_MIX)) GRID_BAR();
    }
    if (IN(PH_WO)) {
        pg8::Gemm g{MIXED, Wout_t, M, D, D}; pg8::StaticOrder S; S.init(M, D, F.G, (int)blockIdx.x);
        pg8::EpiF32 E{MIXOUT, D};
        pg8::gemm_phase<pg8::EpiF32, pg8::StaticOrder, false, PG8_SP2>(F.lds + RING_OFF, g, S, E);
        if (BOTH(PH_WO)) GRID_BAR();
    }
    if (IN(PH_N1)) {
        for (int m = gw; m < M; m += NGW) resnorm_row(F.lane, MIXOUT + (size_t)m * D, g_postmix, x + (size_t)m * D, args.out + (size_t)m * D, g_premlp, XN + (size_t)m * D);
        if (BOTH(PH_N1)) GRID_BAR();
    }
    if (IN(PH_UP)) {
        pg8::Gemm g{XN, Wup_t, M, FF, D}; pg8::StaticOrder S; S.init(M, FF, F.G, (int)blockIdx.x);
        pg8::EpiRelu2 E{HB, FF};
        pg8::gemm_phase<pg8::EpiRelu2, pg8::StaticOrder, PG8_ALIGN, PG8_SP2>(F.lds + RING_OFF, g, S, E);
        if (BOTH(PH_UP)) GRID_BAR();
    }
    if (IN(PH_DOWN)) {
        pg8::Gemm g{HB, Wdn_t, M, D, FF}; pg8::StaticOrder S; S.init(M, D, F.G, (int)blockIdx.x);
        pg8::EpiF32 E{Y, D};
        pg8::gemm_phase<pg8::EpiF32, pg8::StaticOrder, false, PG8_SP2>(F.lds + RING_OFF, g, S, E);
        if (BOTH(PH_DOWN)) GRID_BAR();
    }
    if (IN(PH_N2)) {
        for (int m = gw; m < M; m += NGW) resnorm_row(F.lane, Y + (size_t)m * D, g_postmlp, args.out + (size_t)m * D, args.out + (size_t)m * D, nullptr, nullptr);
    }
#undef IN
#undef BOTH
#undef GRID_BAR
}
__device__ __forceinline__ float wave_max(float v) {
#pragma unroll
    for (int o = 1; o < 64; o <<= 1) v = fmaxf(v, __shfl_xor(v, o));
    return v;
}
__device__ __forceinline__ float softplus_f(float x) { return fmaxf(x, 0.f) + log1pf(expf(-fabsf(x))); }
__device__ __forceinline__ float sigmoid_f(float x) { return 1.f / (1.f + expf(-x)); }
__global__ void k_cum(const float* __restrict__ small, const float* __restrict__ fbias, float* __restrict__ cum) {
    __shared__ float part[256];
    const int b = blockIdx.x >> 3, h = blockIdx.x & 7, tid = threadIdx.x;
    float loc[8]; float s = 0.f;
    const float bz = fbias[h];
#pragma unroll
    for (int i = 0; i < 8; ++i) {
        const float z = small[(size_t)(b * SEQ + tid * 8 + i) * 16 + h] + bz;
        const float lf = fminf(z, 0.f) - log1pf(expf(-fabsf(z)));
        s += lf; loc[i] = s;
    }
    part[tid] = s;
    __syncthreads();
    if (tid == 0) { float run = 0.f; for (int i = 0; i < 256; ++i) { const float t = part[i]; part[i] = run; run += t; } }
    __syncthreads();
    const float off = part[tid];
#pragma unroll
    for (int i = 0; i < 8; ++i) cum[(size_t)blockIdx.x * SEQ + tid * 8 + i] = loc[i] + off;
}
__global__ void __launch_bounds__(256) k_fox(const bf16* __restrict__ FQ, const bf16* __restrict__ FK, const bf16* __restrict__ FV, const float* __restrict__ cum, const float* __restrict__ gnorm, bf16* __restrict__ mixed) {
    __shared__ float lg[4][SEQ];
    __shared__ float qs[4][64];
    const int w = threadIdx.x >> 6, lane = threadIdx.x & 63;
    const int t = blockIdx.x * 4 + w, h = blockIdx.y, b = blockIdx.z;
    const size_t r0 = (size_t)b * SEQ;
    qs[w][lane] = bf2f(FQ[(r0 + t) * 512 + h * 64 + lane]);
    __syncthreads();
    const float* cm = cum + (size_t)(b * 8 + h) * SEQ;
    const float ct = cm[t];
    float mx = -INFINITY;
    for (int s = lane; s <= t; s += 64) {
        const bf16* kr = FK + (r0 + s) * 512 + h * 64;
        float dot = 0.f;
#pragma unroll
        for (int j = 0; j < 64; ++j) dot += qs[w][j] * bf2f(kr[j]);
        const float l = dot + (ct - cm[s]) * LOG2E;
        lg[w][s] = l; mx = fmaxf(mx, l);
    }
    mx = wave_max(mx);
    float sum = 0.f;
    for (int s = lane; s <= t; s += 64) { const float p = exp2f(lg[w][s] - mx); lg[w][s] = p; sum += p; }
    sum = wave_sum(sum);
    __syncthreads();
    float o = 0.f;
    for (int s = 0; s <= t; ++s) o += lg[w][s] * bf2f(FV[(r0 + s) * 512 + h * 64 + lane]);
    o /= sum;
    const float r = rsqrtf(wave_sum(o * o) * (1.f / 64.f) + EPS);
    mixed[(r0 + t) * D + h * 64 + lane] = (bf16)f2bf(o * r * gnorm[lane]);
}
__global__ void k_conv(const bf16* __restrict__ GQ, const bf16* __restrict__ GK, const bf16* __restrict__ GV, const float* __restrict__ small, const float* __restrict__ cw,
                       const float* __restrict__ a_log, const float* __restrict__ dt_bias, float* __restrict__ qf, float* __restrict__ kf, float* __restrict__ vf, float* __restrict__ beta, float* __restrict__ gdec) {
    const int m = blockIdx.x, t = m & (SEQ - 1);
    for (int c = threadIdx.x; c < 1536; c += blockDim.x) {
        const bf16* src = c < 512 ? GQ : (c < 1024 ? GK : GV); float* dst = c < 512 ? qf : (c < 1024 ? kf : vf); const int cc = c & 511;
        float y = 0.f;
#pragma unroll
        for (int j = 0; j < 4; ++j) { const int tt = t - 3 + j; if (tt >= 0) y += cw[j * 1536 + c] * bf2f(src[(size_t)(m - 3 + j) * 512 + cc]); }
        dst[(size_t)m * 512 + cc] = y * sigmoid_f(y);
    }
    if (threadIdx.x < 4) {
        const int h = threadIdx.x;
        beta[m * 4 + h] = sigmoid_f(small[(size_t)m * 16 + 8 + h]);
        gdec[m * 4 + h] = -expf(a_log[h]) * softplus_f(small[(size_t)m * 16 + 12 + h] + dt_bias[h]);
    }
}
__global__ void k_l2(float* __restrict__ qf, float* __restrict__ kf) {
    const int lane = threadIdx.x & 63, item = blockIdx.x * 4 + (threadIdx.x >> 6);
    const int h = item & 3, which = (item >> 2) & 1, m = item >> 3;
    float* p = (which ? kf : qf) + (size_t)m * 512 + h * 128;
    const float a = p[lane], b = p[lane + 64];
    const float r = rsqrtf(wave_sum(a * a + b * b) + EPS) * (which == 0 ? 0.08838834764831845f : 1.f);
    p[lane] = a * r; p[lane + 64] = b * r;
}
__global__ void __launch_bounds__(128) k_gdn_rec(float* __restrict__ qf, const float* __restrict__ kf, const float* __restrict__ vf, const float* __restrict__ beta, const float* __restrict__ gdec) {
    __shared__ float ks[2][128];
    __shared__ float qsh[2][128];
    const int b = blockIdx.x >> 2, h = blockIdx.x & 3, v = threadIdx.x;
    float Sd[128];
#pragma unroll
    for (int d = 0; d < 128; ++d) Sd[d] = 0.f;
    const size_t r0 = (size_t)b * SEQ; const int co = h * 128 + v;
    float qn = qf[r0 * 512 + co], kn = kf[r0 * 512 + co], vn = vf[r0 * 512 + co], an = expf(gdec[r0 * 4 + h]), bn = beta[r0 * 4 + h];
    for (int t = 0; t < SEQ; ++t) {
        const int bufi = t & 1;
        ks[bufi][v] = kn; qsh[bufi][v] = qn;
        const float vt = vn, at = an, bt = bn;
        if (t + 1 < SEQ) { const size_t r = r0 + t + 1; qn = qf[r * 512 + co]; kn = kf[r * 512 + co]; vn = vf[r * 512 + co]; an = expf(gdec[r * 4 + h]); bn = beta[r * 4 + h]; }
        __syncthreads();
        float kS = 0.f;
#pragma unroll
        for (int d = 0; d < 128; ++d) kS += ks[bufi][d] * Sd[d];
        const float coef = bt * (vt - at * kS);
        float o = 0.f;
#pragma unroll
        for (int d = 0; d < 128; ++d) { Sd[d] = at * Sd[d] + ks[bufi][d] * coef; o += qsh[bufi][d] * Sd[d]; }
        qf[(r0 + t) * 512 + co] = o;
    }
}
__global__ void k_gdn_post(const float* __restrict__ qf, const bf16* __restrict__ GZ, const float* __restrict__ gnorm, bf16* __restrict__ mixed) {
    const int lane = threadIdx.x & 63, item = blockIdx.x * 4 + (threadIdx.x >> 6);
    const int h = item & 3, m = item >> 2;
    const float* p = qf + (size_t)m * 512 + h * 128;
    const float a = p[lane], b = p[lane + 64];
    const float r = rsqrtf(wave_sum(a * a + b * b) * (1.f / 128.f) + EPS);
    const float z0 = bf2f(GZ[(size_t)m * 512 + h * 128 + lane]), z1 = bf2f(GZ[(size_t)m * 512 + h * 128 + lane + 64]);
    bf16* o = mixed + (size_t)m * D + 512 + h * 128;
    o[lane] = (bf16)f2bf(a * r * gnorm[lane] * z0 * sigmoid_f(z0));
    o[lane + 64] = (bf16)f2bf(b * r * gnorm[lane + 64] * z1 * sigmoid_f(z1));
}
static void launch_skel(int grid, hipStream_t stream, Args a, int lo, int hi, int li) {
    a.ph_lo = lo; a.ph_hi = hi; a.li = li;
    hipLaunchKernelGGL(skel_fwd, dim3(grid), dim3(NWAVES * 64), LDS_BYTES, stream, a);
    const hipError_t le = hipPeekAtLastError();
    if (le != hipSuccess) fprintf(stderr, "kernel_launch: launch %d failed: %s\n", li, hipGetErrorName(le));
}
extern "C" void kernel_launch(void* const* d_in, const int* in_sizes, int n_in, void* d_out, int out_size, void* d_ws, size_t ws_size, hipStream_t stream) {
    static int grid = 0;
    if (grid == 0) {
        if (n_in != 15 || in_sizes[0] != M * D || out_size != M * D || ws_size < WS_END) { fprintf(stderr, "kernel_launch: unexpected shapes (n_in %d, in0 %d, out %d, ws %zu); nothing launched\n", n_in, n_in > 0 ? in_sizes[0] : -1, out_size, ws_size); grid = -1; return; }
        int dev = 0, cus = 0, per_cu = 0;
        if (hipGetDevice(&dev) != hipSuccess || hipDeviceGetAttribute(&cus, hipDeviceAttributeMultiprocessorCount, dev) != hipSuccess) { grid = -1; return; }
        if (hipFuncSetAttribute((const void*)skel_fwd, hipFuncAttributeMaxDynamicSharedMemorySize, LDS_BYTES) != hipSuccess) { fprintf(stderr, "kernel_launch: hipFuncSetAttribute failed\n"); grid = -1; return; }
        if (hipOccupancyMaxActiveBlocksPerMultiprocessor(&per_cu, (const void*)skel_fwd, NWAVES * 64, LDS_BYTES) != hipSuccess || per_cu < 1)
            fprintf(stderr, "kernel_launch: note: occupancy query reports %d workgroups per CU\n", per_cu);
        (void)hipGetLastError();
        grid = cus;
    }
    if (grid < 0) return;
    if (hipMemsetAsync((char*)d_ws + WS_CTL, 0, CTL_ZERO_BYTES, stream) != hipSuccess) { fprintf(stderr, "kernel_launch: hipMemsetAsync failed\n"); return; }
    Args a{};
    for (int i = 0; i < 15; ++i) a.in[i] = (const float*)d_in[i];
    a.out = (float*)d_out; a.ws = (unsigned char*)d_ws;
    HOST_LAUNCH_PROGRAM
}
```

```cpp
#include <hip/hip_runtime.h>
#include <cstdio>
#include <cstdint>
#define MIXER_PHASE_BODY \
    { static_assert(attn_body::ATTN_LDS_BYTES <= RING_BYTES, "attention LDS"); \
      const attn_body::AttnTensors AT{(const attn_body::bf16*)FQ, (const attn_body::bf16*)(FQ + WS_G512 / 2), (const attn_body::bf16*)(FQ + WS_G512), (attn_body::bf16*)MIXED, (const float*)(ws + WS_CUM), args.in[4]}; \
      const attn_body::StaticOrder S((int)F.G, (int)blockIdx.x); \
      attn_body::attn_phase<attn_body::StaticOrder>((char*)lds + RING_OFF, AT, S); }
#define HOST_LAUNCH_PROGRAM \
    launch_skel(grid, stream, a, PH_PRO, PH_MIX, 0); \
    { unsigned char* ws = (unsigned char*)d_ws; float* outp = (float*)d_out; \
      const bf16* FQ = (const bf16*)(ws + WS_FQ); const bf16* FK = FQ + WS_G512 / 2; const bf16* FV = FK + WS_G512 / 2; const bf16* GQ = FV + WS_G512 / 2; \
      const bf16* GK = GQ + WS_G512 / 2; const bf16* GV = GK + WS_G512 / 2; const bf16* GZ = GV + WS_G512 / 2; \
      float* SMALL = (float*)(ws + WS_SMALL); float* CUM = (float*)(ws + WS_CUM); float* BETA = (float*)(ws + WS_BETA); float* GDEC = (float*)(ws + WS_GDEC); \
      bf16* MIXED = (bf16*)(ws + WS_MIXED); float* qf = outp; float* kf = outp + (size_t)M * 512; float* vf = (float*)(ws + 224 * MiB); \
      k_cum<<<NB * HF, 256, 0, stream>>>(SMALL, a.in[3], CUM); \
      k_conv<<<M, 256, 0, stream>>>(GQ, GK, GV, SMALL, a.in[5], a.in[6], a.in[7], qf, kf, vf, BETA, GDEC); \
      k_l2<<<M * 8 / 4, 256, 0, stream>>>(qf, kf); \
      k_gdn_rec<<<NB * HG, 128, 0, stream>>>(qf, kf, vf, BETA, GDEC); \
      k_gdn_post<<<M * 4 / 4, 256, 0, stream>>>(qf, GZ, a.in[8], MIXED); (void)FK; (void)FV; } \
    launch_skel(grid, stream, a, PH_MIX, PH_END, 1);
namespace pg8 {
#define PG8_LAS __attribute__((address_space(3)))
typedef unsigned short bf16_t;
typedef short bf16x8 __attribute__((ext_vector_type(8)));
typedef float f32x4 __attribute__((ext_vector_type(4)));
typedef unsigned u32x4 __attribute__((ext_vector_type(4)));
constexpr int BM = 256, BK = 64, HALF = 128, HTB = HALF * BK * 2  , STAGE_BYTES = 8 * HTB, NXCD = 8, WGM = 8;

__host__ __device__ __forceinline__ int lds_byte(int r, int c) { const int st = (r >> 4) * 2 + (c >> 5), rr = r & 15, cc = c & 31, ob = rr * 64 + cc * 2; return st * 1024 + (ob ^ (((ob >> 9) & 1) << 5)); }
__host__ __device__ __forceinline__ void stage_rc(int b, int& R, int& C) { const int st = b / 1024, sb = b % 1024, swz = sb ^ (((sb >> 9) & 1) << 5); R = (st >> 1) * 16 + swz / 64; C = (st & 1) * 32 + (swz % 64) / 2; }
__host__ __device__ __forceinline__ int perm32(int rho) { const int n = rho >> 4, i = rho & 15; return 8 * (i >> 2) + 4 * n + (i & 3); }

struct Unit { int pm, pn; };
struct Gemm { const bf16_t* A; const bf16_t* Bt; int M, N, K; };

struct StaticOrder {
    int nM, nN, nwg, G, c;
    __host__ __device__ void init(int M, int N, int G_, int c_) { nM = M / BM; nN = N / BM; nwg = nM * nN; G = G_; c = c_; }
    __host__ __device__ bool next(int i, Unit& u) const {
        const long L = (long)i * G + c; if (L >= nwg) return false;
        int wgid = (int)L; { const int q = nwg / NXCD, r = nwg % NXCD, xcd = wgid % NXCD, off = wgid / NXCD; wgid = (xcd < r ? xcd * (q + 1) : r * (q + 1) + (xcd - r) * q) + off; }
        const int nig = WGM * nN, gid = wgid / nig, fm = gid * WGM, gsz = (nM - fm) < WGM ? (nM - fm) : WGM;
        u.pm = fm + ((wgid % nig) % gsz); u.pn = (wgid % nig) / gsz; return true;
    }
    __device__ __forceinline__ void a_ready(const Unit&) const {}
    __device__ __forceinline__ void done(const Unit&) const {}
};

__device__ __forceinline__ unsigned cvt_pk_bf16(float lo, float hi) { unsigned r; asm volatile("v_cvt_pk_bf16_f32 %0, %1, %2" : "=v"(r) : "v"(lo), "v"(hi)); return r; }
typedef float f32x2 __attribute__((ext_vector_type(2)));
struct EpiProj {
    static constexpr bool PERM = true, AFTER_DRAIN = false;
    bf16_t* O; size_t gstride; float* small; float qscale;
    __device__ __forceinline__ void operator()(const f32x4 (&acc)[2][2][4][2], const Unit& u, int wr, int wc, int fr, int fq) const {
        const int row0 = u.pm * BM + wr * 64 + fr;
        if (u.pn < 14) {
            const int t = u.pn >> 1; bf16_t* base = O + (size_t)t * gstride; const float sc = (t == 0) ? qscale : 1.f;
            const int col0 = (u.pn & 1) * 256 + wc * 32 + 8 * fq;
#pragma unroll
            for (int ai = 0; ai < 2; ++ai)
#pragma unroll
                for (int m = 0; m < 4; ++m) { bf16_t* rowp = base + (size_t)(row0 + ai * HALF + m * 16) * 512 + col0;
#pragma unroll
                    for (int bj = 0; bj < 2; ++bj) { const f32x4 v0 = acc[ai][bj][m][0] * sc, v1 = acc[ai][bj][m][1] * sc;
                        u32x4 w; w.x = cvt_pk_bf16(v0[0], v0[1]); w.y = cvt_pk_bf16(v0[2], v0[3]); w.z = cvt_pk_bf16(v1[0], v1[1]); w.w = cvt_pk_bf16(v1[2], v1[3]);
                        *(u32x4*)(rowp + bj * HALF) = w; } }
        } else {
            if (wc == 0 && fq < 2) {
#pragma unroll
                for (int ai = 0; ai < 2; ++ai)
#pragma unroll
                    for (int m = 0; m < 4; ++m) { float* rowp = small + (size_t)(row0 + ai * HALF + m * 16) * 16 + 8 * fq;
                        *(f32x4*)(rowp) = acc[ai][0][m][0]; *(f32x4*)(rowp + 4) = acc[ai][0][m][1]; }
            }
        }
    }
};
struct EpiRelu2 {
    static constexpr bool PERM = true, AFTER_DRAIN = false;
    bf16_t* O; int ldc;
    __device__ __forceinline__ void operator()(const f32x4 (&acc)[2][2][4][2], const Unit& u, int wr, int wc, int fr, int fq) const {
        const int row0 = u.pm * BM + wr * 64 + fr, col0 = u.pn * BM + wc * 32 + 8 * fq;
#pragma unroll
        for (int ai = 0; ai < 2; ++ai)
#pragma unroll
            for (int m = 0; m < 4; ++m) { bf16_t* rowp = O + (size_t)(row0 + ai * HALF + m * 16) * ldc + col0;
#pragma unroll
                for (int bj = 0; bj < 2; ++bj) { f32x4 v0 = acc[ai][bj][m][0], v1 = acc[ai][bj][m][1];
#pragma unroll
                    for (int e = 0; e < 4; ++e) { const float a = fmaxf(v0[e], 0.f), b = fmaxf(v1[e], 0.f); v0[e] = a * a; v1[e] = b * b; }
                    u32x4 w; w.x = cvt_pk_bf16(v0[0], v0[1]); w.y = cvt_pk_bf16(v0[2], v0[3]); w.z = cvt_pk_bf16(v1[0], v1[1]); w.w = cvt_pk_bf16(v1[2], v1[3]);
                    *(u32x4*)(rowp + bj * HALF) = w; } }
    }
};
struct EpiF32 {
    static constexpr bool PERM = false, AFTER_DRAIN = false;
    float* O; int ldc;
    __device__ __forceinline__ void operator()(const f32x4 (&acc)[2][2][4][2], const Unit& u, int wr, int wc, int fr, int fq) const {
        const int row0 = u.pm * BM + wr * 64 + fr, col0 = u.pn * BM + wc * 32 + 4 * fq;
#pragma unroll
        for (int ai = 0; ai < 2; ++ai)
#pragma unroll
            for (int m = 0; m < 4; ++m) { float* rowp = O + (size_t)(row0 + ai * HALF + m * 16) * ldc + col0;
#pragma unroll
                for (int bj = 0; bj < 2; ++bj)
#pragma unroll
                    for (int n = 0; n < 2; ++n) *(f32x4*)(rowp + bj * HALF + n * 16) = acc[ai][bj][m][n]; }
    }
};
template <class Epi, class Sched, bool ALIGN_EPI = false, bool SP2 = false>
__device__ __forceinline__ void gemm_phase(PG8_LAS unsigned char* lds, const Gemm g, const Sched& S, const Epi& E) {
    const int tid = threadIdx.x, wid = __builtin_amdgcn_readfirstlane(tid >> 6), lane = tid & 63, wr = wid >> 2, wc = wid & 3, fr = lane & 15, fq = lane >> 4;
    const int K = g.K, nt = K / BK;
    unsigned voffA[2], voffB[2];
#pragma unroll
    for (int i = 0; i < 2; ++i) { int R, C; stage_rc(tid * 16 + i * 8192, R, C); const int Rb = Epi::PERM ? ((R & ~31) + perm32(R & 31)) : R;
        voffA[i] = (unsigned)(R * K + C) * 2u; voffB[i] = (unsigned)(Rb * K + C) * 2u; }
    const size_t kstep = (size_t)(BK * 2);
    const size_t hstep = (size_t)HALF * K * 2;
    const size_t tstep = 2 * hstep;
    const unsigned ldsw = (unsigned)wid * 1024u;
    const int aoff = lds_byte(wr * 64 + fr, fq * 8), boff = lds_byte(wc * 32 + fr, fq * 8);
#define PG8_SA(b, h) (((b) * 2 + (h)) * HTB)
#define PG8_SB(b, h) ((4 + (b) * 2 + (h)) * HTB)
#define PG8_STAGE(bufoff, gbase, voff) do { _Pragma("unroll") for (int _i = 0; _i < 2; ++_i) \
        __builtin_amdgcn_global_load_lds((const unsigned*)((const char*)(gbase) + (voff)[_i]), (PG8_LAS unsigned*)(lds + (bufoff) + ldsw + _i * 8192), 16, 0, 0); } while (0)
#define PG8_LDA(dst, b, h) do { _Pragma("unroll") for (int m = 0; m < 4; ++m) _Pragma("unroll") for (int k = 0; k < 2; ++k) dst[m][k] = *(const PG8_LAS bf16x8*)(lds + PG8_SA(b, h) + aoff + m * 2048 + k * 1024); } while (0)
#define PG8_LDB(dst, b, h) do { _Pragma("unroll") for (int n = 0; n < 2; ++n) _Pragma("unroll") for (int k = 0; k < 2; ++k) dst[n][k] = *(const PG8_LAS bf16x8*)(lds + PG8_SB(b, h) + boff + n * 2048 + k * 1024); } while (0)
#define PG8_MMA(ai, bj, At, Bt) do { __builtin_amdgcn_s_setprio(1); _Pragma("unroll") for (int m = 0; m < 4; ++m) _Pragma("unroll") for (int n = 0; n < 2; ++n) _Pragma("unroll") for (int k = 0; k < 2; ++k) \
        acc[ai][bj][m][n] = __builtin_amdgcn_mfma_f32_16x16x32_bf16(Bt[n][k], At[m][k], acc[ai][bj][m][n], 0, 0, 0); __builtin_amdgcn_s_setprio(0); } while (0)
#define PG8_WAIT_V(n) asm volatile("s_waitcnt vmcnt(" #n ")" ::: "memory")
#define PG8_WAIT_L(n) asm volatile("s_waitcnt lgkmcnt(" #n ")" ::: "memory")
#define PG8_BAR __builtin_amdgcn_s_barrier()
#define PG8_SCHED __builtin_amdgcn_sched_barrier(0)
    Unit cur, nxt; int ui = 0;
    if (!S.next(0, cur)) return;
    f32x4 acc[2][2][4][2];
#pragma unroll
    for (int a = 0; a < 2; ++a)
#pragma unroll
        for (int b = 0; b < 2; ++b)
#pragma unroll
            for (int m = 0; m < 4; ++m)
#pragma unroll
                for (int n = 0; n < 2; ++n) acc[a][b][m][n] = (f32x4){0.f, 0.f, 0.f, 0.f};
    bf16x8 At[4][2], B0[2][2], B1[2][2];
    const char* cA = (const char*)g.A + (size_t)cur.pm * tstep; const char* cB = (const char*)g.Bt + (size_t)cur.pn * tstep;
    S.a_ready(cur);
    if constexpr (SP2) {
        PG8_STAGE(PG8_SB(0, 0), cB, voffB); PG8_STAGE(PG8_SB(0, 1), cB + hstep, voffB); PG8_STAGE(PG8_SA(0, 0), cA, voffA); PG8_STAGE(PG8_SA(0, 1), cA + hstep, voffA);
        if (wr == 1) PG8_BAR;
        PG8_WAIT_V(2); PG8_BAR;
        PG8_STAGE(PG8_SB(1, 0), cB + kstep, voffB); PG8_STAGE(PG8_SA(1, 0), cA + kstep, voffA); PG8_STAGE(PG8_SB(1, 1), cB + hstep + kstep, voffB);
        PG8_WAIT_V(6); PG8_BAR;
    } else {
        PG8_STAGE(PG8_SB(0, 0), cB, voffB); PG8_STAGE(PG8_SA(0, 0), cA, voffA); PG8_STAGE(PG8_SB(0, 1), cB + hstep, voffB); PG8_STAGE(PG8_SA(0, 1), cA + hstep, voffA);
        if (wr == 1) PG8_BAR;
        PG8_WAIT_V(4); PG8_BAR;
        PG8_STAGE(PG8_SB(1, 0), cB + kstep, voffB); PG8_STAGE(PG8_SA(1, 0), cA + kstep, voffA); PG8_STAGE(PG8_SB(1, 1), cB + hstep + kstep, voffB);
        PG8_WAIT_V(6); PG8_BAR;
    }
    for (;;) {
        const bool has_next = S.next(ui + 1, nxt);
        const char* nA = has_next ? (const char*)g.A + (size_t)nxt.pm * tstep : cA; const char* nB = has_next ? (const char*)g.Bt + (size_t)nxt.pn * tstep : cB;
        for (int t = 0; t < nt; t += 2) {
            const bool last = (t == nt - 2);
            const char* a1 = cA + (size_t)(t + 1) * kstep;
            const char* a2 = last ? nA : cA + (size_t)(t + 2) * kstep; const char* b2 = last ? nB : cB + (size_t)(t + 2) * kstep;
            const char* a3 = a2 + kstep; const char* b3 = b2 + kstep;
            if (last && has_next) S.a_ready(nxt);
            if constexpr (SP2) {
            PG8_LDB(B0, 0, 0); PG8_LDB(B1, 0, 1); PG8_SCHED; PG8_LDA(At, 0, 0); PG8_STAGE(PG8_SA(1, 1), a1 + hstep, voffA);
            PG8_WAIT_V(8); PG8_WAIT_L(0); PG8_BAR; PG8_MMA(0, 0, At, B0); PG8_MMA(0, 1, At, B1); PG8_BAR; PG8_SCHED;
            PG8_LDA(At, 0, 1); PG8_STAGE(PG8_SB(0, 0), b2, voffB); PG8_STAGE(PG8_SB(0, 1), b2 + hstep, voffB); PG8_STAGE(PG8_SA(0, 0), a2, voffA);
            PG8_WAIT_V(8); PG8_WAIT_L(0); PG8_BAR; PG8_MMA(1, 0, At, B0); PG8_MMA(1, 1, At, B1); PG8_BAR; PG8_SCHED;
            PG8_LDB(B0, 1, 0); PG8_LDB(B1, 1, 1); PG8_SCHED; PG8_LDA(At, 1, 0); PG8_STAGE(PG8_SA(0, 1), a2 + hstep, voffA);
            PG8_WAIT_V(8); PG8_WAIT_L(0); PG8_BAR; PG8_MMA(0, 0, At, B0); PG8_MMA(0, 1, At, B1); PG8_BAR; PG8_SCHED;
            PG8_LDA(At, 1, 1); PG8_STAGE(PG8_SB(1, 0), b3, voffB); PG8_STAGE(PG8_SB(1, 1), b3 + hstep, voffB); PG8_STAGE(PG8_SA(1, 0), a3, voffA);
            PG8_WAIT_V(8); PG8_WAIT_L(0); PG8_BAR; PG8_MMA(1, 0, At, B0); PG8_MMA(1, 1, At, B1); PG8_BAR; PG8_SCHED;
            } else {
            PG8_LDB(B0, 0, 0); PG8_SCHED; PG8_LDA(At, 0, 0); PG8_STAGE(PG8_SA(1, 1), a1 + hstep, voffA);
            PG8_WAIT_L(8); PG8_BAR; PG8_WAIT_L(0); PG8_MMA(0, 0, At, B0); PG8_BAR; PG8_SCHED;
            PG8_LDB(B1, 0, 1); PG8_STAGE(PG8_SB(0, 0), b2, voffB);
            PG8_BAR; PG8_WAIT_L(0); PG8_MMA(0, 1, At, B1); PG8_BAR;
            PG8_LDA(At, 0, 1); PG8_STAGE(PG8_SA(0, 0), a2, voffA);
            PG8_BAR; PG8_WAIT_L(0); PG8_MMA(1, 0, At, B0); PG8_BAR; PG8_SCHED;
            PG8_STAGE(PG8_SB(0, 1), b2 + hstep, voffB);
            PG8_WAIT_V(6); PG8_BAR; PG8_MMA(1, 1, At, B1); PG8_BAR;
            PG8_LDB(B0, 1, 0); PG8_SCHED; PG8_LDA(At, 1, 0); PG8_STAGE(PG8_SA(0, 1), a2 + hstep, voffA);
            PG8_WAIT_L(8); PG8_BAR; PG8_WAIT_L(0); PG8_MMA(0, 0, At, B0); PG8_BAR; PG8_SCHED;
            PG8_LDB(B1, 1, 1); PG8_STAGE(PG8_SB(1, 0), b3, voffB);
            PG8_BAR; PG8_WAIT_L(0); PG8_MMA(0, 1, At, B1); PG8_BAR;
            PG8_LDA(At, 1, 1); PG8_STAGE(PG8_SA(1, 0), a3, voffA);
            PG8_BAR; PG8_WAIT_L(0); PG8_MMA(1, 0, At, B0); PG8_BAR; PG8_SCHED;
            PG8_STAGE(PG8_SB(1, 1), b3 + hstep, voffB);
            PG8_WAIT_V(6); PG8_BAR; PG8_MMA(1, 1, At, B1); PG8_BAR;
            }
        }
        if constexpr (ALIGN_EPI) { if (wr == 0) PG8_BAR; }
        if constexpr (!Epi::AFTER_DRAIN) { E(acc, cur, wr, wc, fr, fq); S.done(cur); }
        if (!has_next) break;
#pragma unroll
        for (int a = 0; a < 2; ++a)
#pragma unroll
            for (int b = 0; b < 2; ++b)
#pragma unroll
                for (int m = 0; m < 4; ++m)
#pragma unroll
                    for (int n = 0; n < 2; ++n) acc[a][b][m][n] = (f32x4){0.f, 0.f, 0.f, 0.f};
        cur = nxt; cA = nA; cB = nB; ++ui;
        if constexpr (ALIGN_EPI) { if (wr == 1) PG8_BAR; }
    }
    PG8_WAIT_V(0);
    if constexpr (!ALIGN_EPI) { if (wr == 0) PG8_BAR; }
    PG8_BAR;
    if constexpr (Epi::AFTER_DRAIN) { E.fused(acc, cur, wr, wc, fr, fq, lds, wid, lane); S.done(cur); }
#undef PG8_SA
#undef PG8_SB
#undef PG8_STAGE
#undef PG8_LDA
#undef PG8_LDB
#undef PG8_MMA
#undef PG8_WAIT_V
#undef PG8_WAIT_L
#undef PG8_BAR
#undef PG8_SCHED
}
}
#include <hip/hip_bf16.h>
#include <cmath>
namespace attn_body {
using bf16=__hip_bfloat16;
using bf16x8=__attribute__((ext_vector_type(8)))short;
using s16x4=__attribute__((ext_vector_type(4)))short;
using f32x16=__attribute__((ext_vector_type(16)))float;
using u32x4=__attribute__((ext_vector_type(4)))unsigned;
constexpr int BATCH=8,NHEAD=8,SEQ=2048,D=64,DM=NHEAD*D,OPITCH=1024;
constexpr int NW=8,QBLK=32,QB=QBLK*NW,KVBLK=64,NQB=SEQ/QB;
constexpr int ATTN_PITCH=DM, ATTN_UNIT_ROWS=QB;
__device__ __forceinline__ int crow(int r,int hi){return (r&3)+8*(r>>2)+4*hi;}
#define SBAR() __builtin_amdgcn_sched_barrier(0)
__device__ __forceinline__ void cmask(f32x16&p0,f32x16&p1,int jb,int qrel,int hi){
  const float NEG=-INFINITY; int kb=64*jb+4*hi;
  #pragma unroll
  for(int r=0;r<16;++r){int kv=kb+(r&3)+8*(r>>2); if(kv>qrel)p0[r]=NEG; if(kv+32>qrel)p1[r]=NEG;}
}

constexpr int NSLOT=3, SLOTB=8192;
constexpr int LDS_K=0, LDS_V=NSLOT*SLOTB, LDS_WS=2*NSLOT*SLOTB, LDS_OST=LDS_WS+NW*64*4, LDS_KB=LDS_OST+NW*4096, LDS_BYTES=LDS_KB+SEQ*16;
constexpr float C2=0.125f*1.4426950408889634f;
__device__ __forceinline__ void glds16(const void*gsrc,unsigned lds_dst){unsigned keep;
  asm volatile("s_mov_b32 %0, m0\n\ts_mov_b32 m0, %2\n\ts_nop 0\n\tglobal_load_lds_dwordx4 %1, off\n\ts_mov_b32 m0, %0":"=&s"(keep):"v"(gsrc),"s"(lds_dst):"memory");}
__device__ __forceinline__ float max3f(float a,float b,float c){float r;asm("v_max3_f32 %0, %1, %2, %3":"=v"(r):"v"(a),"v"(b),"v"(c));return r;}
__device__ __forceinline__ float max2f(float a,float b){float r;asm("v_max_f32_e32 %0, %1, %2":"=v"(r):"v"(a),"v"(b));return r;}
__device__ __forceinline__ float fadd_s(float a,float b){float r;asm("v_add_f32_e32 %0, %1, %2":"=v"(r):"v"(a),"v"(b));return r;}
__device__ __forceinline__ float fsub_s(float a,float b){float r;asm("v_sub_f32_e32 %0, %1, %2":"=v"(r):"v"(a),"v"(b));return r;}
typedef float f32x2_t __attribute__((ext_vector_type(2))); typedef __bf16 bf16x2_t __attribute__((ext_vector_type(2)));
__device__ __forceinline__ unsigned cvtpk_s(float lo,float hi){f32x2_t v={lo,hi};bf16x2_t b=__builtin_convertvector(v,bf16x2_t);return __builtin_bit_cast(unsigned,b);}
#define WAIT_BAR(N) asm volatile("s_waitcnt vmcnt(" #N ") lgkmcnt(0)\n\ts_barrier":::"memory")

__device__ __forceinline__ void qkt(f32x16&p0,f32x16&p1,const char*Kslot,const bf16x8*qr,const bf16x8 ka0,const bf16x8 ka1,const bf16x8 qbf,int r32,int hi){
  p0=__builtin_amdgcn_mfma_f32_32x32x16_bf16(ka0,qbf,f32x16{},0,0,0);p1=__builtin_amdgcn_mfma_f32_32x32x16_bf16(ka1,qbf,f32x16{},0,0,0);
  const char*kb=Kslot+hi*1024+r32*16;
  #pragma unroll
  for(int d0=0;d0<4;++d0){
    const bf16x8 b0=*reinterpret_cast<const bf16x8*>(kb+d0*2048);
    const bf16x8 b1=*reinterpret_cast<const bf16x8*>(kb+d0*2048+512);
    p0=__builtin_amdgcn_mfma_f32_32x32x16_bf16(b0,qr[d0],p0,0,0,0);p1=__builtin_amdgcn_mfma_f32_32x32x16_bf16(b1,qr[d0],p1,0,0,0);}
}
typedef __attribute__((address_space(3))) const char* lds_cptr;
typedef short v4i16_t __attribute__((ext_vector_type(4)));
__device__ __forceinline__ void kload8(bf16x8*kf,lds_cptr kp){
  kf[0]=*(const __attribute__((address_space(3))) bf16x8*)(kp);      kf[1]=*(const __attribute__((address_space(3))) bf16x8*)(kp+512);
  kf[2]=*(const __attribute__((address_space(3))) bf16x8*)(kp+2048); kf[3]=*(const __attribute__((address_space(3))) bf16x8*)(kp+2560);
  kf[4]=*(const __attribute__((address_space(3))) bf16x8*)(kp+4096); kf[5]=*(const __attribute__((address_space(3))) bf16x8*)(kp+4608);
  kf[6]=*(const __attribute__((address_space(3))) bf16x8*)(kp+6144); kf[7]=*(const __attribute__((address_space(3))) bf16x8*)(kp+6656);
}
__device__ __forceinline__ void kload2(bf16x8*kf,lds_cptr kp,int j){ kf[2*j]=*(const __attribute__((address_space(3))) bf16x8*)(kp+j*2048); kf[2*j+1]=*(const __attribute__((address_space(3))) bf16x8*)(kp+j*2048+512); }
__device__ __forceinline__ s16x4 vtr(lds_cptr p){ return __builtin_bit_cast(s16x4,__builtin_amdgcn_ds_read_tr16_b64_v4i16((__attribute__((address_space(3))) v4i16_t*)p)); }
__device__ __forceinline__ float rowmax(const f32x16&p0,const f32x16&p1){
  float a=max3f(p0[0],p0[1],p1[0]),b=max3f(p0[2],p0[3],p1[1]);a=max3f(a,p1[2],p1[3]);
  #pragma unroll
  for(int r=4;r<16;r+=4){a=max3f(a,p0[r],p0[r+1]);b=max3f(b,p0[r+2],p0[r+3]);a=max3f(a,p1[r],p1[r+1]);b=max3f(b,p1[r+2],p1[r+3]);}
  const float m=max2f(a,b);
  auto rr=__builtin_amdgcn_permlane32_swap(__float_as_uint(m),__float_as_uint(m),false,false);
  return max2f(__uint_as_float(rr[0]),__uint_as_float(rr[1]));
}
__device__ __forceinline__ void pv(f32x16*o,int vb,bf16x8 pa0,bf16x8 pa1,bf16x8 pa2,bf16x8 pa3){
  #pragma unroll
  for(int d0=0;d0<2;++d0){s16x4 lo[4],hi[4];
    #pragma unroll
    for(int ks=0;ks<4;++ks){
      asm volatile("ds_read_b64_tr_b16 %0,%1 offset:%c2":"=&v"(lo[ks]):"v"(vb),"i"(d0*4096+ks*1024):"memory");
      asm volatile("ds_read_b64_tr_b16 %0,%1 offset:%c2":"=&v"(hi[ks]):"v"(vb),"i"(d0*4096+ks*1024+512):"memory");}
    asm volatile("s_waitcnt lgkmcnt(0)":::"memory");SBAR();
    #define PK(k) (bf16x8){lo[k][0],lo[k][1],lo[k][2],lo[k][3],hi[k][0],hi[k][1],hi[k][2],hi[k][3]}
    o[d0]=__builtin_amdgcn_mfma_f32_32x32x16_bf16(pa0,PK(0),o[d0],0,0,0);
    o[d0]=__builtin_amdgcn_mfma_f32_32x32x16_bf16(pa1,PK(1),o[d0],0,0,0);
    o[d0]=__builtin_amdgcn_mfma_f32_32x32x16_bf16(pa2,PK(2),o[d0],0,0,0);
    o[d0]=__builtin_amdgcn_mfma_f32_32x32x16_bf16(pa3,PK(3),o[d0],0,0,0);
    #undef PK
  }
}

#ifndef ATTN_STORE16
#define ATTN_STORE16(p,v) (*(u32x4*)(p)=(v))
#endif
__device__ __forceinline__ unsigned bfbits(float f){unsigned u=__builtin_bit_cast(unsigned,f);return (u+0x7fffu+((u>>16)&1u))>>16;}
__device__ __forceinline__ void split3(float x,unsigned&h1,unsigned&h2,unsigned&h3){h1=bfbits(x);const float r1=x-__uint_as_float(h1<<16);h2=bfbits(r1);const float r2=r1-__uint_as_float(h2<<16);h3=bfbits(r2);}
template<int THRL> __device__ __forceinline__ void attn_unit(int b,int h,int qb,const bf16*Q,const bf16*__restrict__ K,const bf16*__restrict__ V,bf16*O,const float*cumbh,const float*gnorm,char*shm){
  const int tid=threadIdx.x,lane=tid&63,r32=lane&31,hi=lane>>5; const int wid=__builtin_amdgcn_readfirstlane(tid>>6);
  const long rowbase=(long)b*SEQ; const int q0=qb*QB;
  const bf16*Qw=Q+(rowbase+q0+wid*QBLK)*DM+h*D;
  const bf16*Kh=K+rowbase*DM+h*D,*Vh=V+rowbase*DM+h*D;
  const unsigned lds0=(unsigned)(uintptr_t)shm;
  float*wsf=(float*)(shm+LDS_WS)+wid*64;
  { const float cref=cumbh[q0]; u32x4*kbw=(u32x4*)(shm+LDS_KB);
    for(int i=tid;i<q0+QB;i+=NW*64){ const float kb=(cref-cumbh[i])*1.4426950408889634f; unsigned h1,h2,h3; split3(kb,h1,h2,h3); kbw[i]=(u32x4){h1|(h2<<16),h3|0x3F800000u,0x3F803F80u,0u}; } }
  const bf16*ksrc=Kh+(long)lane*DM+wid*8;
  const bf16*vsrc=Vh+(long)(16*(wid&3)+(lane>>2))*DM+(wid>>2)*32+(lane&3)*8;
  const unsigned kdst=lds0+LDS_K+wid*1024, vdst=lds0+LDS_V+wid*1024;
  #define DMA_K(t,slot) glds16(ksrc+(long)(t)*KVBLK*DM,(unsigned)__builtin_amdgcn_readfirstlane(kdst+(slot)))
  #define DMA_V(t,slot) glds16(vsrc+(long)(t)*KVBLK*DM,(unsigned)__builtin_amdgcn_readfirstlane(vdst+(slot)))
  const int vb0=(int)(lds0+LDS_V)+((lane>>4)&1)*32+(lane&3)*8+(4*hi+((lane&15)>>2))*64;
  const char*Kbase=shm+LDS_K; bf16x8 kf[8];
  const lds_cptr shm3=(lds_cptr)shm; const lds_cptr kp0=shm3+LDS_K+hi*1024+r32*16; const lds_cptr vp0=shm3+LDS_V+((lane>>4)&1)*32+(lane&3)*8+(4*hi+((lane&15)>>2))*64;
  const int NT=(q0+QB)/KVBLK;
  DMA_K(0,0);DMA_V(0,0);DMA_K(1,SLOTB);
  bf16x8 qr[4];
  #pragma unroll
  for(int d0=0;d0<4;++d0)qr[d0]=*reinterpret_cast<const bf16x8*>(&Qw[(long)r32*DM+d0*16+hi*8]);
  float mhat=0.f,l_reg=0.f;f32x16 o[2];o[0]=f32x16{};o[1]=f32x16{};u32x4 qbw=(u32x4){hi?0u:0x3F803F80u,hi?0u:0x3F80u,0u,0u};
  const lds_cptr kbp0=(lds_cptr)shm+LDS_KB+r32*16;
  #define QBF __builtin_bit_cast(bf16x8,qbw)
  #define KBLD(t,p) (*(const __attribute__((address_space(3))) bf16x8*)(kbp0+((t)*64+(p)*32)*16))
  #define SETQB() do{ unsigned h1_,h2_,h3_; split3(-mhat,h1_,h2_,h3_); qbw[1]=hi?0u:(0x3F80u|(h1_<<16)); qbw[2]=hi?0u:(h2_|(h3_<<16)); asm volatile("":"+v"(qbw)); }while(0)
  const int qrel=wid*QBLK+r32;
  #define CMASK(P0,P1,t) do{int jb_=(t)-(NT-4); if(jb_>=0)cmask(P0,P1,jb_,qrel,hi);}while(0)
  bool resc=false;
  #define START(P0,P1) do{ const float rm=rowmax(P0,P1); resc=false; \
    { const float dl=rm; mhat=fadd_s(mhat,dl); \
      _Pragma("unroll") for(int r=0;r<16;++r){P0[r]=fsub_s(P0[r],dl);P1[r]=fsub_s(P1[r],dl);} \
      SETQB(); } \
    _Pragma("unroll") for(int r=0;r<16;++r)P0[r]=__builtin_amdgcn_exp2f(P0[r]); }while(0)
  #define RESC() do{ if(resc){ asm volatile("s_waitcnt lgkmcnt(0)":::"memory"); \
      _Pragma("unroll") for(int d_=0;d_<2;++d_) _Pragma("unroll") for(int r=0;r<16;++r)o[d_][r]*=wsf[crow(r,hi)]; } }while(0)
  f32x16 pA0,pA1,pB0,pB1;
  int sl_prev=0,sl_cur=0,sl_next=SLOTB;
  #define ROT() do{sl_prev=sl_cur;sl_cur=sl_next;sl_next=(sl_next==(NSLOT-1)*SLOTB)?0:sl_next+SLOTB;}while(0)
  DMA_K(2,2*SLOTB);
  WAIT_BAR(3);
  qkt(pA0,pA1,Kbase,qr,KBLD(0,0),KBLD(0,1),QBF,r32,hi);asm volatile("s_nop 15\n\ts_nop 7":"+v"(pA0),"+v"(pA1));CMASK(pA0,pA1,0);
  START(pA0,pA1);
  _Pragma("unroll") for(int r=0;r<16;++r)pA1[r]=__builtin_amdgcn_exp2f(pA1[r]);
  WAIT_BAR(0);
  DMA_K(3,0);DMA_V(1,SLOTB);
  ROT();
  kload8(kf,kp0+sl_cur);
  WAIT_BAR(2);
  s16x4 vlo[8],vhi[8]; u32x4 pw0,pw1,pw2,pw3;
  #define PKW(P,B) cvtpk_s(P[B],P[B+1])
  #define PAF(k) __builtin_bit_cast(bf16x8,pw##k)
  #define VFR(i) (bf16x8){vlo[i][0],vlo[i][1],vlo[i][2],vlo[i][3],vhi[i][0],vhi[i][1],vhi[i][2],vhi[i][3]}
  #define PIN(x) asm volatile("":"+v"(x))
  #define MX3(a,b,c) __builtin_fmaxf(__builtin_fmaxf((a),(b)),(c))
  #define GAPA(MF,A0,A1,A2,A3,W0,W1,PW) do{ MF; sacc+=A0; sacc+=A1; sacc+=A2; sacc+=A3; PIN(sacc); W0; W1; PIN(PW); SBAR(); }while(0)
  #define EX(v) __builtin_amdgcn_exp2f(v)
  #define GAPB(MF,X,B) do{ MF; X[B]=EX(X[B]); X[B+1]=EX(X[B+1]); X[B+2]=EX(X[B+2]); X[B+3]=EX(X[B+3]); PIN(X); SBAR(); }while(0)
  #define VRD(i) do{ vlo[i]=vtr(vp_+(((i)>>2)*4096+((i)&3)*1024)); vhi[i]=vtr(vp_+(((i)>>2)*4096+((i)&3)*1024+512)); }while(0)
  #define KRD(G,j) do{ if(G){ kload2(kf,kp0+sl_next,j); SBAR(); } }while(0)
  #define STEP(C0,C1,P0,P1,t,GK,GV,GL) do{ SBAR(); \
    const lds_cptr vp_=vp0+sl_prev; \
    { const bf16x8 ka0_=KBLD(t,0), ka1_=KBLD(t,1); VRD(0); SBAR(); \
      C0=__builtin_amdgcn_mfma_f32_32x32x16_bf16(ka0_,QBF,f32x16{},0,0,0); C1=__builtin_amdgcn_mfma_f32_32x32x16_bf16(ka1_,QBF,f32x16{},0,0,0); SBAR(); } \
    float sacc=(P0[0]+P0[1]); \
    GAPA(C0=__builtin_amdgcn_mfma_f32_32x32x16_bf16(kf[0],qr[0],C0,0,0,0), P0[2],P0[3],P0[4],P0[5],     pw0[0]=PKW(P0,0), pw0[1]=PKW(P0,2), pw0); \
    VRD(4); SBAR(); GAPA(C1=__builtin_amdgcn_mfma_f32_32x32x16_bf16(kf[1],qr[0],C1,0,0,0), P0[6],P0[7],P0[8],P0[9],     pw0[2]=PKW(P0,4), pw0[3]=PKW(P0,6), pw0); \
    VRD(1); SBAR(); GAPA(C0=__builtin_amdgcn_mfma_f32_32x32x16_bf16(kf[2],qr[1],C0,0,0,0),   P0[10],P0[11],P0[12],P0[13], pw1[0]=PKW(P0,8), pw1[1]=PKW(P0,10), pw1); \
    VRD(5); SBAR(); GAPA(C1=__builtin_amdgcn_mfma_f32_32x32x16_bf16(kf[3],qr[1],C1,0,0,0),   P0[14],P0[15],P1[0],P1[1],   pw1[2]=PKW(P0,12),pw1[3]=PKW(P0,14), pw1); \
    VRD(2); SBAR(); GAPA(C0=__builtin_amdgcn_mfma_f32_32x32x16_bf16(kf[4],qr[2],C0,0,0,0),   P1[2],P1[3],P1[4],P1[5],     pw2[0]=PKW(P1,0), pw2[1]=PKW(P1,2), pw2); \
    VRD(6); SBAR(); GAPA(C1=__builtin_amdgcn_mfma_f32_32x32x16_bf16(kf[5],qr[2],C1,0,0,0),   P1[6],P1[7],P1[8],P1[9],     pw2[2]=PKW(P1,4), pw2[3]=PKW(P1,6), pw2); \
    VRD(3); SBAR(); GAPA(C0=__builtin_amdgcn_mfma_f32_32x32x16_bf16(kf[6],qr[3],C0,0,0,0),   P1[10],P1[11],P1[12],P1[13], pw3[0]=PKW(P1,8), pw3[1]=PKW(P1,10), pw3); \
    VRD(7); SBAR(); GAPA(C1=__builtin_amdgcn_mfma_f32_32x32x16_bf16(kf[7],qr[3],C1,0,0,0),   P1[14],P1[15],0.f,0.f,       pw3[2]=PKW(P1,12),pw3[3]=PKW(P1,14), pw3); \
    l_reg+=sacc; \
    if(GK){DMA_K((t)+3,sl_cur);} if(GV){DMA_V((t)+1,sl_next);} \
    CMASK(C0,C1,t); \
    { float a=MX3(C0[0],C0[1],C1[0]),b=MX3(C0[2],C0[3],C1[1]); a=MX3(a,C1[2],C1[3]); \
      _Pragma("unroll") for(int r=4;r<16;r+=4){a=MX3(a,C0[r],C0[r+1]);b=MX3(b,C0[r+2],C0[r+3]);a=MX3(a,C1[r],C1[r+1]);b=MX3(b,C1[r+2],C1[r+3]);} \
      float rm=__builtin_fmaxf(a,b); { auto rr=__builtin_amdgcn_permlane32_swap(__float_as_uint(rm),__float_as_uint(rm),false,false); rm=__builtin_fmaxf(__uint_as_float(rr[0]),__uint_as_float(rr[1])); } \
      resc=false; \
      if(__builtin_expect(__any(rm>(float)THRL),0)){ const float dl=__builtin_fmaxf(rm,0.f); mhat+=dl; \
        _Pragma("unroll") for(int r=0;r<16;++r){C0[r]-=dl;C1[r]-=dl;} \
        SETQB(); \
        const float f=__builtin_amdgcn_exp2f(-dl); l_reg*=f; if(hi==0)wsf[r32]=f; resc=true; } } \
    SBAR(); \
    GAPB(o[0]=__builtin_amdgcn_mfma_f32_32x32x16_bf16(PAF(0),VFR(0),o[0],0,0,0), C0,0); \
    GAPB(o[1]=__builtin_amdgcn_mfma_f32_32x32x16_bf16(PAF(0),VFR(4),o[1],0,0,0), C0,4); \
    KRD(GL,0); GAPB(o[0]=__builtin_amdgcn_mfma_f32_32x32x16_bf16(PAF(1),VFR(1),o[0],0,0,0), C0,8); \
    KRD(GL,1); GAPB(o[1]=__builtin_amdgcn_mfma_f32_32x32x16_bf16(PAF(1),VFR(5),o[1],0,0,0), C0,12); \
    KRD(GL,2); GAPB(o[0]=__builtin_amdgcn_mfma_f32_32x32x16_bf16(PAF(2),VFR(2),o[0],0,0,0), C1,0); \
    KRD(GL,3); GAPB(o[1]=__builtin_amdgcn_mfma_f32_32x32x16_bf16(PAF(2),VFR(6),o[1],0,0,0), C1,4); \
    GAPB(o[0]=__builtin_amdgcn_mfma_f32_32x32x16_bf16(PAF(3),VFR(3),o[0],0,0,0), C1,8); \
    GAPB(o[1]=__builtin_amdgcn_mfma_f32_32x32x16_bf16(PAF(3),VFR(7),o[1],0,0,0), C1,12); \
    }while(0)
  int t=1;
  #undef CMASK
  #define CMASK(P0,P1,t) do{}while(0)
  for(;t+5<NT;t+=2){
    STEP(pB0,pB1,pA0,pA1,t,true,true,true);     WAIT_BAR(2); RESC(); ROT();
    STEP(pA0,pA1,pB0,pB1,t+1,true,true,true);   WAIT_BAR(2); RESC(); ROT();
  }
  #undef CMASK
  #define CMASK(P0,P1,t) do{int jb_=(t)-(NT-4); if(jb_>=0)cmask(P0,P1,jb_,qrel,hi);}while(0)
  #define ENDW(tt) do{ if((tt)+3<NT){WAIT_BAR(2);} else if((tt)+2<NT){WAIT_BAR(1);} else {WAIT_BAR(0);} }while(0)
  for(;t+1<NT;t+=2){
    STEP(pB0,pB1,pA0,pA1,t,(t+3<NT),(t+1<NT),(t+1<NT));       ENDW(t);   RESC(); ROT();
    STEP(pA0,pA1,pB0,pB1,t+1,(t+4<NT),(t+2<NT),(t+2<NT));     ENDW(t+1); RESC(); ROT();
  }
  STEP(pB0,pB1,pA0,pA1,NT-1,false,false,false); RESC();
  { float sacc=pB0[0]+pB0[1]; _Pragma("unroll") for(int r=2;r<16;++r)sacc+=pB0[r]; _Pragma("unroll") for(int r=0;r<16;++r)sacc+=pB1[r]; l_reg+=sacc;
    pw0=(u32x4){PKW(pB0,0),PKW(pB0,2),PKW(pB0,4),PKW(pB0,6)};pw1=(u32x4){PKW(pB0,8),PKW(pB0,10),PKW(pB0,12),PKW(pB0,14)};pw2=(u32x4){PKW(pB1,0),PKW(pB1,2),PKW(pB1,4),PKW(pB1,6)};pw3=(u32x4){PKW(pB1,8),PKW(pB1,10),PKW(pB1,12),PKW(pB1,14)};
    SBAR(); pv(o,vb0+sl_cur,PAF(0),PAF(1),PAF(2),PAF(3)); }
  #undef PKW
  #undef PAF
  #undef VFR
  #undef PIN
  #undef MX3
  #undef GAPA
  #undef GAPB
  #undef EX
  #undef VRD
  #undef KRD
  #undef STEP
  #undef ENDW
  {auto rr=__builtin_amdgcn_permlane32_swap(__float_as_uint(l_reg),__float_as_uint(l_reg),false,false);l_reg=__uint_as_float(rr[0])+__uint_as_float(rr[1]);}
  if(hi==0)wsf[32+r32]=l_reg;asm volatile("s_waitcnt lgkmcnt(0)":::"memory");
  float rli[16];
  #pragma unroll
  for(int r=0;r<16;++r)rli[r]=__builtin_amdgcn_rcpf(wsf[32+crow(r,hi)]);
  bf16*Ow=O+(rowbase+q0+wid*QBLK)*OPITCH+h*D;
  float gn[8];
  #pragma unroll
  for(int j=0;j<8;++j)gn[j]=gnorm[(lane&7)*8+j];
  { bf16*stg=(bf16*)(shm+LDS_OST)+wid*2048;
    #pragma unroll
    for(int r=0;r<16;++r){const int orow=crow(r,hi);
      #pragma unroll
      for(int d0=0;d0<2;++d0)stg[orow*64+d0*32+r32]=__float2bfloat16(o[d0][r]*rli[r]);}
    asm volatile("s_waitcnt lgkmcnt(0)":::"memory");
    #pragma unroll
    for(int i=0;i<4;++i){const int row=i*8+(lane>>3),ch=lane&7; const u32x4 v=*(const u32x4*)(stg+row*64+ch*8);
      float f[8];
      #pragma unroll
      for(int j=0;j<4;++j){f[2*j]=__uint_as_float(v[j]<<16);f[2*j+1]=__uint_as_float(v[j]&0xffff0000u);}
      float ss=0.f;
      #pragma unroll
      for(int j=0;j<8;++j)ss+=f[j]*f[j];
      ss+=__shfl_xor(ss,1);ss+=__shfl_xor(ss,2);ss+=__shfl_xor(ss,4);
      const float rs=__builtin_amdgcn_rsqf(ss*(1.f/64.f)+1e-6f);
      u32x4 w;
      #pragma unroll
      for(int j=0;j<4;++j)w[j]=cvtpk_s(f[2*j]*rs*gn[2*j],f[2*j+1]*rs*gn[2*j+1]);
      ATTN_STORE16(Ow+(long)row*OPITCH+ch*8,w);} }
  asm volatile("s_waitcnt lgkmcnt(0)\n\ts_barrier":::"memory");
  #undef DMA_K
  #undef DMA_V
  #undef QBF
  #undef KBLD
  #undef SETQB
  #undef CMASK
  #undef START
  #undef RESC
  #undef ROT
}
constexpr int ATTN_LDS_BYTES=LDS_BYTES;
struct AttnTensors { const bf16* Q; const bf16* K; const bf16* V; bf16* O; const float* cum; const float* gnorm; };
struct AttnUnit { int bh; int qb; };
struct StaticOrder {
  int vcu;
  __device__ __forceinline__ explicit StaticOrder(int grid,int block):vcu((block%8)*(grid/8)+block/8){}
  __device__ __forceinline__ bool next(int i,AttnUnit&u)const{ if(i>=2)return false; const int s=vcu&3; u.bh=vcu>>2; u.qb=(i==0)?7-s:s; return true; }
  __device__ __forceinline__ void a_ready(const AttnUnit&)const{}
  __device__ __forceinline__ void done(const AttnUnit&)const{}
};
template<class Sched,int THRL=8> __device__ __forceinline__ void attn_phase(char*lds,const AttnTensors&T,const Sched&S){
  AttnUnit u;
  for(int i=0;S.next(i,u);++i){ S.a_ready(u); attn_unit<THRL>(u.bh/NHEAD,u.bh%NHEAD,u.qb,T.Q,T.K,T.V,T.O,T.cum+(long)u.bh*SEQ,T.gnorm,lds); S.done(u); }
}
#undef SBAR
#undef WAIT_BAR
}
#ifndef PG8_SP2
#define PG8_SP2 true
#endif
#ifndef PG8_ALIGN
#define PG8_ALIGN true
#endif
constexpr int NWAVES = 8;
constexpr int NB = 8, SEQ = 2048, D = 1024, M = NB * SEQ, FF = 4096;
constexpr int HF = 8, HG = 4;
constexpr int DPROJ = 3600, NPROJ = 3840;
constexpr float EPS = 1e-6f;
constexpr float LOG2E = 1.4426950408889634f;
constexpr float QSCALE = 0.125f * LOG2E;
constexpr int C_FF = 1536, C_GQ = 1544, C_GB = 3080, C_GA = 3084, C_GZ = 3088;
constexpr size_t MiB = 1u << 20;
constexpr size_t WS_CTL = 0, CTL_ZERO_BYTES = 1 * MiB;
constexpr size_t WS_WIN = 2 * MiB, WS_WOUT = 10 * MiB, WS_WUP = 12 * MiB, WS_WDN = 20 * MiB;
constexpr size_t WS_X = 28 * MiB;
constexpr size_t WS_XN = 32 * MiB;
constexpr size_t WS_FQ = 64 * MiB, WS_G512 = 16 * MiB;
constexpr size_t WS_SMALL = 176 * MiB;
constexpr size_t WS_CUM = 177 * MiB;
constexpr size_t WS_BETA = 178 * MiB, WS_GDEC = 178 * MiB + 512 * 1024;
constexpr size_t WS_MIXED = 192 * MiB;
constexpr size_t WS_H = 64 * MiB;
constexpr size_t WS_MIXOUT = 64 * MiB;
constexpr size_t WS_Y = 192 * MiB;
constexpr size_t WS_END = 256 * MiB;
constexpr int CW_TMO = 0, CW_CODE = 1;
constexpr int CW_BAR = 4096;
constexpr int CW_SEAM = 16384, SEAM_BANK = 128 * 64;
constexpr int RING_OFF = 0, RING_BYTES = 131072;
constexpr int LDSCTL_OFF = RING_BYTES, MISC_OFF = LDSCTL_OFF + 320;
constexpr int LDS_BYTES = 147456;
#define GAS __attribute__((address_space(1)))
#define LAS __attribute__((address_space(3)))
typedef unsigned short bf16;
typedef unsigned v4u __attribute__((ext_vector_type(4)));
typedef float f32x4 __attribute__((ext_vector_type(4)));
typedef short bf16x8 __attribute__((ext_vector_type(8)));
typedef GAS unsigned gu32;
typedef GAS unsigned long long gu64;
#define RLX_AGENT __ATOMIC_RELAXED, __HIP_MEMORY_SCOPE_AGENT
#define LDS_WAIT() asm volatile("s_waitcnt lgkmcnt(0)" ::: "memory")
#define VM_WAIT() asm volatile("s_waitcnt vmcnt(0)" ::: "memory")
__device__ __forceinline__ unsigned long long rt() { return __builtin_amdgcn_s_memrealtime(); }
__device__ __forceinline__ unsigned f2bf(float f) { unsigned u = __builtin_bit_cast(unsigned, f); return (u + 0x7fffu + ((u >> 16) & 1u)) >> 16; }
__device__ __forceinline__ unsigned pk2(float lo, float hi) { return f2bf(lo) | (f2bf(hi) << 16); }

#define XB_TMO      128
#define XB_XCNT(j)  (256  + 64 * (j))
#define XB_XSUB(j)  (1280 + 64 * (j))
#define XB_XGEN(j)  (2304 + 64 * (j))
#define XB_TOP      3328
#define XB_TOPGEN   3392
#define XCD_BAR_WORDS 3456
#define XB_SPIN_CAP (1u << 18)

__device__ __forceinline__ unsigned xb_ld(unsigned* p)              { return __hip_atomic_load(p, __ATOMIC_RELAXED, __HIP_MEMORY_SCOPE_AGENT); }
__device__ __forceinline__ unsigned xb_add(unsigned* p, unsigned v) { return __hip_atomic_fetch_add(p, v, __ATOMIC_RELAXED, __HIP_MEMORY_SCOPE_AGENT); }
__device__ __forceinline__ unsigned xb_xcc_id() { return (unsigned)__builtin_amdgcn_s_getreg((3 << 11) | 20) & 0xFu; }
#define XB_SPIN(cond, bar) do { unsigned _sp = 0; while (cond) { __builtin_amdgcn_s_sleep(1); \
    if ((++_sp & 255u) == 0u) { if (xb_ld(&(bar)[XB_TMO])) break; if (_sp > XB_SPIN_CAP) { atomicAdd(&(bar)[XB_TMO], 1u); break; } } } } while (0)

struct XcdBarrier {
    unsigned* bar; unsigned x;
    volatile LAS unsigned* st;
};

__device__ __forceinline__ XcdBarrier xcd_barrier_post(unsigned* bar, volatile LAS unsigned* st) {
    XcdBarrier b; b.bar = bar; b.x = xb_xcc_id(); b.st = st;
    if (threadIdx.x == 0) (void)xb_add(&bar[XB_XCNT(b.x)], 1u);
    return b;
}
__device__ __forceinline__ void xcd_barrier_complete(unsigned* bar, unsigned x, unsigned& nloc, unsigned& nx) {
    const unsigned G = gridDim.x * gridDim.y * gridDim.z;
    unsigned sum, cnt, mine, sp = 0u;
    for (;;) {
        sum = 0u; cnt = 0u; mine = 0u;
#pragma unroll
        for (unsigned j = 0; j < 16; ++j) { const unsigned c = xb_ld(&bar[XB_XCNT(j)]); sum += c; cnt += (c > 0u) ? 1u : 0u; mine = (j == x) ? c : mine; }
        if (sum == G) break;
        __builtin_amdgcn_s_sleep(1);
        if ((++sp & 255u) == 0u) { if (xb_ld(&bar[XB_TMO])) break; if (sp > XB_SPIN_CAP) { atomicAdd(&bar[XB_TMO], 1u); break; } }
    }
    nloc = mine > 0u ? mine : 1u; nx = cnt > 0u ? cnt : 1u;
}

__device__ __forceinline__ void xcd_barrier(const XcdBarrier& b) {
    asm volatile("s_waitcnt vmcnt(0)" ::: "memory");
    __syncthreads();
    if (threadIdx.x == 0) {
        unsigned* bar = b.bar;
        __builtin_amdgcn_s_waitcnt(0);
        unsigned nloc = b.st[0], nx = b.st[1];
        if (nloc == 0u) { xcd_barrier_complete(bar, b.x, nloc, nx); b.st[0] = nloc; b.st[1] = nx; }
        const unsigned old = xb_add(&bar[XB_XSUB(b.x)], 1u);
        const unsigned gen = old / nloc;
        if (old + 1u == (gen + 1u) * nloc) {
            __builtin_amdgcn_fence(__ATOMIC_RELEASE, "agent");
            asm volatile("s_waitcnt vmcnt(0)" ::: "memory");
            const unsigned og = xb_add(&bar[XB_TOP], 1u);
            const unsigned tg = og / nx;
            if (og + 1u == (tg + 1u) * nx) xb_add(&bar[XB_TOPGEN], 1u);
            else XB_SPIN(xb_ld(&bar[XB_TOPGEN]) == tg, bar);
            __builtin_amdgcn_fence(__ATOMIC_ACQUIRE, "agent");
            xb_add(&bar[XB_XGEN(b.x)], 1u);
            asm volatile("s_waitcnt vmcnt(0)" ::: "memory");
        } else {
            XB_SPIN(xb_ld(&bar[XB_XGEN(b.x)]) == gen, bar);
            __builtin_amdgcn_fence(__ATOMIC_ACQUIRE, "agent");
            asm volatile("s_waitcnt vmcnt(0)" ::: "memory");
        }
    }
    __syncthreads();
}
struct Frame {
    LAS unsigned char* lds;
    volatile LAS unsigned* MISC;
    gu32* ctl;
    int tid, lane, wave;
    int vcu, G;
};
__device__ __forceinline__ float wave_sum(float v) {
#pragma unroll
    for (int o = 1; o < 64; o <<= 1) v += __shfl_xor(v, o);
    return v;
}
__device__ __forceinline__ float bf2f(unsigned short u) { return __uint_as_float((unsigned)u << 16); }
__device__ __forceinline__ int proj_src_col(int n) {
    if (n < 1536) return n;
    if (n < 3072) return n + 8;
    if (n < 3584) return n + 16;
    if (n < 3592) return C_FF + (n - 3584);
    if (n < 3596) return C_GB + (n - 3592);
    if (n < 3600) return C_GA + (n - 3596);
    return -1;
}
template <bool REMAP>
__device__ __forceinline__ void p0_transpose_item(const float* W, int K, int N, int Ndst, bf16* WT, LAS float* scr, int item, int lane) {
    const int nblk = Ndst / 32, kb = item / nblk, nb = item % nblk, k0 = 64 * kb, n0 = 32 * nb;
    const int sc = REMAP ? proj_src_col(n0 + (lane & 31)) : n0 + (lane & 31);
#pragma unroll 8
    for (int i = 0; i < 32; ++i) { const int kk = 2 * i + (lane >> 5); scr[kk * 33 + (lane & 31)] = (sc >= 0) ? W[(size_t)(k0 + kk) * N + sc] : 0.f; }
    LDS_WAIT(); asm volatile("" ::: "memory");
    const int c = lane & 7;
#pragma unroll
    for (int j = 0; j < 4; ++j) { const int n = (lane >> 3) + 8 * j; const LAS float* s = scr + (8 * c) * 33 + n;
        v4u o; o.x = pk2(s[0 * 33], s[1 * 33]); o.y = pk2(s[2 * 33], s[3 * 33]); o.z = pk2(s[4 * 33], s[5 * 33]); o.w = pk2(s[6 * 33], s[7 * 33]);
        *(GAS v4u*)(WT + (size_t)(n0 + n) * K + k0 + 8 * c) = o; }
    LDS_WAIT(); asm volatile("" ::: "memory");
}
__device__ __forceinline__ void rms_row_to_bf16(int lane, const float* xrow, const float* g, bf16* orow) {
    const GAS f32x4* xr = (const GAS f32x4*)xrow + lane; const GAS f32x4* gr = (const GAS f32x4*)g + lane;
    f32x4 v[4]; float s = 0.f;
#pragma unroll
    for (int j = 0; j < 4; ++j) { v[j] = xr[64 * j]; s += (v[j].x * v[j].x + v[j].y * v[j].y) + (v[j].z * v[j].z + v[j].w * v[j].w); }
    const float r = rsqrtf(wave_sum(s) * (1.f / D) + EPS);
    GAS unsigned long long* o8 = (GAS unsigned long long*)orow + lane;
#pragma unroll
    for (int j = 0; j < 4; ++j) { const f32x4 gg = gr[64 * j];
        o8[64 * j] = (unsigned long long)pk2(v[j].x * r * gg.x, v[j].y * r * gg.y) | ((unsigned long long)pk2(v[j].z * r * gg.z, v[j].w * r * gg.w) << 32); }
}
__device__ __forceinline__ void resnorm_row(int lane, const float* yrow, const float* g1, const float* baserow, float* outrow, const float* g2, bf16* xnrow) {
    const GAS f32x4* yr = (const GAS f32x4*)yrow + lane; const GAS f32x4* gr = (const GAS f32x4*)g1 + lane; const GAS f32x4* br = (const GAS f32x4*)baserow + lane;
    f32x4 v[4]; float s = 0.f;
#pragma unroll
    for (int j = 0; j < 4; ++j) { v[j] = yr[64 * j]; s += (v[j].x * v[j].x + v[j].y * v[j].y) + (v[j].z * v[j].z + v[j].w * v[j].w); }
    const float r = rsqrtf(wave_sum(s) * (1.f / D) + EPS);
    float s2 = 0.f;
#pragma unroll
    for (int j = 0; j < 4; ++j) { const f32x4 gg = gr[64 * j], bb = br[64 * j]; v[j] = bb + v[j] * r * gg; s2 += (v[j].x * v[j].x + v[j].y * v[j].y) + (v[j].z * v[j].z + v[j].w * v[j].w);
        ((GAS f32x4*)outrow + lane)[64 * j] = v[j]; }
    if (xnrow) {
        const float r2 = rsqrtf(wave_sum(s2) * (1.f / D) + EPS); const GAS f32x4* g2r = (const GAS f32x4*)g2 + lane;
        GAS unsigned long long* o8 = (GAS unsigned long long*)xnrow + lane;
#pragma unroll
        for (int j = 0; j < 4; ++j) { const f32x4 gg = g2r[64 * j];
            o8[64 * j] = (unsigned long long)pk2(v[j].x * r2 * gg.x, v[j].y * r2 * gg.y) | ((unsigned long long)pk2(v[j].z * r2 * gg.z, v[j].w * r2 * gg.w) << 32); }
    }
}

struct Args { const float* in[15]; float* out; unsigned char* ws; int ph_lo, ph_hi, li, pad; };
enum { PH_PRO = 0, PH_PROJ = 1, PH_MIX = 2, PH_WO = 3, PH_N1 = 4, PH_UP = 5, PH_DOWN = 6, PH_N2 = 7, PH_END = 8 };

__global__ void __launch_bounds__(NWAVES * 64, 2) skel_fwd(Args args) {
    extern __shared__ __attribute__((aligned(16))) unsigned char lds[];
    Frame F;
    F.lds = (LAS unsigned char*)lds;
    F.MISC = (volatile LAS unsigned*)(F.lds + MISC_OFF);
    F.tid = threadIdx.x; F.lane = F.tid & 63; F.wave = __builtin_amdgcn_readfirstlane(F.tid >> 6);
    F.G = gridDim.x; { const int bx = blockIdx.x; F.vcu = (F.G % 8 == 0) ? (bx % 8) * (F.G / 8) + bx / 8 : bx; }
    unsigned char* ws = args.ws;
    F.ctl = (gu32*)(ws + WS_CTL);
    const float* x = args.in[0]; const float* g_premix = args.in[1]; const float* w_in = args.in[2];
    const float* w_out = args.in[9]; const float* g_postmix = args.in[10]; const float* g_premlp = args.in[11];
    const float* w_up = args.in[12]; const float* w_down = args.in[13]; const float* g_postmlp = args.in[14];
    bf16* Win_t = (bf16*)(ws + WS_WIN); bf16* Wout_t = (bf16*)(ws + WS_WOUT); bf16* Wup_t = (bf16*)(ws + WS_WUP); bf16* Wdn_t = (bf16*)(ws + WS_WDN);
    bf16* XN = (bf16*)(ws + WS_XN); bf16* FQ = (bf16*)(ws + WS_FQ); bf16* MIXED = (bf16*)(ws + WS_MIXED); bf16* HB = (bf16*)(ws + WS_H);
    float* SMALL = (float*)(ws + WS_SMALL); float* MIXOUT = (float*)(ws + WS_MIXOUT); float* Y = (float*)(ws + WS_Y);
    for (int u = F.tid; u < (LDS_BYTES - LDSCTL_OFF) / 4; u += NWAVES * 64) ((LAS unsigned*)(F.lds + LDSCTL_OFF))[u] = 0u;
    __syncthreads();
    XcdBarrier bar = xcd_barrier_post((unsigned*)(F.ctl + CW_BAR) + args.li * XCD_BAR_WORDS, F.MISC + 8);
    const int lo = args.ph_lo, hi = args.ph_hi;
#define IN(k) (lo <= (k) && (k) < hi)
#define BOTH(k) (IN(k) && IN((k) + 1))
#define GRID_BAR() xcd_barrier(bar)
    const int gw = F.vcu * NWAVES + F.wave, NGW = F.G * NWAVES;

    if (IN(PH_PRO)) {
        LAS float* scr = (LAS float*)(F.lds + RING_OFF + F.wave * 16384);
        constexpr int I_IN = (D / 64) * (NPROJ / 32), I_O = (D / 64) * (D / 32), I_1 = (D / 64) * (FF / 32), I_2 = (FF / 64) * (D / 32);
        constexpr int NITEMS = I_IN + I_O + I_1 + I_2;
        for (int it = gw; it < NITEMS; it += NGW) {
            int r = it;
            if (r < I_IN) { p0_transpose_item<true>(w_in, D, DPROJ, NPROJ, Win_t, scr, r, F.lane); continue; } r -= I_IN;
            if (r < I_O) { p0_transpose_item<false>(w_out, D, D, D, Wout_t, scr, r, F.lane); continue; } r -= I_O;
            if (r < I_1) { p0_transpose_item<false>(w_up, D, FF, FF, Wup_t, scr, r, F.lane); continue; } r -= I_1;
            p0_transpose_item<false>(w_down, FF, D, D, Wdn_t, scr, r, F.lane);
        }
        for (int m = gw; m < M; m += NGW) rms_row_to_bf16(F.lane, x + (size_t)m * D, g_premix, XN + (size_t)m * D);
        if (BOTH(PH_PRO)) GRID_BAR();
    }
    if (IN(PH_PROJ)) {
        pg8::Gemm g{XN, Win_t, M, NPROJ, D}; pg8::StaticOrder S; S.init(M, NPROJ, F.G, (int)blockIdx.x);
        pg8::EpiProj E{FQ, (size_t)(WS_G512 / 2), SMALL, QSCALE};
        pg8::gemm_phase<pg8::EpiProj, pg8::StaticOrder, PG8_ALIGN, PG8_SP2>(F.lds + RING_OFF, g, S, E);
        if (BOTH(PH_PROJ)) GRID_BAR();
    }
    if (IN(PH_MIX)) {
        MIXER_PHASE_BODY
        if (BOTH(PH_MIX)) GRID_BAR();
    }
    if (IN(PH_WO)) {
        pg8::Gemm g{MIXED, Wout_t, M, D, D}; pg8::StaticOrder S; S.init(M, D, F.G, (int)blockIdx.x);
        pg8::EpiF32 E{MIXOUT, D};
        pg8::gemm_phase<pg8::EpiF32, pg8::StaticOrder, false, PG8_SP2>(F.lds + RING_OFF, g, S, E);
        if (BOTH(PH_WO)) GRID_BAR();
    }
    if (IN(PH_N1)) {
        for (int m = gw; m < M; m += NGW) resnorm_row(F.lane, MIXOUT + (size_t)m * D, g_postmix, x + (size_t)m * D, args.out + (size_t)m * D, g_premlp, XN + (size_t)m * D);
        if (BOTH(PH_N1)) GRID_BAR();
    }
    if (IN(PH_UP)) {
        pg8::Gemm g{XN, Wup_t, M, FF, D}; pg8::StaticOrder S; S.init(M, FF, F.G, (int)blockIdx.x);
        pg8::EpiRelu2 E{HB, FF};
        pg8::gemm_phase<pg8::EpiRelu2, pg8::StaticOrder, PG8_ALIGN, PG8_SP2>(F.lds + RING_OFF, g, S, E);
        if (BOTH(PH_UP)) GRID_BAR();
    }
    if (IN(PH_DOWN)) {
        pg8::Gemm g{HB, Wdn_t, M, D, FF}; pg8::StaticOrder S; S.init(M, D, F.G, (int)blockIdx.x);
        pg8::EpiF32 E{Y, D};
        pg8::gemm_phase<pg8::EpiF32, pg8::StaticOrder, false, PG8_SP2>(F.lds + RING_OFF, g, S, E);
        if (BOTH(PH_DOWN)) GRID_BAR();
    }
    if (IN(PH_N2)) {
        for (int m = gw; m < M; m += NGW) resnorm_row(F.lane, Y + (size_t)m * D, g_postmlp, args.out + (size_t)m * D, args.out + (size_t)m * D, nullptr, nullptr);
    }
#undef IN
#undef BOTH
#undef GRID_BAR
}
__device__ __forceinline__ float wave_max(float v) {
#pragma unroll
    for (int o = 1; o < 64; o <<= 1) v = fmaxf(v, __shfl_xor(v, o));
    return v;
}
__device__ __forceinline__ float softplus_f(float x) { return fmaxf(x, 0.f) + log1pf(expf(-fabsf(x))); }
__device__ __forceinline__ float sigmoid_f(float x) { return 1.f / (1.f + expf(-x)); }
__global__ void k_cum(const float* __restrict__ small, const float* __restrict__ fbias, float* __restrict__ cum) {
    __shared__ float part[256];
    const int b = blockIdx.x >> 3, h = blockIdx.x & 7, tid = threadIdx.x;
    float loc[8]; float s = 0.f;
    const float bz = fbias[h];
#pragma unroll
    for (int i = 0; i < 8; ++i) {
        const float z = small[(size_t)(b * SEQ + tid * 8 + i) * 16 + h] + bz;
        const float lf = fminf(z, 0.f) - log1pf(expf(-fabsf(z)));
        s += lf; loc[i] = s;
    }
    part[tid] = s;
    __syncthreads();
    if (tid == 0) { float run = 0.f; for (int i = 0; i < 256; ++i) { const float t = part[i]; part[i] = run; run += t; } }
    __syncthreads();
    const float off = part[tid];
#pragma unroll
    for (int i = 0; i < 8; ++i) cum[(size_t)blockIdx.x * SEQ + tid * 8 + i] = loc[i] + off;
}
__global__ void __launch_bounds__(256) k_fox(const bf16* __restrict__ FQ, const bf16* __restrict__ FK, const bf16* __restrict__ FV, const float* __restrict__ cum, const float* __restrict__ gnorm, bf16* __restrict__ mixed) {
    __shared__ float lg[4][SEQ];
    __shared__ float qs[4][64];
    const int w = threadIdx.x >> 6, lane = threadIdx.x & 63;
    const int t = blockIdx.x * 4 + w, h = blockIdx.y, b = blockIdx.z;
    const size_t r0 = (size_t)b * SEQ;
    qs[w][lane] = bf2f(FQ[(r0 + t) * 512 + h * 64 + lane]);
    __syncthreads();
    const float* cm = cum + (size_t)(b * 8 + h) * SEQ;
    const float ct = cm[t];
    float mx = -INFINITY;
    for (int s = lane; s <= t; s += 64) {
        const bf16* kr = FK + (r0 + s) * 512 + h * 64;
        float dot = 0.f;
#pragma unroll
        for (int j = 0; j < 64; ++j) dot += qs[w][j] * bf2f(kr[j]);
        const float l = dot + (ct - cm[s]) * LOG2E;
        lg[w][s] = l; mx = fmaxf(mx, l);
    }
    mx = wave_max(mx);
    float sum = 0.f;
    for (int s = lane; s <= t; s += 64) { const float p = exp2f(lg[w][s] - mx); lg[w][s] = p; sum += p; }
    sum = wave_sum(sum);
    __syncthreads();
    float o = 0.f;
    for (int s = 0; s <= t; ++s) o += lg[w][s] * bf2f(FV[(r0 + s) * 512 + h * 64 + lane]);
    o /= sum;
    const float r = rsqrtf(wave_sum(o * o) * (1.f / 64.f) + EPS);
    mixed[(r0 + t) * D + h * 64 + lane] = (bf16)f2bf(o * r * gnorm[lane]);
}
__global__ void k_conv(const bf16* __restrict__ GQ, const bf16* __restrict__ GK, const bf16* __restrict__ GV, const float* __restrict__ small, const float* __restrict__ cw,
                       const float* __restrict__ a_log, const float* __restrict__ dt_bias, float* __restrict__ qf, float* __restrict__ kf, float* __restrict__ vf, float* __restrict__ beta, float* __restrict__ gdec) {
    const int m = blockIdx.x, t = m & (SEQ - 1);
    for (int c = threadIdx.x; c < 1536; c += blockDim.x) {
        const bf16* src = c < 512 ? GQ : (c < 1024 ? GK : GV); float* dst = c < 512 ? qf : (c < 1024 ? kf : vf); const int cc = c & 511;
        float y = 0.f;
#pragma unroll
        for (int j = 0; j < 4; ++j) { const int tt = t - 3 + j; if (tt >= 0) y += cw[j * 1536 + c] * bf2f(src[(size_t)(m - 3 + j) * 512 + cc]); }
        dst[(size_t)m * 512 + cc] = y * sigmoid_f(y);
    }
    if (threadIdx.x < 4) {
        const int h = threadIdx.x;
        beta[m * 4 + h] = sigmoid_f(small[(size_t)m * 16 + 8 + h]);
        gdec[m * 4 + h] = -expf(a_log[h]) * softplus_f(small[(size_t)m * 16 + 12 + h] + dt_bias[h]);
    }
}
__global__ void k_l2(float* __restrict__ qf, float* __restrict__ kf) {
    const int lane = threadIdx.x & 63, item = blockIdx.x * 4 + (threadIdx.x >> 6);
    const int h = item & 3, which = (item >> 2) & 1, m = item >> 3;
    float* p = (which ? kf : qf) + (size_t)m * 512 + h * 128;
    const float a = p[lane], b = p[lane + 64];
    const float r = rsqrtf(wave_sum(a * a + b * b) + EPS) * (which == 0 ? 0.08838834764831845f : 1.f);
    p[lane] = a * r; p[lane + 64] = b * r;
}
__global__ void __launch_bounds__(128) k_gdn_rec(float* __restrict__ qf, const float* __restrict__ kf, const float* __restrict__ vf, const float* __restrict__ beta, const float* __restrict__ gdec) {
    __shared__ float ks[2][128];
    __shared__ float qsh[2][128];
    const int b = blockIdx.x >> 2, h = blockIdx.x & 3, v = threadIdx.x;
    float Sd[128];
#pragma unroll
    for (int d = 0; d < 128; ++d) Sd[d] = 0.f;
    const size_t r0 = (size_t)b * SEQ; const int co = h * 128 + v;
    float qn = qf[r0 * 512 + co], kn = kf[r0 * 512 + co], vn = vf[r0 * 512 + co], an = expf(gdec[r0 * 4 + h]), bn = beta[r0 * 4 + h];
    for (int t = 0; t < SEQ; ++t) {
        const int bufi = t & 1;
        ks[bufi][v] = kn; qsh[bufi][v] = qn;
        const float vt = vn, at = an, bt = bn;
        if (t + 1 < SEQ) { const size_t r = r0 + t + 1; qn = qf[r * 512 + co]; kn = kf[r * 512 + co]; vn = vf[r * 512 + co]; an = expf(gdec[r * 4 + h]); bn = beta[r * 4 + h]; }
        __syncthreads();
        float kS = 0.f;
#pragma unroll
        for (int d = 0; d < 128; ++d) kS += ks[bufi][d] * Sd[d];
        const float coef = bt * (vt - at * kS);
        float o = 0.f;
#pragma unroll
        for (int d = 0; d < 128; ++d) { Sd[d] = at * Sd[d] + ks[bufi][d] * coef; o += qsh[bufi][d] * Sd[d]; }
        qf[(r0 + t) * 512 + co] = o;
    }
}
__global__ void k_gdn_post(const float* __restrict__ qf, const bf16* __restrict__ GZ, const float* __restrict__ gnorm, bf16* __restrict__ mixed) {
    const int lane = threadIdx.x & 63, item = blockIdx.x * 4 + (threadIdx.x >> 6);
    const int h = item & 3, m = item >> 2;
    const float* p = qf + (size_t)m * 512 + h * 128;
    const float a = p[lane], b = p[lane + 64];
    const float r = rsqrtf(wave_sum(a * a + b * b) * (1.f / 128.f) + EPS);
    const float z0 = bf2f(GZ[(size_t)m * 512 + h * 128 + lane]), z1 = bf2f(GZ[(size_t)m * 512 + h * 128 + lane + 64]);
    bf16* o = mixed + (size_t)m * D + 512 + h * 128;
    o[lane] = (bf16)f2bf(a * r * gnorm[lane] * z0 * sigmoid_f(z0));
    o[lane + 64] = (bf16)f2bf(b * r * gnorm[lane + 64] * z1 * sigmoid_f(z1));
}
static void launch_skel(int grid, hipStream_t stream, Args a, int lo, int hi, int li) {
    a.ph_lo = lo; a.ph_hi = hi; a.li = li;
    hipLaunchKernelGGL(skel_fwd, dim3(grid), dim3(NWAVES * 64), LDS_BYTES, stream, a);
    const hipError_t le = hipPeekAtLastError();
    if (le != hipSuccess) fprintf(stderr, "kernel_launch: launch %d failed: %s\n", li, hipGetErrorName(le));
}
extern "C" void kernel_launch(void* const* d_in, const int* in_sizes, int n_in, void* d_out, int out_size, void* d_ws, size_t ws_size, hipStream_t stream) {
    static int grid = 0;
    if (grid == 0) {
        if (n_in != 15 || in_sizes[0] != M * D || out_size != M * D || ws_size < WS_END) { fprintf(stderr, "kernel_launch: unexpected shapes (n_in %d, in0 %d, out %d, ws %zu); nothing launched\n", n_in, n_in > 0 ? in_sizes[0] : -1, out_size, ws_size); grid = -1; return; }
        int dev = 0, cus = 0, per_cu = 0;
        if (hipGetDevice(&dev) != hipSuccess || hipDeviceGetAttribute(&cus, hipDeviceAttributeMultiprocessorCount, dev) != hipSuccess) { grid = -1; return; }
        if (hipFuncSetAttribute((const void*)skel_fwd, hipFuncAttributeMaxDynamicSharedMemorySize, LDS_BYTES) != hipSuccess) { fprintf(stderr, "kernel_launch: hipFuncSetAttribute failed\n"); grid = -1; return; }
        if (hipOccupancyMaxActiveBlocksPerMultiprocessor(&per_cu, (const void*)skel_fwd, NWAVES * 64, LDS_BYTES) != hipSuccess || per_cu < 1)
            fprintf(stderr, "kernel_launch: note: occupancy query reports %d workgroups per CU\n", per_cu);
        (void)hipGetLastError();
        grid = cus;
    }
    if (grid < 0) return;
    if (hipMemsetAsync((char*)d_ws + WS_CTL, 0, CTL_ZERO_BYTES, stream) != hipSuccess) { fprintf(stderr, "kernel_launch: hipMemsetAsync failed\n"); return; }
    Args a{};
    for (int i = 0; i < 15; ++i) a.in[i] = (const float*)d_in[i];
    a.out = (float*)d_out; a.ws = (unsigned char*)d_ws;
    HOST_LAUNCH_PROGRAM
}
```

```cpp
#include <hip/hip_runtime.h>
#include <cstdio>
#include <cstdint>
#define HOST_LAUNCH_PROGRAM launch_skel(grid, stream, a, PH_PRO, PH_END, 0);
namespace pg8 {
#define PG8_LAS __attribute__((address_space(3)))
typedef unsigned short bf16_t;
typedef short bf16x8 __attribute__((ext_vector_type(8)));
typedef float f32x4 __attribute__((ext_vector_type(4)));
typedef unsigned u32x4 __attribute__((ext_vector_type(4)));
constexpr int BM = 256, BK = 64, HALF = 128, HTB = HALF * BK * 2  , STAGE_BYTES = 8 * HTB, NXCD = 8, WGM = 8;

__host__ __device__ __forceinline__ int lds_byte(int r, int c) { const int st = (r >> 4) * 2 + (c >> 5), rr = r & 15, cc = c & 31, ob = rr * 64 + cc * 2; return st * 1024 + (ob ^ (((ob >> 9) & 1) << 5)); }
__host__ __device__ __forceinline__ void stage_rc(int b, int& R, int& C) { const int st = b / 1024, sb = b % 1024, swz = sb ^ (((sb >> 9) & 1) << 5); R = (st >> 1) * 16 + swz / 64; C = (st & 1) * 32 + (swz % 64) / 2; }
__host__ __device__ __forceinline__ int perm32(int rho) { const int n = rho >> 4, i = rho & 15; return 8 * (i >> 2) + 4 * n + (i & 3); }

struct Unit { int pm, pn; };
struct Gemm { const bf16_t* A; const bf16_t* Bt; int M, N, K; };

struct StaticOrder {
    int nM, nN, nwg, G, c;
    __host__ __device__ void init(int M, int N, int G_, int c_) { nM = M / BM; nN = N / BM; nwg = nM * nN; G = G_; c = c_; }
    __host__ __device__ bool next(int i, Unit& u) const {
        const long L = (long)i * G + c; if (L >= nwg) return false;
        int wgid = (int)L; { const int q = nwg / NXCD, r = nwg % NXCD, xcd = wgid % NXCD, off = wgid / NXCD; wgid = (xcd < r ? xcd * (q + 1) : r * (q + 1) + (xcd - r) * q) + off; }
        const int nig = WGM * nN, gid = wgid / nig, fm = gid * WGM, gsz = (nM - fm) < WGM ? (nM - fm) : WGM;
        u.pm = fm + ((wgid % nig) % gsz); u.pn = (wgid % nig) / gsz; return true;
    }
    __device__ __forceinline__ void a_ready(const Unit&) const {}
    __device__ __forceinline__ void done(const Unit&) const {}
};

__device__ __forceinline__ unsigned cvt_pk_bf16(float lo, float hi) { unsigned r; asm volatile("v_cvt_pk_bf16_f32 %0, %1, %2" : "=v"(r) : "v"(lo), "v"(hi)); return r; }
typedef float f32x2 __attribute__((ext_vector_type(2)));
struct EpiProj {
    static constexpr bool PERM = true, AFTER_DRAIN = false;
    bf16_t* O; size_t gstride; float* small; float qscale;
    __device__ __forceinline__ void operator()(const f32x4 (&acc)[2][2][4][2], const Unit& u, int wr, int wc, int fr, int fq) const {
        const int row0 = u.pm * BM + wr * 64 + fr;
        if (u.pn < 14) {
            const int t = u.pn >> 1; bf16_t* base = O + (size_t)t * gstride; const float sc = (t == 0) ? qscale : 1.f;
            const int col0 = (u.pn & 1) * 256 + wc * 32 + 8 * fq;
#pragma unroll
            for (int ai = 0; ai < 2; ++ai)
#pragma unroll
                for (int m = 0; m < 4; ++m) { bf16_t* rowp = base + (size_t)(row0 + ai * HALF + m * 16) * 512 + col0;
#pragma unroll
                    for (int bj = 0; bj < 2; ++bj) { const f32x4 v0 = acc[ai][bj][m][0] * sc, v1 = acc[ai][bj][m][1] * sc;
                        u32x4 w; w.x = cvt_pk_bf16(v0[0], v0[1]); w.y = cvt_pk_bf16(v0[2], v0[3]); w.z = cvt_pk_bf16(v1[0], v1[1]); w.w = cvt_pk_bf16(v1[2], v1[3]);
                        *(u32x4*)(rowp + bj * HALF) = w; } }
        } else {
            if (wc == 0 && fq < 2) {
#pragma unroll
                for (int ai = 0; ai < 2; ++ai)
#pragma unroll
                    for (int m = 0; m < 4; ++m) { float* rowp = small + (size_t)(row0 + ai * HALF + m * 16) * 16 + 8 * fq;
                        *(f32x4*)(rowp) = acc[ai][0][m][0]; *(f32x4*)(rowp + 4) = acc[ai][0][m][1]; }
            }
        }
    }
};
struct EpiRelu2 {
    static constexpr bool PERM = true, AFTER_DRAIN = false;
    bf16_t* O; int ldc;
    __device__ __forceinline__ void operator()(const f32x4 (&acc)[2][2][4][2], const Unit& u, int wr, int wc, int fr, int fq) const {
        const int row0 = u.pm * BM + wr * 64 + fr, col0 = u.pn * BM + wc * 32 + 8 * fq;
#pragma unroll
        for (int ai = 0; ai < 2; ++ai)
#pragma unroll
            for (int m = 0; m < 4; ++m) { bf16_t* rowp = O + (size_t)(row0 + ai * HALF + m * 16) * ldc + col0;
#pragma unroll
                for (int bj = 0; bj < 2; ++bj) { f32x4 v0 = acc[ai][bj][m][0], v1 = acc[ai][bj][m][1];
#pragma unroll
                    for (int e = 0; e < 4; ++e) { const float a = fmaxf(v0[e], 0.f), b = fmaxf(v1[e], 0.f); v0[e] = a * a; v1[e] = b * b; }
                    u32x4 w; w.x = cvt_pk_bf16(v0[0], v0[1]); w.y = cvt_pk_bf16(v0[2], v0[3]); w.z = cvt_pk_bf16(v1[0], v1[1]); w.w = cvt_pk_bf16(v1[2], v1[3]);
                    *(u32x4*)(rowp + bj * HALF) = w; } }
    }
};
struct EpiF32 {
    static constexpr bool PERM = false, AFTER_DRAIN = false;
    float* O; int ldc;
    __device__ __forceinline__ void operator()(const f32x4 (&acc)[2][2][4][2], const Unit& u, int wr, int wc, int fr, int fq) const {
        const int row0 = u.pm * BM + wr * 64 + fr, col0 = u.pn * BM + wc * 32 + 4 * fq;
#pragma unroll
        for (int ai = 0; ai < 2; ++ai)
#pragma unroll
            for (int m = 0; m < 4; ++m) { float* rowp = O + (size_t)(row0 + ai * HALF + m * 16) * ldc + col0;
#pragma unroll
                for (int bj = 0; bj < 2; ++bj)
#pragma unroll
                    for (int n = 0; n < 2; ++n) *(f32x4*)(rowp + bj * HALF + n * 16) = acc[ai][bj][m][n]; }
    }
};
template <class Epi, class Sched, bool ALIGN_EPI = false, bool SP2 = false>
__device__ __forceinline__ void gemm_phase(PG8_LAS unsigned char* lds, const Gemm g, const Sched& S, const Epi& E) {
    const int tid = threadIdx.x, wid = __builtin_amdgcn_readfirstlane(tid >> 6), lane = tid & 63, wr = wid >> 2, wc = wid & 3, fr = lane & 15, fq = lane >> 4;
    const int K = g.K, nt = K / BK;
    unsigned voffA[2], voffB[2];
#pragma unroll
    for (int i = 0; i < 2; ++i) { int R, C; stage_rc(tid * 16 + i * 8192, R, C); const int Rb = Epi::PERM ? ((R & ~31) + perm32(R & 31)) : R;
        voffA[i] = (unsigned)(R * K + C) * 2u; voffB[i] = (unsigned)(Rb * K + C) * 2u; }
    const size_t kstep = (size_t)(BK * 2);
    const size_t hstep = (size_t)HALF * K * 2;
    const size_t tstep = 2 * hstep;
    const unsigned ldsw = (unsigned)wid * 1024u;
    const int aoff = lds_byte(wr * 64 + fr, fq * 8), boff = lds_byte(wc * 32 + fr, fq * 8);
#define PG8_SA(b, h) (((b) * 2 + (h)) * HTB)
#define PG8_SB(b, h) ((4 + (b) * 2 + (h)) * HTB)
#define PG8_STAGE(bufoff, gbase, voff) do { _Pragma("unroll") for (int _i = 0; _i < 2; ++_i) \
        __builtin_amdgcn_global_load_lds((const unsigned*)((const char*)(gbase) + (voff)[_i]), (PG8_LAS unsigned*)(lds + (bufoff) + ldsw + _i * 8192), 16, 0, 0); } while (0)
#define PG8_LDA(dst, b, h) do { _Pragma("unroll") for (int m = 0; m < 4; ++m) _Pragma("unroll") for (int k = 0; k < 2; ++k) dst[m][k] = *(const PG8_LAS bf16x8*)(lds + PG8_SA(b, h) + aoff + m * 2048 + k * 1024); } while (0)
#define PG8_LDB(dst, b, h) do { _Pragma("unroll") for (int n = 0; n < 2; ++n) _Pragma("unroll") for (int k = 0; k < 2; ++k) dst[n][k] = *(const PG8_LAS bf16x8*)(lds + PG8_SB(b, h) + boff + n * 2048 + k * 1024); } while (0)
#define PG8_MMA(ai, bj, At, Bt) do { __builtin_amdgcn_s_setprio(1); _Pragma("unroll") for (int m = 0; m < 4; ++m) _Pragma("unroll") for (int n = 0; n < 2; ++n) _Pragma("unroll") for (int k = 0; k < 2; ++k) \
        acc[ai][bj][m][n] = __builtin_amdgcn_mfma_f32_16x16x32_bf16(Bt[n][k], At[m][k], acc[ai][bj][m][n], 0, 0, 0); __builtin_amdgcn_s_setprio(0); } while (0)
#define PG8_WAIT_V(n) asm volatile("s_waitcnt vmcnt(" #n ")" ::: "memory")
#define PG8_WAIT_L(n) asm volatile("s_waitcnt lgkmcnt(" #n ")" ::: "memory")
#define PG8_BAR __builtin_amdgcn_s_barrier()
#define PG8_SCHED __builtin_amdgcn_sched_barrier(0)
    Unit cur, nxt; int ui = 0;
    if (!S.next(0, cur)) return;
    f32x4 acc[2][2][4][2];
#pragma unroll
    for (int a = 0; a < 2; ++a)
#pragma unroll
        for (int b = 0; b < 2; ++b)
#pragma unroll
            for (int m = 0; m < 4; ++m)
#pragma unroll
                for (int n = 0; n < 2; ++n) acc[a][b][m][n] = (f32x4){0.f, 0.f, 0.f, 0.f};
    bf16x8 At[4][2], B0[2][2], B1[2][2];
    const char* cA = (const char*)g.A + (size_t)cur.pm * tstep; const char* cB = (const char*)g.Bt + (size_t)cur.pn * tstep;
    S.a_ready(cur);
    if constexpr (SP2) {
        PG8_STAGE(PG8_SB(0, 0), cB, voffB); PG8_STAGE(PG8_SB(0, 1), cB + hstep, voffB); PG8_STAGE(PG8_SA(0, 0), cA, voffA); PG8_STAGE(PG8_SA(0, 1), cA + hstep, voffA);
        if (wr == 1) PG8_BAR;
        PG8_WAIT_V(2); PG8_BAR;
        PG8_STAGE(PG8_SB(1, 0), cB + kstep, voffB); PG8_STAGE(PG8_SA(1, 0), cA + kstep, voffA); PG8_STAGE(PG8_SB(1, 1), cB + hstep + kstep, voffB);
        PG8_WAIT_V(6); PG8_BAR;
    } else {
        PG8_STAGE(PG8_SB(0, 0), cB, voffB); PG8_STAGE(PG8_SA(0, 0), cA, voffA); PG8_STAGE(PG8_SB(0, 1), cB + hstep, voffB); PG8_STAGE(PG8_SA(0, 1), cA + hstep, voffA);
        if (wr == 1) PG8_BAR;
        PG8_WAIT_V(4); PG8_BAR;
        PG8_STAGE(PG8_SB(1, 0), cB + kstep, voffB); PG8_STAGE(PG8_SA(1, 0), cA + kstep, voffA); PG8_STAGE(PG8_SB(1, 1), cB + hstep + kstep, voffB);
        PG8_WAIT_V(6); PG8_BAR;
    }
    for (;;) {
        const bool has_next = S.next(ui + 1, nxt);
        const char* nA = has_next ? (const char*)g.A + (size_t)nxt.pm * tstep : cA; const char* nB = has_next ? (const char*)g.Bt + (size_t)nxt.pn * tstep : cB;
        for (int t = 0; t < nt; t += 2) {
            const bool last = (t == nt - 2);
            const char* a1 = cA + (size_t)(t + 1) * kstep;
            const char* a2 = last ? nA : cA + (size_t)(t + 2) * kstep; const char* b2 = last ? nB : cB + (size_t)(t + 2) * kstep;
            const char* a3 = a2 + kstep; const char* b3 = b2 + kstep;
            if (last && has_next) S.a_ready(nxt);
            if constexpr (SP2) {
            PG8_LDB(B0, 0, 0); PG8_LDB(B1, 0, 1); PG8_SCHED; PG8_LDA(At, 0, 0); PG8_STAGE(PG8_SA(1, 1), a1 + hstep, voffA);
            PG8_WAIT_V(8); PG8_WAIT_L(0); PG8_BAR; PG8_MMA(0, 0, At, B0); PG8_MMA(0, 1, At, B1); PG8_BAR; PG8_SCHED;
            PG8_LDA(At, 0, 1); PG8_STAGE(PG8_SB(0, 0), b2, voffB); PG8_STAGE(PG8_SB(0, 1), b2 + hstep, voffB); PG8_STAGE(PG8_SA(0, 0), a2, voffA);
            PG8_WAIT_V(8); PG8_WAIT_L(0); PG8_BAR; PG8_MMA(1, 0, At, B0); PG8_MMA(1, 1, At, B1); PG8_BAR; PG8_SCHED;
            PG8_LDB(B0, 1, 0); PG8_LDB(B1, 1, 1); PG8_SCHED; PG8_LDA(At, 1, 0); PG8_STAGE(PG8_SA(0, 1), a2 + hstep, voffA);
            PG8_WAIT_V(8); PG8_WAIT_L(0); PG8_BAR; PG8_MMA(0, 0, At, B0); PG8_MMA(0, 1, At, B1); PG8_BAR; PG8_SCHED;
            PG8_LDA(At, 1, 1); PG8_STAGE(PG8_SB(1, 0), b3, voffB); PG8_STAGE(PG8_SB(1, 1), b3 + hstep, voffB); PG8_STAGE(PG8_SA(1, 0), a3, voffA);
            PG8_WAIT_V(8); PG8_WAIT_L(0); PG8_BAR; PG8_MMA(1, 0, At, B0); PG8_MMA(1, 1, At, B1); PG8_BAR; PG8_SCHED;
            } else {
            PG8_LDB(B0, 0, 0); PG8_SCHED; PG8_LDA(At, 0, 0); PG8_STAGE(PG8_SA(1, 1), a1 + hstep, voffA);
            PG8_WAIT_L(8); PG8_BAR; PG8_WAIT_L(0); PG8_MMA(0, 0, At, B0); PG8_BAR; PG8_SCHED;
            PG8_LDB(B1, 0, 1); PG8_STAGE(PG8_SB(0, 0), b2, voffB);
            PG8_BAR; PG8_WAIT_L(0); PG8_MMA(0, 1, At, B1); PG8_BAR;
            PG8_LDA(At, 0, 1); PG8_STAGE(PG8_SA(0, 0), a2, voffA);
            PG8_BAR; PG8_WAIT_L(0); PG8_MMA(1, 0, At, B0); PG8_BAR; PG8_SCHED;
            PG8_STAGE(PG8_SB(0, 1), b2 + hstep, voffB);
            PG8_WAIT_V(6); PG8_BAR; PG8_MMA(1, 1, At, B1); PG8_BAR;
            PG8_LDB(B0, 1, 0); PG8_SCHED; PG8_LDA(At, 1, 0); PG8_STAGE(PG8_SA(0, 1), a2 + hstep, voffA);
            PG8_WAIT_L(8); PG8_BAR; PG8_WAIT_L(0); PG8_MMA(0, 0, At, B0); PG8_BAR; PG8_SCHED;
            PG8_LDB(B1, 1, 1); PG8_STAGE(PG8_SB(1, 0), b3, voffB);
            PG8_BAR; PG8_WAIT_L(0); PG8_MMA(0, 1, At, B1); PG8_BAR;
            PG8_LDA(At, 1, 1); PG8_STAGE(PG8_SA(1, 0), a3, voffA);
            PG8_BAR; PG8_WAIT_L(0); PG8_MMA(1, 0, At, B0); PG8_BAR; PG8_SCHED;
            PG8_STAGE(PG8_SB(1, 1), b3 + hstep, voffB);
            PG8_WAIT_V(6); PG8_BAR; PG8_MMA(1, 1, At, B1); PG8_BAR;
            }
        }
        if constexpr (ALIGN_EPI) { if (wr == 0) PG8_BAR; }
        if constexpr (!Epi::AFTER_DRAIN) { E(acc, cur, wr, wc, fr, fq); S.done(cur); }
        if (!has_next) break;
#pragma unroll
        for (int a = 0; a < 2; ++a)
#pragma unroll
            for (int b = 0; b < 2; ++b)
#pragma unroll
                for (int m = 0; m < 4; ++m)
#pragma unroll
                    for (int n = 0; n < 2; ++n) acc[a][b][m][n] = (f32x4){0.f, 0.f, 0.f, 0.f};
        cur = nxt; cA = nA; cB = nB; ++ui;
        if constexpr (ALIGN_EPI) { if (wr == 1) PG8_BAR; }
    }
    PG8_WAIT_V(0);
    if constexpr (!ALIGN_EPI) { if (wr == 0) PG8_BAR; }
    PG8_BAR;
    if constexpr (Epi::AFTER_DRAIN) { E.fused(acc, cur, wr, wc, fr, fq, lds, wid, lane); S.done(cur); }
#undef PG8_SA
#undef PG8_SB
#undef PG8_STAGE
#undef PG8_LDA
#undef PG8_LDB
#undef PG8_MMA
#undef PG8_WAIT_V
#undef PG8_WAIT_L
#undef PG8_BAR
#undef PG8_SCHED
}
}
#include <hip/hip_bf16.h>
#include <cmath>
namespace attn_body {
using bf16=__hip_bfloat16;
using bf16x8=__attribute__((ext_vector_type(8)))short;
using s16x4=__attribute__((ext_vector_type(4)))short;
using f32x16=__attribute__((ext_vector_type(16)))float;
using u32x4=__attribute__((ext_vector_type(4)))unsigned;
constexpr int BATCH=8,NHEAD=8,SEQ=2048,D=64,DM=NHEAD*D,OPITCH=1024;
constexpr int NW=8,QBLK=32,QB=QBLK*NW,KVBLK=64,NQB=SEQ/QB;
constexpr int ATTN_PITCH=DM, ATTN_UNIT_ROWS=QB;
__device__ __forceinline__ int crow(int r,int hi){return (r&3)+8*(r>>2)+4*hi;}
#define SBAR() __builtin_amdgcn_sched_barrier(0)
__device__ __forceinline__ void cmask(f32x16&p0,f32x16&p1,int jb,int qrel,int hi){
  const float NEG=-INFINITY; int kb=64*jb+4*hi;
  #pragma unroll
  for(int r=0;r<16;++r){int kv=kb+(r&3)+8*(r>>2); if(kv>qrel)p0[r]=NEG; if(kv+32>qrel)p1[r]=NEG;}
}

constexpr int NSLOT=3, SLOTB=8192;
constexpr int LDS_K=0, LDS_V=NSLOT*SLOTB, LDS_WS=2*NSLOT*SLOTB, LDS_OST=LDS_WS+NW*64*4, LDS_KB=LDS_OST+NW*4096, LDS_BYTES=LDS_KB+SEQ*16;
constexpr float C2=0.125f*1.4426950408889634f;
__device__ __forceinline__ void glds16(const void*gsrc,unsigned lds_dst){unsigned keep;
  asm volatile("s_mov_b32 %0, m0\n\ts_mov_b32 m0, %2\n\ts_nop 0\n\tglobal_load_lds_dwordx4 %1, off\n\ts_mov_b32 m0, %0":"=&s"(keep):"v"(gsrc),"s"(lds_dst):"memory");}
__device__ __forceinline__ float max3f(float a,float b,float c){float r;asm("v_max3_f32 %0, %1, %2, %3":"=v"(r):"v"(a),"v"(b),"v"(c));return r;}
__device__ __forceinline__ float max2f(float a,float b){float r;asm("v_max_f32_e32 %0, %1, %2":"=v"(r):"v"(a),"v"(b));return r;}
__device__ __forceinline__ float fadd_s(float a,float b){float r;asm("v_add_f32_e32 %0, %1, %2":"=v"(r):"v"(a),"v"(b));return r;}
__device__ __forceinline__ float fsub_s(float a,float b){float r;asm("v_sub_f32_e32 %0, %1, %2":"=v"(r):"v"(a),"v"(b));return r;}
typedef float f32x2_t __attribute__((ext_vector_type(2))); typedef __bf16 bf16x2_t __attribute__((ext_vector_type(2)));
__device__ __forceinline__ unsigned cvtpk_s(float lo,float hi){f32x2_t v={lo,hi};bf16x2_t b=__builtin_convertvector(v,bf16x2_t);return __builtin_bit_cast(unsigned,b);}
#define WAIT_BAR(N) asm volatile("s_waitcnt vmcnt(" #N ") lgkmcnt(0)\n\ts_barrier":::"memory")

__device__ __forceinline__ void qkt(f32x16&p0,f32x16&p1,const char*Kslot,const bf16x8*qr,const bf16x8 ka0,const bf16x8 ka1,const bf16x8 qbf,int r32,int hi){
  p0=__builtin_amdgcn_mfma_f32_32x32x16_bf16(ka0,qbf,f32x16{},0,0,0);p1=__builtin_amdgcn_mfma_f32_32x32x16_bf16(ka1,qbf,f32x16{},0,0,0);
  const char*kb=Kslot+hi*1024+r32*16;
  #pragma unroll
  for(int d0=0;d0<4;++d0){
    const bf16x8 b0=*reinterpret_cast<const bf16x8*>(kb+d0*2048);
    const bf16x8 b1=*reinterpret_cast<const bf16x8*>(kb+d0*2048+512);
    p0=__builtin_amdgcn_mfma_f32_32x32x16_bf16(b0,qr[d0],p0,0,0,0);p1=__builtin_amdgcn_mfma_f32_32x32x16_bf16(b1,qr[d0],p1,0,0,0);}
}
typedef __attribute__((address_space(3))) const char* lds_cptr;
typedef short v4i16_t __attribute__((ext_vector_type(4)));
__device__ __forceinline__ void kload8(bf16x8*kf,lds_cptr kp){
  kf[0]=*(const __attribute__((address_space(3))) bf16x8*)(kp);      kf[1]=*(const __attribute__((address_space(3))) bf16x8*)(kp+512);
  kf[2]=*(const __attribute__((address_space(3))) bf16x8*)(kp+2048); kf[3]=*(const __attribute__((address_space(3))) bf16x8*)(kp+2560);
  kf[4]=*(const __attribute__((address_space(3))) bf16x8*)(kp+4096); kf[5]=*(const __attribute__((address_space(3))) bf16x8*)(kp+4608);
  kf[6]=*(const __attribute__((address_space(3))) bf16x8*)(kp+6144); kf[7]=*(const __attribute__((address_space(3))) bf16x8*)(kp+6656);
}
__device__ __forceinline__ void kload2(bf16x8*kf,lds_cptr kp,int j){ kf[2*j]=*(const __attribute__((address_space(3))) bf16x8*)(kp+j*2048); kf[2*j+1]=*(const __attribute__((address_space(3))) bf16x8*)(kp+j*2048+512); }
__device__ __forceinline__ s16x4 vtr(lds_cptr p){ return __builtin_bit_cast(s16x4,__builtin_amdgcn_ds_read_tr16_b64_v4i16((__attribute__((address_space(3))) v4i16_t*)p)); }
__device__ __forceinline__ float rowmax(const f32x16&p0,const f32x16&p1){
  float a=max3f(p0[0],p0[1],p1[0]),b=max3f(p0[2],p0[3],p1[1]);a=max3f(a,p1[2],p1[3]);
  #pragma unroll
  for(int r=4;r<16;r+=4){a=max3f(a,p0[r],p0[r+1]);b=max3f(b,p0[r+2],p0[r+3]);a=max3f(a,p1[r],p1[r+1]);b=max3f(b,p1[r+2],p1[r+3]);}
  const float m=max2f(a,b);
  auto rr=__builtin_amdgcn_permlane32_swap(__float_as_uint(m),__float_as_uint(m),false,false);
  return max2f(__uint_as_float(rr[0]),__uint_as_float(rr[1]));
}
__device__ __forceinline__ void pv(f32x16*o,int vb,bf16x8 pa0,bf16x8 pa1,bf16x8 pa2,bf16x8 pa3){
  #pragma unroll
  for(int d0=0;d0<2;++d0){s16x4 lo[4],hi[4];
    #pragma unroll
    for(int ks=0;ks<4;++ks){
      asm volatile("ds_read_b64_tr_b16 %0,%1 offset:%c2":"=&v"(lo[ks]):"v"(vb),"i"(d0*4096+ks*1024):"memory");
      asm volatile("ds_read_b64_tr_b16 %0,%1 offset:%c2":"=&v"(hi[ks]):"v"(vb),"i"(d0*4096+ks*1024+512):"memory");}
    asm volatile("s_waitcnt lgkmcnt(0)":::"memory");SBAR();
    #define PK(k) (bf16x8){lo[k][0],lo[k][1],lo[k][2],lo[k][3],hi[k][0],hi[k][1],hi[k][2],hi[k][3]}
    o[d0]=__builtin_amdgcn_mfma_f32_32x32x16_bf16(pa0,PK(0),o[d0],0,0,0);
    o[d0]=__builtin_amdgcn_mfma_f32_32x32x16_bf16(pa1,PK(1),o[d0],0,0,0);
    o[d0]=__builtin_amdgcn_mfma_f32_32x32x16_bf16(pa2,PK(2),o[d0],0,0,0);
    o[d0]=__builtin_amdgcn_mfma_f32_32x32x16_bf16(pa3,PK(3),o[d0],0,0,0);
    #undef PK
  }
}

#ifndef ATTN_STORE16
#define ATTN_STORE16(p,v) (*(u32x4*)(p)=(v))
#endif
__device__ __forceinline__ unsigned bfbits(float f){unsigned u=__builtin_bit_cast(unsigned,f);return (u+0x7fffu+((u>>16)&1u))>>16;}
__device__ __forceinline__ void split3(float x,unsigned&h1,unsigned&h2,unsigned&h3){h1=bfbits(x);const float r1=x-__uint_as_float(h1<<16);h2=bfbits(r1);const float r2=r1-__uint_as_float(h2<<16);h3=bfbits(r2);}
template<int THRL> __device__ __forceinline__ void attn_unit(int b,int h,int qb,const bf16*Q,const bf16*__restrict__ K,const bf16*__restrict__ V,bf16*O,const float*cumbh,const float*gnorm,char*shm){
  const int tid=threadIdx.x,lane=tid&63,r32=lane&31,hi=lane>>5; const int wid=__builtin_amdgcn_readfirstlane(tid>>6);
  const long rowbase=(long)b*SEQ; const int q0=qb*QB;
  const bf16*Qw=Q+(rowbase+q0+wid*QBLK)*DM+h*D;
  const bf16*Kh=K+rowbase*DM+h*D,*Vh=V+rowbase*DM+h*D;
  const unsigned lds0=(unsigned)(uintptr_t)shm;
  float*wsf=(float*)(shm+LDS_WS)+wid*64;
  { const float cref=cumbh[q0]; u32x4*kbw=(u32x4*)(shm+LDS_KB);
    for(int i=tid;i<q0+QB;i+=NW*64){ const float kb=(cref-cumbh[i])*1.4426950408889634f; unsigned h1,h2,h3; split3(kb,h1,h2,h3); kbw[i]=(u32x4){h1|(h2<<16),h3|0x3F800000u,0x3F803F80u,0u}; } }
  const bf16*ksrc=Kh+(long)lane*DM+wid*8;
  const bf16*vsrc=Vh+(long)(16*(wid&3)+(lane>>2))*DM+(wid>>2)*32+(lane&3)*8;
  const unsigned kdst=lds0+LDS_K+wid*1024, vdst=lds0+LDS_V+wid*1024;
  #define DMA_K(t,slot) glds16(ksrc+(long)(t)*KVBLK*DM,(unsigned)__builtin_amdgcn_readfirstlane(kdst+(slot)))
  #define DMA_V(t,slot) glds16(vsrc+(long)(t)*KVBLK*DM,(unsigned)__builtin_amdgcn_readfirstlane(vdst+(slot)))
  const int vb0=(int)(lds0+LDS_V)+((lane>>4)&1)*32+(lane&3)*8+(4*hi+((lane&15)>>2))*64;
  const char*Kbase=shm+LDS_K; bf16x8 kf[8];
  const lds_cptr shm3=(lds_cptr)shm; const lds_cptr kp0=shm3+LDS_K+hi*1024+r32*16; const lds_cptr vp0=shm3+LDS_V+((lane>>4)&1)*32+(lane&3)*8+(4*hi+((lane&15)>>2))*64;
  const int NT=(q0+QB)/KVBLK;
  DMA_K(0,0);DMA_V(0,0);DMA_K(1,SLOTB);
  bf16x8 qr[4];
  #pragma unroll
  for(int d0=0;d0<4;++d0)qr[d0]=*reinterpret_cast<const bf16x8*>(&Qw[(long)r32*DM+d0*16+hi*8]);
  float mhat=0.f,l_reg=0.f;f32x16 o[2];o[0]=f32x16{};o[1]=f32x16{};u32x4 qbw=(u32x4){hi?0u:0x3F803F80u,hi?0u:0x3F80u,0u,0u};
  const lds_cptr kbp0=(lds_cptr)shm+LDS_KB+r32*16;
  #define QBF __builtin_bit_cast(bf16x8,qbw)
  #define KBLD(t,p) (*(const __attribute__((address_space(3))) bf16x8*)(kbp0+((t)*64+(p)*32)*16))
  #define SETQB() do{ unsigned h1_,h2_,h3_; split3(-mhat,h1_,h2_,h3_); qbw[1]=hi?0u:(0x3F80u|(h1_<<16)); qbw[2]=hi?0u:(h2_|(h3_<<16)); asm volatile("":"+v"(qbw)); }while(0)
  const int qrel=wid*QBLK+r32;
  #define CMASK(P0,P1,t) do{int jb_=(t)-(NT-4); if(jb_>=0)cmask(P0,P1,jb_,qrel,hi);}while(0)
  bool resc=false;
  #define START(P0,P1) do{ const float rm=rowmax(P0,P1); resc=false; \
    { const float dl=rm; mhat=fadd_s(mhat,dl); \
      _Pragma("unroll") for(int r=0;r<16;++r){P0[r]=fsub_s(P0[r],dl);P1[r]=fsub_s(P1[r],dl);} \
      SETQB(); } \
    _Pragma("unroll") for(int r=0;r<16;++r)P0[r]=__builtin_amdgcn_exp2f(P0[r]); }while(0)
  #define RESC() do{ if(resc){ asm volatile("s_waitcnt lgkmcnt(0)":::"memory"); \
      _Pragma("unroll") for(int d_=0;d_<2;++d_) _Pragma("unroll") for(int r=0;r<16;++r)o[d_][r]*=wsf[crow(r,hi)]; } }while(0)
  f32x16 pA0,pA1,pB0,pB1;
  int sl_prev=0,sl_cur=0,sl_next=SLOTB;
  #define ROT() do{sl_prev=sl_cur;sl_cur=sl_next;sl_next=(sl_next==(NSLOT-1)*SLOTB)?0:sl_next+SLOTB;}while(0)
  DMA_K(2,2*SLOTB);
  WAIT_BAR(3);
  qkt(pA0,pA1,Kbase,qr,KBLD(0,0),KBLD(0,1),QBF,r32,hi);asm volatile("s_nop 15\n\ts_nop 7":"+v"(pA0),"+v"(pA1));CMASK(pA0,pA1,0);
  START(pA0,pA1);
  _Pragma("unroll") for(int r=0;r<16;++r)pA1[r]=__builtin_amdgcn_exp2f(pA1[r]);
  WAIT_BAR(0);
  DMA_K(3,0);DMA_V(1,SLOTB);
  ROT();
  kload8(kf,kp0+sl_cur);
  WAIT_BAR(2);
  s16x4 vlo[8],vhi[8]; u32x4 pw0,pw1,pw2,pw3;
  #define PKW(P,B) cvtpk_s(P[B],P[B+1])
  #define PAF(k) __builtin_bit_cast(bf16x8,pw##k)
  #define VFR(i) (bf16x8){vlo[i][0],vlo[i][1],vlo[i][2],vlo[i][3],vhi[i][0],vhi[i][1],vhi[i][2],vhi[i][3]}
  #define PIN(x) asm volatile("":"+v"(x))
  #define MX3(a,b,c) __builtin_fmaxf(__builtin_fmaxf((a),(b)),(c))
  #define GAPA(MF,A0,A1,A2,A3,W0,W1,PW) do{ MF; sacc+=A0; sacc+=A1; sacc+=A2; sacc+=A3; PIN(sacc); W0; W1; PIN(PW); SBAR(); }while(0)
  #define EX(v) __builtin_amdgcn_exp2f(v)
  #define GAPB(MF,X,B) do{ MF; X[B]=EX(X[B]); X[B+1]=EX(X[B+1]); X[B+2]=EX(X[B+2]); X[B+3]=EX(X[B+3]); PIN(X); SBAR(); }while(0)
  #define VRD(i) do{ vlo[i]=vtr(vp_+(((i)>>2)*4096+((i)&3)*1024)); vhi[i]=vtr(vp_+(((i)>>2)*4096+((i)&3)*1024+512)); }while(0)
  #define KRD(G,j) do{ if(G){ kload2(kf,kp0+sl_next,j); SBAR(); } }while(0)
  #define STEP(C0,C1,P0,P1,t,GK,GV,GL) do{ SBAR(); \
    const lds_cptr vp_=vp0+sl_prev; \
    { const bf16x8 ka0_=KBLD(t,0), ka1_=KBLD(t,1); VRD(0); SBAR(); \
      C0=__builtin_amdgcn_mfma_f32_32x32x16_bf16(ka0_,QBF,f32x16{},0,0,0); C1=__builtin_amdgcn_mfma_f32_32x32x16_bf16(ka1_,QBF,f32x16{},0,0,0); SBAR(); } \
    float sacc=(P0[0]+P0[1]); \
    GAPA(C0=__builtin_amdgcn_mfma_f32_32x32x16_bf16(kf[0],qr[0],C0,0,0,0), P0[2],P0[3],P0[4],P0[5],     pw0[0]=PKW(P0,0), pw0[1]=PKW(P0,2), pw0); \
    VRD(4); SBAR(); GAPA(C1=__builtin_amdgcn_mfma_f32_32x32x16_bf16(kf[1],qr[0],C1,0,0,0), P0[6],P0[7],P0[8],P0[9],     pw0[2]=PKW(P0,4), pw0[3]=PKW(P0,6), pw0); \
    VRD(1); SBAR(); GAPA(C0=__builtin_amdgcn_mfma_f32_32x32x16_bf16(kf[2],qr[1],C0,0,0,0),   P0[10],P0[11],P0[12],P0[13], pw1[0]=PKW(P0,8), pw1[1]=PKW(P0,10), pw1); \
    VRD(5); SBAR(); GAPA(C1=__builtin_amdgcn_mfma_f32_32x32x16_bf16(kf[3],qr[1],C1,0,0,0),   P0[14],P0[15],P1[0],P1[1],   pw1[2]=PKW(P0,12),pw1[3]=PKW(P0,14), pw1); \
    VRD(2); SBAR(); GAPA(C0=__builtin_amdgcn_mfma_f32_32x32x16_bf16(kf[4],qr[2],C0,0,0,0),   P1[2],P1[3],P1[4],P1[5],     pw2[0]=PKW(P1,0), pw2[1]=PKW(P1,2), pw2); \
    VRD(6); SBAR(); GAPA(C1=__builtin_amdgcn_mfma_f32_32x32x16_bf16(kf[5],qr[2],C1,0,0,0),   P1[6],P1[7],P1[8],P1[9],     pw2[2]=PKW(P1,4), pw2[3]=PKW(P1,6), pw2); \
    VRD(3); SBAR(); GAPA(C0=__builtin_amdgcn_mfma_f32_32x32x16_bf16(kf[6],qr[3],C0,0,0,0),   P1[10],P1[11],P1[12],P1[13], pw3[0]=PKW(P1,8), pw3[1]=PKW(P1,10), pw3); \
    VRD(7); SBAR(); GAPA(C1=__builtin_amdgcn_mfma_f32_32x32x16_bf16(kf[7],qr[3],C1,0,0,0),   P1[14],P1[15],0.f,0.f,       pw3[2]=PKW(P1,12),pw3[3]=PKW(P1,14), pw3); \
    l_reg+=sacc; \
    if(GK){DMA_K((t)+3,sl_cur);} if(GV){DMA_V((t)+1,sl_next);} \
    CMASK(C0,C1,t); \
    { float a=MX3(C0[0],C0[1],C1[0]),b=MX3(C0[2],C0[3],C1[1]); a=MX3(a,C1[2],C1[3]); \
      _Pragma("unroll") for(int r=4;r<16;r+=4){a=MX3(a,C0[r],C0[r+1]);b=MX3(b,C0[r+2],C0[r+3]);a=MX3(a,C1[r],C1[r+1]);b=MX3(b,C1[r+2],C1[r+3]);} \
      float rm=__builtin_fmaxf(a,b); { auto rr=__builtin_amdgcn_permlane32_swap(__float_as_uint(rm),__float_as_uint(rm),false,false); rm=__builtin_fmaxf(__uint_as_float(rr[0]),__uint_as_float(rr[1])); } \
      resc=false; \
      if(__builtin_expect(__any(rm>(float)THRL),0)){ const float dl=__builtin_fmaxf(rm,0.f); mhat+=dl; \
        _Pragma("unroll") for(int r=0;r<16;++r){C0[r]-=dl;C1[r]-=dl;} \
        SETQB(); \
        const float f=__builtin_amdgcn_exp2f(-dl); l_reg*=f; if(hi==0)wsf[r32]=f; resc=true; } } \
    SBAR(); \
    GAPB(o[0]=__builtin_amdgcn_mfma_f32_32x32x16_bf16(PAF(0),VFR(0),o[0],0,0,0), C0,0); \
    GAPB(o[1]=__builtin_amdgcn_mfma_f32_32x32x16_bf16(PAF(0),VFR(4),o[1],0,0,0), C0,4); \
    KRD(GL,0); GAPB(o[0]=__builtin_amdgcn_mfma_f32_32x32x16_bf16(PAF(1),VFR(1),o[0],0,0,0), C0,8); \
    KRD(GL,1); GAPB(o[1]=__builtin_amdgcn_mfma_f32_32x32x16_bf16(PAF(1),VFR(5),o[1],0,0,0), C0,12); \
    KRD(GL,2); GAPB(o[0]=__builtin_amdgcn_mfma_f32_32x32x16_bf16(PAF(2),VFR(2),o[0],0,0,0), C1,0); \
    KRD(GL,3); GAPB(o[1]=__builtin_amdgcn_mfma_f32_32x32x16_bf16(PAF(2),VFR(6),o[1],0,0,0), C1,4); \
    GAPB(o[0]=__builtin_amdgcn_mfma_f32_32x32x16_bf16(PAF(3),VFR(3),o[0],0,0,0), C1,8); \
    GAPB(o[1]=__builtin_amdgcn_mfma_f32_32x32x16_bf16(PAF(3),VFR(7),o[1],0,0,0), C1,12); \
    }while(0)
  int t=1;
  #undef CMASK
  #define CMASK(P0,P1,t) do{}while(0)
  for(;t+5<NT;t+=2){
    STEP(pB0,pB1,pA0,pA1,t,true,true,true);     WAIT_BAR(2); RESC(); ROT();
    STEP(pA0,pA1,pB0,pB1,t+1,true,true,true);   WAIT_BAR(2); RESC(); ROT();
  }
  #undef CMASK
  #define CMASK(P0,P1,t) do{int jb_=(t)-(NT-4); if(jb_>=0)cmask(P0,P1,jb_,qrel,hi);}while(0)
  #define ENDW(tt) do{ if((tt)+3<NT){WAIT_BAR(2);} else if((tt)+2<NT){WAIT_BAR(1);} else {WAIT_BAR(0);} }while(0)
  for(;t+1<NT;t+=2){
    STEP(pB0,pB1,pA0,pA1,t,(t+3<NT),(t+1<NT),(t+1<NT));       ENDW(t);   RESC(); ROT();
    STEP(pA0,pA1,pB0,pB1,t+1,(t+4<NT),(t+2<NT),(t+2<NT));     ENDW(t+1); RESC(); ROT();
  }
  STEP(pB0,pB1,pA0,pA1,NT-1,false,false,false); RESC();
  { float sacc=pB0[0]+pB0[1]; _Pragma("unroll") for(int r=2;r<16;++r)sacc+=pB0[r]; _Pragma("unroll") for(int r=0;r<16;++r)sacc+=pB1[r]; l_reg+=sacc;
    pw0=(u32x4){PKW(pB0,0),PKW(pB0,2),PKW(pB0,4),PKW(pB0,6)};pw1=(u32x4){PKW(pB0,8),PKW(pB0,10),PKW(pB0,12),PKW(pB0,14)};pw2=(u32x4){PKW(pB1,0),PKW(pB1,2),PKW(pB1,4),PKW(pB1,6)};pw3=(u32x4){PKW(pB1,8),PKW(pB1,10),PKW(pB1,12),PKW(pB1,14)};
    SBAR(); pv(o,vb0+sl_cur,PAF(0),PAF(1),PAF(2),PAF(3)); }
  #undef PKW
  #undef PAF
  #undef VFR
  #undef PIN
  #undef MX3
  #undef GAPA
  #undef GAPB
  #undef EX
  #undef VRD
  #undef KRD
  #undef STEP
  #undef ENDW
  {auto rr=__builtin_amdgcn_permlane32_swap(__float_as_uint(l_reg),__float_as_uint(l_reg),false,false);l_reg=__uint_as_float(rr[0])+__uint_as_float(rr[1]);}
  if(hi==0)wsf[32+r32]=l_reg;asm volatile("s_waitcnt lgkmcnt(0)":::"memory");
  float rli[16];
  #pragma unroll
  for(int r=0;r<16;++r)rli[r]=__builtin_amdgcn_rcpf(wsf[32+crow(r,hi)]);
  bf16*Ow=O+(rowbase+q0+wid*QBLK)*OPITCH+h*D;
  float gn[8];
  #pragma unroll
  for(int j=0;j<8;++j)gn[j]=gnorm[(lane&7)*8+j];
  { bf16*stg=(bf16*)(shm+LDS_OST)+wid*2048;
    #pragma unroll
    for(int r=0;r<16;++r){const int orow=crow(r,hi);
      #pragma unroll
      for(int d0=0;d0<2;++d0)stg[orow*64+d0*32+r32]=__float2bfloat16(o[d0][r]*rli[r]);}
    asm volatile("s_waitcnt lgkmcnt(0)":::"memory");
    #pragma unroll
    for(int i=0;i<4;++i){const int row=i*8+(lane>>3),ch=lane&7; const u32x4 v=*(const u32x4*)(stg+row*64+ch*8);
      float f[8];
      #pragma unroll
      for(int j=0;j<4;++j){f[2*j]=__uint_as_float(v[j]<<16);f[2*j+1]=__uint_as_float(v[j]&0xffff0000u);}
      float ss=0.f;
      #pragma unroll
      for(int j=0;j<8;++j)ss+=f[j]*f[j];
      ss+=__shfl_xor(ss,1);ss+=__shfl_xor(ss,2);ss+=__shfl_xor(ss,4);
      const float rs=__builtin_amdgcn_rsqf(ss*(1.f/64.f)+1e-6f);
      u32x4 w;
      #pragma unroll
      for(int j=0;j<4;++j)w[j]=cvtpk_s(f[2*j]*rs*gn[2*j],f[2*j+1]*rs*gn[2*j+1]);
      ATTN_STORE16(Ow+(long)row*OPITCH+ch*8,w);} }
  asm volatile("s_waitcnt lgkmcnt(0)\n\ts_barrier":::"memory");
  #undef DMA_K
  #undef DMA_V
  #undef QBF
  #undef KBLD
  #undef SETQB
  #undef CMASK
  #undef START
  #undef RESC
  #undef ROT
}
constexpr int ATTN_LDS_BYTES=LDS_BYTES;
struct AttnTensors { const bf16* Q; const bf16* K; const bf16* V; bf16* O; const float* cum; const float* gnorm; };
struct AttnUnit { int bh; int qb; };
struct StaticOrder {
  int vcu;
  __device__ __forceinline__ explicit StaticOrder(int grid,int block):vcu((block%8)*(grid/8)+block/8){}
  __device__ __forceinline__ bool next(int i,AttnUnit&u)const{ if(i>=2)return false; const int s=vcu&3; u.bh=vcu>>2; u.qb=(i==0)?7-s:s; return true; }
  __device__ __forceinline__ void a_ready(const AttnUnit&)const{}
  __device__ __forceinline__ void done(const AttnUnit&)const{}
};
template<class Sched,int THRL=8> __device__ __forceinline__ void attn_phase(char*lds,const AttnTensors&T,const Sched&S){
  AttnUnit u;
  for(int i=0;S.next(i,u);++i){ S.a_ready(u); attn_unit<THRL>(u.bh/NHEAD,u.bh%NHEAD,u.qb,T.Q,T.K,T.V,T.O,T.cum+(long)u.bh*SEQ,T.gnorm,lds); S.done(u); }
}
#undef SBAR
#undef WAIT_BAR
}
namespace gdn {
typedef unsigned short bf16_t;
typedef short bf16x8 __attribute__((ext_vector_type(8)));
typedef float f32x16 __attribute__((ext_vector_type(16)));
typedef float f32x4 __attribute__((ext_vector_type(4)));
typedef float f32x2 __attribute__((ext_vector_type(2)));
typedef unsigned u32x4 __attribute__((ext_vector_type(4)));
typedef unsigned u32x2 __attribute__((ext_vector_type(2)));
typedef __bf16 bf16x2_t __attribute__((ext_vector_type(2)));
#define GLAS __attribute__((address_space(3)))
constexpr int CH = 64, DK = 128, NCH = 32, NITEM = 8 * 4 * NCH, FRAGS = 56, ITEM_ELEMS = FRAGS * 512;
constexpr float L2E = 1.4426950408889634f;
__device__ __forceinline__ int crow(int r, int hi) { return (r & 3) + 8 * (r >> 2) + 4 * hi; }
__device__ __forceinline__ float bf2f(unsigned short u) { return __uint_as_float((unsigned)u << 16); }
__device__ __forceinline__ unsigned cvtpk(float lo, float hi) { f32x2 v = {lo, hi}; bf16x2_t b = __builtin_convertvector(v, bf16x2_t); return __builtin_bit_cast(unsigned, b); }
__device__ __forceinline__ unsigned short f2bf1(float x) { return (unsigned short)(cvtpk(x, 0.f) & 0xffffu); }
__device__ __forceinline__ int frag_off(int r, int kl) { return ((((kl >> 2) & 1) * 32 + r) << 3) + ((kl >> 3) << 2) + (kl & 3); }
__device__ __forceinline__ float silu_f(float y) { return y * __builtin_amdgcn_rcpf(1.f + __expf(-y)); }

constexpr int L_QS = 0, L_KS = 16384, L_MM = 32768, MM_LD = 68, L_SC = L_MM + CH * MM_LD * 4, SLOT_BYTES = 65536;
static_assert(L_SC + 4 * 64 * 4 <= SLOT_BYTES, "gdn LDS slot");
__device__ __forceinline__ int swz(int row, int c16) { return row * 256 + ((c16 ^ (row & 15)) << 4); }

struct G1Args { const bf16_t *GQ, *GK, *GV; const float *small, *cw, *a_log, *dt_bias; float* U; bf16_t* FR; float* GL; };

__device__ __forceinline__ void conv64(const bf16_t* src, bool first, float c0, float c1, float c2, float c3, float (&y)[64]) {
    float x0 = 0.f, x1 = 0.f, x2 = 0.f;
    if (!first) { x0 = bf2f(src[-3 * 512]); x1 = bf2f(src[-2 * 512]); x2 = bf2f(src[-1 * 512]); }
#pragma unroll
    for (int g = 0; g < 4; ++g) {
#pragma unroll
        for (int i = 16 * g; i < 16 * g + 16; ++i) { const float xi = bf2f(src[i * 512]); y[i] = silu_f(c0 * x0 + c1 * x1 + c2 * x2 + c3 * xi); x0 = x1; x1 = x2; x2 = xi; }
        asm volatile("" ::: "memory");
    }
}
__device__ __forceinline__ void conv64_lds(const bf16_t* src, bool first, float c0, float c1, float c2, float c3, GLAS unsigned char* img, int c) {
    float x0 = 0.f, x1 = 0.f, x2 = 0.f;
    if (!first) { x0 = bf2f(src[-3 * 512]); x1 = bf2f(src[-2 * 512]); x2 = bf2f(src[-1 * 512]); }
#pragma unroll
    for (int g = 0; g < 4; ++g) {
#pragma unroll
        for (int i = 16 * g; i < 16 * g + 16; ++i) { const float xi = bf2f(src[i * 512]); *(GLAS bf16_t*)(img + swz(i, c >> 3) + (c & 7) * 2) = f2bf1(silu_f(c0 * x0 + c1 * x1 + c2 * x2 + c3 * xi)); x0 = x1; x1 = x2; x2 = xi; }
        asm volatile("" ::: "memory");
    }
}

__device__ __forceinline__ void g1_pair(const G1Args& A, int pair, GLAS unsigned char* lds0) {
    int tid = threadIdx.x; asm volatile("" : "+v"(tid));
    const int lane = tid & 63, wave = __builtin_amdgcn_readfirstlane(tid >> 6), isl = wave >> 2, lw = wave & 3, lt = tid & 255;
    const int item = pair * 2 + isl, bh = item >> 5, n = item & 31, b = bh >> 2, h = bh & 3;
    const size_t m0 = (size_t)b * 2048 + (size_t)n * 64;
    GLAS unsigned char* lds = lds0 + isl * SLOT_BYTES;
    GLAS float* SC = (GLAS float*)(lds + L_SC);
    GLAS float* MM = (GLAS float*)(lds + L_MM);
    bf16_t* fr = A.FR + (size_t)item * ITEM_ELEMS;
    const bool first = (n == 0);
    float y[64];
    {
        const int which = (lw < 2) ? 2 : 1, c = (lw & 1) * 64 + lane, cc = which * 512 + h * 128 + c;
        const bf16_t* src = ((lw < 2) ? A.GV : A.GK) + m0 * 512 + h * 128 + c;
        conv64(src, first, A.cw[cc], A.cw[1536 + cc], A.cw[2 * 1536 + cc], A.cw[3 * 1536 + cc], y);
        if (lw >= 2) {
#pragma unroll
            for (int i = 0; i < 64; ++i) *(GLAS bf16_t*)(lds + L_KS + swz(i, c >> 3) + (c & 7) * 2) = f2bf1(y[i]);
        }
    }
    if (lw < 2) {
        const int c = lw * 64 + lane, cc = h * 128 + c;
        conv64_lds(A.GQ + m0 * 512 + h * 128 + c, first, A.cw[cc], A.cw[1536 + cc], A.cw[2 * 1536 + cc], A.cw[3 * 1536 + cc], lds + L_QS, c);
    } else if (lw == 2) {
        const float gb = A.small[(m0 + lane) * 16 + 8 + h], ga = A.small[(m0 + lane) * 16 + 12 + h] + A.dt_bias[h];
        const float sp = fmaxf(ga, 0.f) + log1pf(__expf(-fabsf(ga)));
        float g = -__expf(A.a_log[h]) * sp;
#pragma unroll
        for (int o = 1; o < 64; o <<= 1) { const float t = __shfl_up(g, o); if (lane >= o) g += t; }
        SC[128 + lane] = 1.f / (1.f + __expf(-gb));
        SC[192 + lane] = g;
        if (lane == 63) A.GL[item] = __builtin_amdgcn_exp2f(g * L2E);
    }
    __syncthreads();
    {
        const int r = lt >> 2, qd = lt & 3; float sq = 0.f, sk = 0.f;
#pragma unroll
        for (int jj = 0; jj < 4; ++jj) {
            const u32x4 vq = *(const GLAS u32x4*)(lds + L_QS + swz(r, qd * 4 + jj)), vk = *(const GLAS u32x4*)(lds + L_KS + swz(r, qd * 4 + jj));
#pragma unroll
            for (int e = 0; e < 4; ++e) { const float a0 = __uint_as_float(vq[e] << 16), a1 = __uint_as_float(vq[e] & 0xffff0000u), b0 = __uint_as_float(vk[e] << 16), b1 = __uint_as_float(vk[e] & 0xffff0000u);
                sq += a0 * a0 + a1 * a1; sk += b0 * b0 + b1 * b1; }
        }
        sq += __shfl_xor(sq, 1); sq += __shfl_xor(sq, 2); sk += __shfl_xor(sk, 1); sk += __shfl_xor(sk, 2);
        if (qd == 0) { SC[r] = rsqrtf(sq + 1e-6f) * 0.08838834764831845f; SC[64 + r] = rsqrtf(sk + 1e-6f); }
    }
    __syncthreads();
    {
        const int ti = lw >> 1, tj = lw & 1, r32 = lane & 31, hi = lane >> 5;
        f32x16 kk = {}, qk = {};
#pragma unroll
        for (int s = 0; s < 8; ++s) {
            const bf16x8 aK = *(const GLAS bf16x8*)(lds + L_KS + swz(32 * ti + r32, 2 * s + hi)), aQ = *(const GLAS bf16x8*)(lds + L_QS + swz(32 * ti + r32, 2 * s + hi));
            const bf16x8 bK = *(const GLAS bf16x8*)(lds + L_KS + swz(32 * tj + r32, 2 * s + hi));
            kk = __builtin_amdgcn_mfma_f32_32x32x16_bf16(aK, bK, kk, 0, 0, 0); qk = __builtin_amdgcn_mfma_f32_32x32x16_bf16(aQ, bK, qk, 0, 0, 0);
        }
        const int j = 32 * tj + r32; const float rkj = SC[64 + j], gcj = SC[192 + j];
        bf16_t* af = fr + (32 + ti * 4 + (j >> 4)) * 512;
#pragma unroll
        for (int r = 0; r < 16; ++r) {
            const int il = crow(r, hi), i = 32 * ti + il;
            const float e = __builtin_amdgcn_exp2f(fminf(SC[192 + i] - gcj, 0.f) * L2E);
            const float mv = (i > j) ? SC[128 + i] * SC[64 + i] * rkj * kk[r] * e : 0.f;
            const float av = (i >= j) ? SC[i] * rkj * qk[r] * e : 0.f;
            MM[i * MM_LD + j] = mv;
            af[frag_off(il, j & 15)] = f2bf1(av);
        }
    }
    __syncthreads();
    {
        const int c = (lw & 1) * 64 + lane;
        if (lw >= 2) {
            const float gl = SC[192 + 63];
            const int T = c >> 5, r = c & 31;
#pragma unroll
            for (int ks = 0; ks < 4; ++ks)
#pragma unroll
                for (int hh = 0; hh < 2; ++hh) {
                    float kd[8];
#pragma unroll
                    for (int a = 0; a < 2; ++a)
#pragma unroll
                        for (int bq = 0; bq < 4; ++bq) { const int i = 16 * ks + 8 * a + 4 * hh + bq; kd[4 * a + bq] = y[i] * SC[64 + i] * __builtin_amdgcn_exp2f((gl - SC[192 + i]) * L2E); }
                    u32x4 w; w.x = cvtpk(kd[0], kd[1]); w.y = cvtpk(kd[2], kd[3]); w.z = cvtpk(kd[4], kd[5]); w.w = cvtpk(kd[6], kd[7]);
                    *(u32x4*)(fr + (40 + T * 4 + ks) * 512 + ((hh * 32 + r) << 3)) = w;
                }
#pragma unroll
            for (int i = 0; i < 64; ++i) y[i] = y[i] * SC[64 + i] * SC[128 + i] * __builtin_amdgcn_exp2f(SC[192 + i] * L2E);
        } else {
#pragma unroll
            for (int i = 0; i < 64; ++i) y[i] *= SC[128 + i];
        }
#pragma unroll
        for (int i = 1; i < 64; ++i) {
            float acc = y[i];
#pragma unroll
            for (int j4 = 0; j4 < (i + 3) / 4; ++j4) {
                const f32x4 m = *(const GLAS f32x4*)(MM + i * MM_LD + 4 * j4);
                acc -= m[0] * y[4 * j4];
                if (4 * j4 + 1 < i) acc -= m[1] * y[4 * j4 + 1];
                if (4 * j4 + 2 < i) acc -= m[2] * y[4 * j4 + 2];
                if (4 * j4 + 3 < i) acc -= m[3] * y[4 * j4 + 3];
            }
            y[i] = acc;
        }
        if (lw >= 2) {
            const int ks = c >> 4, kl = c & 15;
#pragma unroll
            for (int i = 0; i < 64; ++i) fr[((i >> 5) * 8 + ks) * 512 + frag_off(i & 31, kl)] = f2bf1(-y[i]);
        } else {
            float* up = A.U + m0 * 512 + h * 128 + c;
#pragma unroll
            for (int i = 0; i < 64; ++i) up[(size_t)i * 512] = y[i];
        }
        const int r = lt >> 2, qd = lt & 3; const float sc = SC[r] * __builtin_amdgcn_exp2f(SC[192 + r] * L2E);
#pragma unroll
        for (int jj = 0; jj < 4; ++jj) {
            const int c16 = qd * 4 + jj; const u32x4 vq = *(const GLAS u32x4*)(lds + L_QS + swz(r, c16));
            float f[8];
#pragma unroll
            for (int e = 0; e < 4; ++e) { f[2 * e] = __uint_as_float(vq[e] << 16) * sc; f[2 * e + 1] = __uint_as_float(vq[e] & 0xffff0000u) * sc; }
            bf16_t* qf = fr + (16 + (r >> 5) * 8 + (c16 >> 1)) * 512;
            u32x2 w0, w1; w0.x = cvtpk(f[0], f[1]); w0.y = cvtpk(f[2], f[3]); w1.x = cvtpk(f[4], f[5]); w1.y = cvtpk(f[6], f[7]);
            *(u32x2*)(qf + frag_off(r & 31, 8 * (c16 & 1))) = w0;
            *(u32x2*)(qf + frag_off(r & 31, 8 * (c16 & 1) + 4)) = w1;
        }
    }
    __syncthreads();
}

__device__ __forceinline__ void scan_wave(int bh, int slice, float* U, const bf16_t* FR, const float* GL, int lane) {
    const int b = bh >> 2, h = bh & 3, r32 = lane & 31, hi = lane >> 5;
    f32x16 S[4];
#pragma unroll
    for (int T = 0; T < 4; ++T) S[T] = f32x16{};
    float* ub = U + (size_t)b * 2048 * 512 + h * 128 + slice * 32 + r32;
    for (int n = 0; n < NCH; ++n) {
        const int item = bh * NCH + n;
        const bf16x8* fb = (const bf16x8*)(FR + (size_t)item * ITEM_ELEMS) + lane;
        float* ut = ub + (size_t)n * 64 * 512;
        const float gl = GL[item];
        bf16x8 sf[4][2];
#pragma unroll
        for (int T = 0; T < 4; ++T)
#pragma unroll
            for (int s = 0; s < 2; ++s) { u32x4 p;
#pragma unroll
                for (int e = 0; e < 4; ++e) p[e] = cvtpk(S[T][8 * s + 2 * e], S[T][8 * s + 2 * e + 1]);
                sf[T][s] = __builtin_bit_cast(bf16x8, p); }
        f32x16 VN[2];
#pragma unroll
        for (int I = 0; I < 2; ++I) {
#pragma unroll
            for (int r = 0; r < 16; ++r) VN[I][r] = ut[(size_t)(32 * I + crow(r, hi)) * 512];
#pragma unroll
            for (int ks = 0; ks < 8; ++ks) VN[I] = __builtin_amdgcn_mfma_f32_32x32x16_bf16(fb[(I * 8 + ks) * 64], sf[ks >> 1][ks & 1], VN[I], 0, 0, 0);
        }
        bf16x8 vf[2][2];
#pragma unroll
        for (int J = 0; J < 2; ++J)
#pragma unroll
            for (int s = 0; s < 2; ++s) { u32x4 p;
#pragma unroll
                for (int e = 0; e < 4; ++e) p[e] = cvtpk(VN[J][8 * s + 2 * e], VN[J][8 * s + 2 * e + 1]);
                vf[J][s] = __builtin_bit_cast(bf16x8, p); }
#pragma unroll
        for (int I = 0; I < 2; ++I) {
            f32x16 O = {};
#pragma unroll
            for (int ks = 0; ks < 8; ++ks) O = __builtin_amdgcn_mfma_f32_32x32x16_bf16(fb[(16 + I * 8 + ks) * 64], sf[ks >> 1][ks & 1], O, 0, 0, 0);
#pragma unroll
            for (int ks = 0; ks < 2 * (I + 1); ++ks) O = __builtin_amdgcn_mfma_f32_32x32x16_bf16(fb[(32 + I * 4 + ks) * 64], vf[ks >> 1][ks & 1], O, 0, 0, 0);
#pragma unroll
            for (int r = 0; r < 16; ++r) ut[(size_t)(32 * I + crow(r, hi)) * 512] = O[r];
        }
#pragma unroll
        for (int T = 0; T < 4; ++T) {
            S[T] = S[T] * gl;
#pragma unroll
            for (int ks = 0; ks < 4; ++ks) S[T] = __builtin_amdgcn_mfma_f32_32x32x16_bf16(fb[(40 + T * 4 + ks) * 64], vf[ks >> 1][ks & 1], S[T], 0, 0, 0);
        }
    }
}
#undef GLAS
}
#ifndef PG8_SP2
#define PG8_SP2 true
#endif
#ifndef PG8_ALIGN
#define PG8_ALIGN true
#endif
constexpr int NWAVES = 8;
constexpr int NB = 8, SEQ = 2048, D = 1024, M = NB * SEQ, FF = 4096;
constexpr int HF = 8, HG = 4;
constexpr int DPROJ = 3600, NPROJ = 3840;
constexpr float EPS = 1e-6f;
constexpr float LOG2E = 1.4426950408889634f;
constexpr float QSCALE = 0.125f * LOG2E;
constexpr int C_FF = 1536, C_GQ = 1544, C_GB = 3080, C_GA = 3084, C_GZ = 3088;
constexpr size_t MiB = 1u << 20;
constexpr size_t WS_CTL = 0, CTL_ZERO_BYTES = 1 * MiB;
constexpr size_t WS_WIN = 2 * MiB, WS_WOUT = 10 * MiB, WS_WUP = 12 * MiB, WS_WDN = 20 * MiB;
constexpr size_t WS_X = 28 * MiB;
constexpr size_t WS_XN = 32 * MiB;
constexpr size_t WS_FQ = 64 * MiB, WS_G512 = 16 * MiB;
constexpr size_t WS_SMALL = 176 * MiB;
constexpr size_t WS_CUM = 177 * MiB;
constexpr size_t WS_GU = 32 * MiB;
constexpr size_t WS_GL = 179 * MiB;
constexpr size_t WS_BETA = 178 * MiB, WS_GDEC = 178 * MiB + 512 * 1024;
constexpr size_t WS_MIXED = 192 * MiB;
constexpr size_t WS_H = 64 * MiB;
constexpr size_t WS_MIXOUT = 64 * MiB;
constexpr size_t WS_Y = 192 * MiB;
constexpr size_t WS_END = 256 * MiB;
constexpr int CW_TMO = 0, CW_CODE = 1;
constexpr int CW_BAR = 4096;
constexpr int CW_SEAM = 16384, SEAM_BANK = 128 * 64;
constexpr int RING_OFF = 0, RING_BYTES = 131072;
constexpr int LDSCTL_OFF = RING_BYTES, MISC_OFF = LDSCTL_OFF + 320;
constexpr int LDS_BYTES = 147456;
#define GAS __attribute__((address_space(1)))
#define LAS __attribute__((address_space(3)))
typedef unsigned short bf16;
typedef unsigned v4u __attribute__((ext_vector_type(4)));
typedef float f32x4 __attribute__((ext_vector_type(4)));
typedef short bf16x8 __attribute__((ext_vector_type(8)));
typedef GAS unsigned gu32;
typedef GAS unsigned long long gu64;
#define RLX_AGENT __ATOMIC_RELAXED, __HIP_MEMORY_SCOPE_AGENT
#define LDS_WAIT() asm volatile("s_waitcnt lgkmcnt(0)" ::: "memory")
#define VM_WAIT() asm volatile("s_waitcnt vmcnt(0)" ::: "memory")
__device__ __forceinline__ unsigned long long rt() { return __builtin_amdgcn_s_memrealtime(); }
__device__ __forceinline__ unsigned f2bf(float f) { unsigned u = __builtin_bit_cast(unsigned, f); return (u + 0x7fffu + ((u >> 16) & 1u)) >> 16; }
__device__ __forceinline__ unsigned pk2(float lo, float hi) { return f2bf(lo) | (f2bf(hi) << 16); }

#define XB_TMO      128
#define XB_XCNT(j)  (256  + 64 * (j))
#define XB_XSUB(j)  (1280 + 64 * (j))
#define XB_XGEN(j)  (2304 + 64 * (j))
#define XB_TOP      3328
#define XB_TOPGEN   3392
#define XCD_BAR_WORDS 3456
#define XB_SPIN_CAP (1u << 18)

__device__ __forceinline__ unsigned xb_ld(unsigned* p)              { return __hip_atomic_load(p, __ATOMIC_RELAXED, __HIP_MEMORY_SCOPE_AGENT); }
__device__ __forceinline__ unsigned xb_add(unsigned* p, unsigned v) { return __hip_atomic_fetch_add(p, v, __ATOMIC_RELAXED, __HIP_MEMORY_SCOPE_AGENT); }
__device__ __forceinline__ unsigned xb_xcc_id() { return (unsigned)__builtin_amdgcn_s_getreg((3 << 11) | 20) & 0xFu; }
#define XB_SPIN(cond, bar) do { unsigned _sp = 0; while (cond) { __builtin_amdgcn_s_sleep(1); \
    if ((++_sp & 255u) == 0u) { if (xb_ld(&(bar)[XB_TMO])) break; if (_sp > XB_SPIN_CAP) { atomicAdd(&(bar)[XB_TMO], 1u); break; } } } } while (0)

struct XcdBarrier {
    unsigned* bar; unsigned x;
    volatile LAS unsigned* st;
};

__device__ __forceinline__ XcdBarrier xcd_barrier_post(unsigned* bar, volatile LAS unsigned* st) {
    XcdBarrier b; b.bar = bar; b.x = xb_xcc_id(); b.st = st;
    if (threadIdx.x == 0) (void)xb_add(&bar[XB_XCNT(b.x)], 1u);
    return b;
}
__device__ __forceinline__ void xcd_barrier_complete(unsigned* bar, unsigned x, unsigned& nloc, unsigned& nx) {
    const unsigned G = gridDim.x * gridDim.y * gridDim.z;
    unsigned sum, cnt, mine, sp = 0u;
    for (;;) {
        sum = 0u; cnt = 0u; mine = 0u;
#pragma unroll
        for (unsigned j = 0; j < 16; ++j) { const unsigned c = xb_ld(&bar[XB_XCNT(j)]); sum += c; cnt += (c > 0u) ? 1u : 0u; mine = (j == x) ? c : mine; }
        if (sum == G) break;
        __builtin_amdgcn_s_sleep(1);
        if ((++sp & 255u) == 0u) { if (xb_ld(&bar[XB_TMO])) break; if (sp > XB_SPIN_CAP) { atomicAdd(&bar[XB_TMO], 1u); break; } }
    }
    nloc = mine > 0u ? mine : 1u; nx = cnt > 0u ? cnt : 1u;
}

__device__ __forceinline__ void xcd_barrier(const XcdBarrier& b) {
    asm volatile("s_waitcnt vmcnt(0)" ::: "memory");
    __syncthreads();
    if (threadIdx.x == 0) {
        unsigned* bar = b.bar;
        __builtin_amdgcn_s_waitcnt(0);
        unsigned nloc = b.st[0], nx = b.st[1];
        if (nloc == 0u) { xcd_barrier_complete(bar, b.x, nloc, nx); b.st[0] = nloc; b.st[1] = nx; }
        const unsigned old = xb_add(&bar[XB_XSUB(b.x)], 1u);
        const unsigned gen = old / nloc;
        if (old + 1u == (gen + 1u) * nloc) {
            __builtin_amdgcn_fence(__ATOMIC_RELEASE, "agent");
            asm volatile("s_waitcnt vmcnt(0)" ::: "memory");
            const unsigned og = xb_add(&bar[XB_TOP], 1u);
            const unsigned tg = og / nx;
            if (og + 1u == (tg + 1u) * nx) xb_add(&bar[XB_TOPGEN], 1u);
            else XB_SPIN(xb_ld(&bar[XB_TOPGEN]) == tg, bar);
            __builtin_amdgcn_fence(__ATOMIC_ACQUIRE, "agent");
            xb_add(&bar[XB_XGEN(b.x)], 1u);
            asm volatile("s_waitcnt vmcnt(0)" ::: "memory");
        } else {
            XB_SPIN(xb_ld(&bar[XB_XGEN(b.x)]) == gen, bar);
            __builtin_amdgcn_fence(__ATOMIC_ACQUIRE, "agent");
            asm volatile("s_waitcnt vmcnt(0)" ::: "memory");
        }
    }
    __syncthreads();
}
struct Frame {
    LAS unsigned char* lds;
    volatile LAS unsigned* MISC;
    gu32* ctl;
    int tid, lane, wave;
    int vcu, G;
};
__device__ __forceinline__ float wave_sum(float v) {
#pragma unroll
    for (int o = 1; o < 64; o <<= 1) v += __shfl_xor(v, o);
    return v;
}
__device__ __forceinline__ float bf2f(unsigned short u) { return __uint_as_float((unsigned)u << 16); }
__device__ __forceinline__ int proj_src_col(int n) {
    if (n < 1536) return n;
    if (n < 3072) return n + 8;
    if (n < 3584) return n + 16;
    if (n < 3592) return C_FF + (n - 3584);
    if (n < 3596) return C_GB + (n - 3592);
    if (n < 3600) return C_GA + (n - 3596);
    return -1;
}
template <bool REMAP>
__device__ __forceinline__ void p0_transpose_item(const float* W, int K, int N, int Ndst, bf16* WT, LAS float* scr, int item, int lane) {
    const int nblk = Ndst / 32, kb = item / nblk, nb = item % nblk, k0 = 64 * kb, n0 = 32 * nb;
    const int sc = REMAP ? proj_src_col(n0 + (lane & 31)) : n0 + (lane & 31);
#pragma unroll 8
    for (int i = 0; i < 32; ++i) { const int kk = 2 * i + (lane >> 5); scr[kk * 33 + (lane & 31)] = (sc >= 0) ? W[(size_t)(k0 + kk) * N + sc] : 0.f; }
    LDS_WAIT(); asm volatile("" ::: "memory");
    const int c = lane & 7;
#pragma unroll
    for (int j = 0; j < 4; ++j) { const int n = (lane >> 3) + 8 * j; const LAS float* s = scr + (8 * c) * 33 + n;
        v4u o; o.x = pk2(s[0 * 33], s[1 * 33]); o.y = pk2(s[2 * 33], s[3 * 33]); o.z = pk2(s[4 * 33], s[5 * 33]); o.w = pk2(s[6 * 33], s[7 * 33]);
        *(GAS v4u*)(WT + (size_t)(n0 + n) * K + k0 + 8 * c) = o; }
    LDS_WAIT(); asm volatile("" ::: "memory");
}
__device__ __forceinline__ void rms_row_to_bf16(int lane, const float* xrow, const float* g, bf16* orow) {
    const GAS f32x4* xr = (const GAS f32x4*)xrow + lane; const GAS f32x4* gr = (const GAS f32x4*)g + lane;
    f32x4 v[4]; float s = 0.f;
#pragma unroll
    for (int j = 0; j < 4; ++j) { v[j] = xr[64 * j]; s += (v[j].x * v[j].x + v[j].y * v[j].y) + (v[j].z * v[j].z + v[j].w * v[j].w); }
    const float r = rsqrtf(wave_sum(s) * (1.f / D) + EPS);
    GAS unsigned long long* o8 = (GAS unsigned long long*)orow + lane;
#pragma unroll
    for (int j = 0; j < 4; ++j) { const f32x4 gg = gr[64 * j];
        o8[64 * j] = (unsigned long long)pk2(v[j].x * r * gg.x, v[j].y * r * gg.y) | ((unsigned long long)pk2(v[j].z * r * gg.z, v[j].w * r * gg.w) << 32); }
}
__device__ __forceinline__ void resnorm_row(int lane, const float* yrow, const float* g1, const float* baserow, float* outrow, const float* g2, bf16* xnrow) {
    const GAS f32x4* yr = (const GAS f32x4*)yrow + lane; const GAS f32x4* gr = (const GAS f32x4*)g1 + lane; const GAS f32x4* br = (const GAS f32x4*)baserow + lane;
    f32x4 v[4]; float s = 0.f;
#pragma unroll
    for (int j = 0; j < 4; ++j) { v[j] = yr[64 * j]; s += (v[j].x * v[j].x + v[j].y * v[j].y) + (v[j].z * v[j].z + v[j].w * v[j].w); }
    const float r = rsqrtf(wave_sum(s) * (1.f / D) + EPS);
    float s2 = 0.f;
#pragma unroll
    for (int j = 0; j < 4; ++j) { const f32x4 gg = gr[64 * j], bb = br[64 * j]; v[j] = bb + v[j] * r * gg; s2 += (v[j].x * v[j].x + v[j].y * v[j].y) + (v[j].z * v[j].z + v[j].w * v[j].w);
        ((GAS f32x4*)outrow + lane)[64 * j] = v[j]; }
    if (xnrow) {
        const float r2 = rsqrtf(wave_sum(s2) * (1.f / D) + EPS); const GAS f32x4* g2r = (const GAS f32x4*)g2 + lane;
        GAS unsigned long long* o8 = (GAS unsigned long long*)xnrow + lane;
#pragma unroll
        for (int j = 0; j < 4; ++j) { const f32x4 gg = g2r[64 * j];
            o8[64 * j] = (unsigned long long)pk2(v[j].x * r2 * gg.x, v[j].y * r2 * gg.y) | ((unsigned long long)pk2(v[j].z * r2 * gg.z, v[j].w * r2 * gg.w) << 32); }
    }
}

typedef float f32x2v __attribute__((ext_vector_type(2)));
__device__ __forceinline__ void cum_item(int bh, const float* small, const float* fbias, float* cum, LAS float* part, int tid, int lane, int wave) {
    const int b = bh >> 3, h = bh & 7; const float bz = fbias[h];
    float loc[4]; float s = 0.f;
#pragma unroll
    for (int e = 0; e < 4; ++e) { const float z = small[((size_t)b * SEQ + tid * 4 + e) * 16 + h] + bz; s += fminf(z, 0.f) - log1pf(__expf(-fabsf(z))); loc[e] = s; }
    float inc = s;
#pragma unroll
    for (int o = 1; o < 64; o <<= 1) { const float t = __shfl_up(inc, o); if (lane >= o) inc += t; }
    if (lane == 63) part[wave] = inc;
    __syncthreads();
    float base = inc - s;
    for (int w = 0; w < wave; ++w) base += part[w];
#pragma unroll
    for (int e = 0; e < 4; ++e) cum[(size_t)bh * SEQ + tid * 4 + e] = loc[e] + base;
    __syncthreads();
}

__device__ __forceinline__ int opaque_lane() { int t = threadIdx.x; asm volatile("" : "+v"(t)); return t & 63; }
struct Args { const float* in[15]; float* out; unsigned char* ws; int ph_lo, ph_hi, li, pad; };
enum { PH_PRO = 0, PH_PROJ = 1, PH_MIX = 2, PH_WO = 3, PH_N1 = 4, PH_UP = 5, PH_DOWN = 6, PH_N2 = 7, PH_END = 8 };

__global__ void __launch_bounds__(NWAVES * 64, 2) skel_fwd(Args args) {
    extern __shared__ __attribute__((aligned(16))) unsigned char lds[];
    Frame F;
    F.lds = (LAS unsigned char*)lds;
    F.MISC = (volatile LAS unsigned*)(F.lds + MISC_OFF);
    F.tid = threadIdx.x; F.lane = F.tid & 63; F.wave = __builtin_amdgcn_readfirstlane(F.tid >> 6);
    F.G = gridDim.x; { const int bx = blockIdx.x; F.vcu = (F.G % 8 == 0) ? (bx % 8) * (F.G / 8) + bx / 8 : bx; }
    unsigned char* ws = args.ws;
    F.ctl = (gu32*)(ws + WS_CTL);
    const float* x = args.in[0]; const float* g_premix = args.in[1]; const float* w_in = args.in[2];
    const float* w_out = args.in[9]; const float* g_postmix = args.in[10]; const float* g_premlp = args.in[11];
    const float* w_up = args.in[12]; const float* w_down = args.in[13]; const float* g_postmlp = args.in[14];
    bf16* Win_t = (bf16*)(ws + WS_WIN); bf16* Wout_t = (bf16*)(ws + WS_WOUT); bf16* Wup_t = (bf16*)(ws + WS_WUP); bf16* Wdn_t = (bf16*)(ws + WS_WDN);
    bf16* XN = (bf16*)(ws + WS_XN); bf16* FQ = (bf16*)(ws + WS_FQ); bf16* MIXED = (bf16*)(ws + WS_MIXED); bf16* HB = (bf16*)(ws + WS_H);
    float* SMALL = (float*)(ws + WS_SMALL); float* MIXOUT = (float*)(ws + WS_MIXOUT); float* Y = (float*)(ws + WS_Y);
    for (int u = F.tid; u < (LDS_BYTES - LDSCTL_OFF) / 4; u += NWAVES * 64) ((LAS unsigned*)(F.lds + LDSCTL_OFF))[u] = 0u;
    __syncthreads();
    XcdBarrier bar = xcd_barrier_post((unsigned*)(F.ctl + CW_BAR) + args.li * XCD_BAR_WORDS, F.MISC + 8);
    const int lo = args.ph_lo, hi = args.ph_hi;
#define IN(k) (lo <= (k) && (k) < hi)
#define BOTH(k) (IN(k) && IN((k) + 1))
#define GRID_BAR() xcd_barrier(bar)
    const int gw = F.vcu * NWAVES + F.wave, NGW = F.G * NWAVES;

    if (IN(PH_PRO)) {
        LAS float* scr = (LAS float*)(F.lds + RING_OFF + F.wave * 16384);
        constexpr int I_IN = (D / 64) * (NPROJ / 32), I_O = (D / 64) * (D / 32), I_1 = (D / 64) * (FF / 32), I_2 = (FF / 64) * (D / 32);
        constexpr int NITEMS = I_IN + I_O + I_1 + I_2;
        for (int it = gw; it < NITEMS; it += NGW) {
            int r = it;
            if (r < I_IN) { p0_transpose_item<true>(w_in, D, DPROJ, NPROJ, Win_t, scr, r, F.lane); continue; } r -= I_IN;
            if (r < I_O) { p0_transpose_item<false>(w_out, D, D, D, Wout_t, scr, r, F.lane); continue; } r -= I_O;
            if (r < I_1) { p0_transpose_item<false>(w_up, D, FF, FF, Wup_t, scr, r, F.lane); continue; } r -= I_1;
            p0_transpose_item<false>(w_down, FF, D, D, Wdn_t, scr, r, F.lane);
        }
        { const int ln = opaque_lane(); for (int m = gw; m < M; m += NGW) rms_row_to_bf16(ln, x + (size_t)m * D, g_premix, XN + (size_t)m * D); }
        if (BOTH(PH_PRO)) GRID_BAR();
    }
    if (IN(PH_PROJ)) {
        pg8::Gemm g{XN, Win_t, M, NPROJ, D}; pg8::StaticOrder S; S.init(M, NPROJ, F.G, (int)blockIdx.x);
        pg8::EpiProj E{FQ, (size_t)(WS_G512 / 2), SMALL, QSCALE};
        pg8::gemm_phase<pg8::EpiProj, pg8::StaticOrder, PG8_ALIGN, PG8_SP2>(F.lds + RING_OFF, g, S, E);
        if (BOTH(PH_PROJ)) GRID_BAR();
    }
    if (IN(PH_MIX)) {
        float* CUM = (float*)(ws + WS_CUM); float* GU = (float*)(ws + WS_GU); float* GLp = (float*)(ws + WS_GL); bf16* FR = (bf16*)args.out;
        if (F.vcu < NB * HF) cum_item(F.vcu, SMALL, args.in[3], CUM, (LAS float*)(F.lds + RING_OFF), F.tid, F.lane, F.wave);
        {
            const gdn::G1Args GA{FQ + 3 * (WS_G512 / 2), FQ + 4 * (WS_G512 / 2), FQ + 5 * (WS_G512 / 2), SMALL, args.in[5], args.in[6], args.in[7], GU, FR, GLp};
_Pragma("nounroll")
            for (int k = 0; k < 2 * ((gdn::NITEM / 2 + 2 * F.G - 1) / (2 * F.G)); ++k) { const int pr = (k >> 1) * 2 * F.G + F.vcu * 2 + (k & 1); if (pr < gdn::NITEM / 2) gdn::g1_pair(GA, pr, F.lds + RING_OFF); }
        }
        GRID_BAR();
        {
            static_assert(attn_body::ATTN_LDS_BYTES <= RING_BYTES, "attention LDS");
            const attn_body::AttnTensors AT{(const attn_body::bf16*)FQ, (const attn_body::bf16*)(FQ + WS_G512 / 2), (const attn_body::bf16*)(FQ + 2 * (WS_G512 / 2)), (attn_body::bf16*)MIXED, CUM, args.in[4]};
            const attn_body::StaticOrder S((int)F.G, (int)blockIdx.x);
            attn_body::attn_phase<attn_body::StaticOrder>((char*)lds + RING_OFF, AT, S);
        }
        if (F.wave < 4) for (int bh = F.vcu; bh < NB * HG; bh += F.G) gdn::scan_wave(bh, F.wave, GU, FR, GLp, opaque_lane());
        GRID_BAR();
        {
            const bf16* GZ = FQ + 6 * (WS_G512 / 2); const float* gno = args.in[8]; const int ln = opaque_lane();
            for (int it = gw; it < M * HG; it += NGW) {
                const int m = it >> 2, h = it & 3;
                const f32x2v o2 = *(const GAS f32x2v*)(GU + (size_t)m * 512 + h * 128 + 2 * ln);
                const float r = rsqrtf(wave_sum(o2.x * o2.x + o2.y * o2.y) * (1.f / 128.f) + EPS);
                const unsigned zz = *(const GAS unsigned*)(GZ + (size_t)m * 512 + h * 128 + 2 * ln);
                const float z0 = __uint_as_float(zz << 16), z1 = __uint_as_float(zz & 0xffff0000u);
                const f32x2v gg = *(const GAS f32x2v*)(gno + 2 * ln);
                const float a0 = o2.x * r * gg.x * z0 / (1.f + __expf(-z0)), a1 = o2.y * r * gg.y * z1 / (1.f + __expf(-z1));
                *(GAS unsigned*)(MIXED + (size_t)m * D + 512 + h * 128 + 2 * ln) = pk2(a0, a1);
            }
        }
        if (BOTH(PH_MIX)) GRID_BAR();
    }
    if (IN(PH_WO)) {
        pg8::Gemm g{MIXED, Wout_t, M, D, D}; pg8::StaticOrder S; S.init(M, D, F.G, (int)blockIdx.x);
        pg8::EpiF32 E{MIXOUT, D};
        pg8::gemm_phase<pg8::EpiF32, pg8::StaticOrder, false, PG8_SP2>(F.lds + RING_OFF, g, S, E);
        if (BOTH(PH_WO)) GRID_BAR();
    }
    if (IN(PH_N1)) {
        { const int ln = opaque_lane(); for (int m = gw; m < M; m += NGW) resnorm_row(ln, MIXOUT + (size_t)m * D, g_postmix, x + (size_t)m * D, args.out + (size_t)m * D, g_premlp, XN + (size_t)m * D); }
        if (BOTH(PH_N1)) GRID_BAR();
    }
    if (IN(PH_UP)) {
        pg8::Gemm g{XN, Wup_t, M, FF, D}; pg8::StaticOrder S; S.init(M, FF, F.G, (int)blockIdx.x);
        pg8::EpiRelu2 E{HB, FF};
        pg8::gemm_phase<pg8::EpiRelu2, pg8::StaticOrder, PG8_ALIGN, PG8_SP2>(F.lds + RING_OFF, g, S, E);
        if (BOTH(PH_UP)) GRID_BAR();
    }
    if (IN(PH_DOWN)) {
        pg8::Gemm g{HB, Wdn_t, M, D, FF}; pg8::StaticOrder S; S.init(M, D, F.G, (int)blockIdx.x);
        pg8::EpiF32 E{Y, D};
        pg8::gemm_phase<pg8::EpiF32, pg8::StaticOrder, false, PG8_SP2>(F.lds + RING_OFF, g, S, E);
        if (BOTH(PH_DOWN)) GRID_BAR();
    }
    if (IN(PH_N2)) {
        { const int ln = opaque_lane(); for (int m = gw; m < M; m += NGW) resnorm_row(ln, Y + (size_t)m * D, g_postmlp, args.out + (size_t)m * D, args.out + (size_t)m * D, nullptr, nullptr); }
    }
#undef IN
#undef BOTH
#undef GRID_BAR
}
static void launch_skel(int grid, hipStream_t stream, Args a, int lo, int hi, int li) {
    a.ph_lo = lo; a.ph_hi = hi; a.li = li;
    hipLaunchKernelGGL(skel_fwd, dim3(grid), dim3(NWAVES * 64), LDS_BYTES, stream, a);
    const hipError_t le = hipPeekAtLastError();
    if (le != hipSuccess) fprintf(stderr, "kernel_launch: launch %d failed: %s\n", li, hipGetErrorName(le));
}
extern "C" void kernel_launch(void* const* d_in, const int* in_sizes, int n_in, void* d_out, int out_size, void* d_ws, size_t ws_size, hipStream_t stream) {
    static int grid = 0;
    if (grid == 0) {
        if (n_in != 15 || in_sizes[0] != M * D || out_size != M * D || ws_size < WS_END) { fprintf(stderr, "kernel_launch: unexpected shapes (n_in %d, in0 %d, out %d, ws %zu); nothing launched\n", n_in, n_in > 0 ? in_sizes[0] : -1, out_size, ws_size); grid = -1; return; }
        int dev = 0, cus = 0, per_cu = 0;
        if (hipGetDevice(&dev) != hipSuccess || hipDeviceGetAttribute(&cus, hipDeviceAttributeMultiprocessorCount, dev) != hipSuccess) { grid = -1; return; }
        if (hipFuncSetAttribute((const void*)skel_fwd, hipFuncAttributeMaxDynamicSharedMemorySize, LDS_BYTES) != hipSuccess) { fprintf(stderr, "kernel_launch: hipFuncSetAttribute failed\n"); grid = -1; return; }
        if (hipOccupancyMaxActiveBlocksPerMultiprocessor(&per_cu, (const void*)skel_fwd, NWAVES * 64, LDS_BYTES) != hipSuccess || per_cu < 1)
            fprintf(stderr, "kernel_launch: note: occupancy query reports %d workgroups per CU\n", per_cu);
        (void)hipGetLastError();
        grid = cus;
    }
    if (grid < 0) return;
    if (hipMemsetAsync((char*)d_ws + WS_CTL, 0, CTL_ZERO_BYTES, stream) != hipSuccess) { fprintf(stderr, "kernel_launch: hipMemsetAsync failed\n"); return; }
    Args a{};
    for (int i = 0; i < 15; ++i) a.in[i] = (const float*)d_in[i];
    a.out = (float*)d_out; a.ws = (unsigned char*)d_ws;
    HOST_LAUNCH_PROGRAM
}
```

```cpp
#include <hip/hip_runtime.h>
#include <cstdio>
#include <cstdint>
__device__ __forceinline__ int lane_id() { int l = (int)__builtin_amdgcn_mbcnt_hi(~0u, __builtin_amdgcn_mbcnt_lo(~0u, 0u)); asm volatile("" : "+v"(l)); return l; }
#define HOST_LAUNCH_PROGRAM launch_skel(grid, stream, a, PH_PRO, PH_END, 0);
namespace pg8 {
#define PG8_LAS __attribute__((address_space(3)))
typedef unsigned short bf16_t;
typedef short bf16x8 __attribute__((ext_vector_type(8)));
typedef float f32x4 __attribute__((ext_vector_type(4)));
typedef unsigned u32x4 __attribute__((ext_vector_type(4)));
constexpr int BM = 256, BK = 64, HALF = 128, HTB = HALF * BK * 2  , STAGE_BYTES = 8 * HTB, NXCD = 8, WGM = 8;

__host__ __device__ __forceinline__ int lds_byte(int r, int c) { const int st = (r >> 4) * 2 + (c >> 5), rr = r & 15, cc = c & 31, ob = rr * 64 + cc * 2; return st * 1024 + (ob ^ (((ob >> 9) & 1) << 5)); }
__host__ __device__ __forceinline__ void stage_rc(int b, int& R, int& C) { const int st = b / 1024, sb = b % 1024, swz = sb ^ (((sb >> 9) & 1) << 5); R = (st >> 1) * 16 + swz / 64; C = (st & 1) * 32 + (swz % 64) / 2; }
__host__ __device__ __forceinline__ int perm32(int rho) { const int n = rho >> 4, i = rho & 15; return 8 * (i >> 2) + 4 * n + (i & 3); }

struct Unit { int pm, pn; };
struct Gemm { const bf16_t* A; const bf16_t* Bt; int M, N, K; };

struct StaticOrder {
    int nM, nN, nwg, G, c;
    __host__ __device__ void init(int M, int N, int G_, int c_) { nM = M / BM; nN = N / BM; nwg = nM * nN; G = G_; c = c_; }
    __host__ __device__ bool next(int i, Unit& u) const {
        const long L = (long)i * G + c; if (L >= nwg) return false;
        int wgid = (int)L; { const int q = nwg / NXCD, r = nwg % NXCD, xcd = wgid % NXCD, off = wgid / NXCD; wgid = (xcd < r ? xcd * (q + 1) : r * (q + 1) + (xcd - r) * q) + off; }
        const int nig = WGM * nN, gid = wgid / nig, fm = gid * WGM, gsz = (nM - fm) < WGM ? (nM - fm) : WGM;
        u.pm = fm + ((wgid % nig) % gsz); u.pn = (wgid % nig) / gsz; return true;
    }
    __device__ __forceinline__ void a_ready(const Unit&) const {}
    __device__ __forceinline__ void done(const Unit&) const {}
};

__device__ __forceinline__ unsigned cvt_pk_bf16(float lo, float hi) { unsigned r; asm volatile("v_cvt_pk_bf16_f32 %0, %1, %2" : "=v"(r) : "v"(lo), "v"(hi)); return r; }
typedef float f32x2 __attribute__((ext_vector_type(2)));
struct EpiProj {
    static constexpr bool PERM = true, AFTER_DRAIN = false;
    bf16_t* O; size_t gstride; float* small; float qscale;
    __device__ __forceinline__ void operator()(const f32x4 (&acc)[2][2][4][2], const Unit& u, int wr, int wc, int fr, int fq) const {
        const int row0 = u.pm * BM + wr * 64 + fr;
        if (u.pn < 14) {
            const int t = u.pn >> 1; bf16_t* base = O + (size_t)t * gstride; const float sc = (t == 0) ? qscale : 1.f;
            const int col0 = (u.pn & 1) * 256 + wc * 32 + 8 * fq;
#pragma unroll
            for (int ai = 0; ai < 2; ++ai)
#pragma unroll
                for (int m = 0; m < 4; ++m) { bf16_t* rowp = base + (size_t)(row0 + ai * HALF + m * 16) * 512 + col0;
#pragma unroll
                    for (int bj = 0; bj < 2; ++bj) { const f32x4 v0 = acc[ai][bj][m][0] * sc, v1 = acc[ai][bj][m][1] * sc;
                        u32x4 w; w.x = cvt_pk_bf16(v0[0], v0[1]); w.y = cvt_pk_bf16(v0[2], v0[3]); w.z = cvt_pk_bf16(v1[0], v1[1]); w.w = cvt_pk_bf16(v1[2], v1[3]);
                        *(u32x4*)(rowp + bj * HALF) = w; } }
        } else {
            if (wc == 0 && fq < 2) {
#pragma unroll
                for (int ai = 0; ai < 2; ++ai)
#pragma unroll
                    for (int m = 0; m < 4; ++m) { float* rowp = small + (size_t)(row0 + ai * HALF + m * 16) * 16 + 8 * fq;
                        *(f32x4*)(rowp) = acc[ai][0][m][0]; *(f32x4*)(rowp + 4) = acc[ai][0][m][1]; }
            }
        }
    }
};
struct EpiRelu2 {
    static constexpr bool PERM = true, AFTER_DRAIN = false;
    bf16_t* O; int ldc;
    __device__ __forceinline__ void operator()(const f32x4 (&acc)[2][2][4][2], const Unit& u, int wr, int wc, int fr, int fq) const {
        const int row0 = u.pm * BM + wr * 64 + fr, col0 = u.pn * BM + wc * 32 + 8 * fq;
#pragma unroll
        for (int ai = 0; ai < 2; ++ai)
#pragma unroll
            for (int m = 0; m < 4; ++m) { bf16_t* rowp = O + (size_t)(row0 + ai * HALF + m * 16) * ldc + col0;
#pragma unroll
                for (int bj = 0; bj < 2; ++bj) { f32x4 v0 = acc[ai][bj][m][0], v1 = acc[ai][bj][m][1];
#pragma unroll
                    for (int e = 0; e < 4; ++e) { const float a = fmaxf(v0[e], 0.f), b = fmaxf(v1[e], 0.f); v0[e] = a * a; v1[e] = b * b; }
                    u32x4 w; w.x = cvt_pk_bf16(v0[0], v0[1]); w.y = cvt_pk_bf16(v0[2], v0[3]); w.z = cvt_pk_bf16(v1[0], v1[1]); w.w = cvt_pk_bf16(v1[2], v1[3]);
                    *(u32x4*)(rowp + bj * HALF) = w; } }
    }
};
struct EpiF32 {
    static constexpr bool PERM = false, AFTER_DRAIN = false;
    float* O; int ldc;
    __device__ __forceinline__ void operator()(const f32x4 (&acc)[2][2][4][2], const Unit& u, int wr, int wc, int fr, int fq) const {
        const int row0 = u.pm * BM + wr * 64 + fr, col0 = u.pn * BM + wc * 32 + 4 * fq;
#pragma unroll
        for (int ai = 0; ai < 2; ++ai)
#pragma unroll
            for (int m = 0; m < 4; ++m) { float* rowp = O + (size_t)(row0 + ai * HALF + m * 16) * ldc + col0;
#pragma unroll
                for (int bj = 0; bj < 2; ++bj)
#pragma unroll
                    for (int n = 0; n < 2; ++n) *(f32x4*)(rowp + bj * HALF + n * 16) = acc[ai][bj][m][n]; }
    }
};
template <class Epi, class Sched, bool ALIGN_EPI = false, bool SP2 = false>
__device__ __forceinline__ void gemm_phase(PG8_LAS unsigned char* lds, const Gemm g, const Sched& S, const Epi& E, const int wv) {
    const int lane = lane_id(), wid = wv, tid = wv * 64 + lane, wr = wid >> 2, wc = wid & 3, fr = lane & 15, fq = lane >> 4;
    const int K = g.K, nt = K / BK;
    unsigned voffA[2], voffB[2];
#pragma unroll
    for (int i = 0; i < 2; ++i) { int R, C; stage_rc(tid * 16 + i * 8192, R, C); const int Rb = Epi::PERM ? ((R & ~31) + perm32(R & 31)) : R;
        voffA[i] = (unsigned)(R * K + C) * 2u; voffB[i] = (unsigned)(Rb * K + C) * 2u; }
    const size_t kstep = (size_t)(BK * 2);
    const size_t hstep = (size_t)HALF * K * 2;
    const size_t tstep = 2 * hstep;
    const unsigned ldsw = (unsigned)wid * 1024u;
    const int aoff = lds_byte(wr * 64 + fr, fq * 8), boff = lds_byte(wc * 32 + fr, fq * 8);
#define PG8_SA(b, h) (((b) * 2 + (h)) * HTB)
#define PG8_SB(b, h) ((4 + (b) * 2 + (h)) * HTB)
#define PG8_STAGE(bufoff, gbase, voff) do { _Pragma("unroll") for (int _i = 0; _i < 2; ++_i) \
        __builtin_amdgcn_global_load_lds((const unsigned*)((const char*)(gbase) + (voff)[_i]), (PG8_LAS unsigned*)(lds + (bufoff) + ldsw + _i * 8192), 16, 0, 0); } while (0)
#define PG8_LDA(dst, b, h) do { _Pragma("unroll") for (int m = 0; m < 4; ++m) _Pragma("unroll") for (int k = 0; k < 2; ++k) dst[m][k] = *(const PG8_LAS bf16x8*)(lds + PG8_SA(b, h) + aoff + m * 2048 + k * 1024); } while (0)
#define PG8_LDB(dst, b, h) do { _Pragma("unroll") for (int n = 0; n < 2; ++n) _Pragma("unroll") for (int k = 0; k < 2; ++k) dst[n][k] = *(const PG8_LAS bf16x8*)(lds + PG8_SB(b, h) + boff + n * 2048 + k * 1024); } while (0)
#define PG8_MMA(ai, bj, At, Bt) do { __builtin_amdgcn_s_setprio(1); _Pragma("unroll") for (int m = 0; m < 4; ++m) _Pragma("unroll") for (int n = 0; n < 2; ++n) _Pragma("unroll") for (int k = 0; k < 2; ++k) \
        acc[ai][bj][m][n] = __builtin_amdgcn_mfma_f32_16x16x32_bf16(Bt[n][k], At[m][k], acc[ai][bj][m][n], 0, 0, 0); __builtin_amdgcn_s_setprio(0); } while (0)
#define PG8_WAIT_V(n) asm volatile("s_waitcnt vmcnt(" #n ")" ::: "memory")
#define PG8_WAIT_L(n) asm volatile("s_waitcnt lgkmcnt(" #n ")" ::: "memory")
#define PG8_BAR __builtin_amdgcn_s_barrier()
#define PG8_SCHED __builtin_amdgcn_sched_barrier(0)
    Unit cur, nxt; int ui = 0;
    if (!S.next(0, cur)) return;
    f32x4 acc[2][2][4][2];
#pragma unroll
    for (int a = 0; a < 2; ++a)
#pragma unroll
        for (int b = 0; b < 2; ++b)
#pragma unroll
            for (int m = 0; m < 4; ++m)
#pragma unroll
                for (int n = 0; n < 2; ++n) acc[a][b][m][n] = (f32x4){0.f, 0.f, 0.f, 0.f};
    bf16x8 At[4][2], B0[2][2], B1[2][2];
    const char* cA = (const char*)g.A + (size_t)cur.pm * tstep; const char* cB = (const char*)g.Bt + (size_t)cur.pn * tstep;
    S.a_ready(cur);
    if constexpr (SP2) {
        PG8_STAGE(PG8_SB(0, 0), cB, voffB); PG8_STAGE(PG8_SB(0, 1), cB + hstep, voffB); PG8_STAGE(PG8_SA(0, 0), cA, voffA); PG8_STAGE(PG8_SA(0, 1), cA + hstep, voffA);
        if (wr == 1) PG8_BAR;
        PG8_WAIT_V(2); PG8_BAR;
        PG8_STAGE(PG8_SB(1, 0), cB + kstep, voffB); PG8_STAGE(PG8_SA(1, 0), cA + kstep, voffA); PG8_STAGE(PG8_SB(1, 1), cB + hstep + kstep, voffB);
        PG8_WAIT_V(6); PG8_BAR;
    } else {
        PG8_STAGE(PG8_SB(0, 0), cB, voffB); PG8_STAGE(PG8_SA(0, 0), cA, voffA); PG8_STAGE(PG8_SB(0, 1), cB + hstep, voffB); PG8_STAGE(PG8_SA(0, 1), cA + hstep, voffA);
        if (wr == 1) PG8_BAR;
        PG8_WAIT_V(4); PG8_BAR;
        PG8_STAGE(PG8_SB(1, 0), cB + kstep, voffB); PG8_STAGE(PG8_SA(1, 0), cA + kstep, voffA); PG8_STAGE(PG8_SB(1, 1), cB + hstep + kstep, voffB);
        PG8_WAIT_V(6); PG8_BAR;
    }
    for (;;) {
        const bool has_next = S.next(ui + 1, nxt);
        const char* nA = has_next ? (const char*)g.A + (size_t)nxt.pm * tstep : cA; const char* nB = has_next ? (const char*)g.Bt + (size_t)nxt.pn * tstep : cB;
        for (int t = 0; t < nt; t += 2) {
            const bool last = (t == nt - 2);
            const char* a1 = cA + (size_t)(t + 1) * kstep;
            const char* a2 = last ? nA : cA + (size_t)(t + 2) * kstep; const char* b2 = last ? nB : cB + (size_t)(t + 2) * kstep;
            const char* a3 = a2 + kstep; const char* b3 = b2 + kstep;
            if (last && has_next) S.a_ready(nxt);
            if constexpr (SP2) {
            PG8_LDB(B0, 0, 0); PG8_LDB(B1, 0, 1); PG8_SCHED; PG8_LDA(At, 0, 0); PG8_STAGE(PG8_SA(1, 1), a1 + hstep, voffA);
            PG8_WAIT_V(8); PG8_WAIT_L(0); PG8_BAR; PG8_MMA(0, 0, At, B0); PG8_MMA(0, 1, At, B1); PG8_BAR; PG8_SCHED;
            PG8_LDA(At, 0, 1); PG8_STAGE(PG8_SB(0, 0), b2, voffB); PG8_STAGE(PG8_SB(0, 1), b2 + hstep, voffB); PG8_STAGE(PG8_SA(0, 0), a2, voffA);
            PG8_WAIT_V(8); PG8_WAIT_L(0); PG8_BAR; PG8_MMA(1, 0, At, B0); PG8_MMA(1, 1, At, B1); PG8_BAR; PG8_SCHED;
            PG8_LDB(B0, 1, 0); PG8_LDB(B1, 1, 1); PG8_SCHED; PG8_LDA(At, 1, 0); PG8_STAGE(PG8_SA(0, 1), a2 + hstep, voffA);
            PG8_WAIT_V(8); PG8_WAIT_L(0); PG8_BAR; PG8_MMA(0, 0, At, B0); PG8_MMA(0, 1, At, B1); PG8_BAR; PG8_SCHED;
            PG8_LDA(At, 1, 1); PG8_STAGE(PG8_SB(1, 0), b3, voffB); PG8_STAGE(PG8_SB(1, 1), b3 + hstep, voffB); PG8_STAGE(PG8_SA(1, 0), a3, voffA);
            PG8_WAIT_V(8); PG8_WAIT_L(0); PG8_BAR; PG8_MMA(1, 0, At, B0); PG8_MMA(1, 1, At, B1); PG8_BAR; PG8_SCHED;
            } else {
            PG8_LDB(B0, 0, 0); PG8_SCHED; PG8_LDA(At, 0, 0); PG8_STAGE(PG8_SA(1, 1), a1 + hstep, voffA);
            PG8_WAIT_L(8); PG8_BAR; PG8_WAIT_L(0); PG8_MMA(0, 0, At, B0); PG8_BAR; PG8_SCHED;
            PG8_LDB(B1, 0, 1); PG8_STAGE(PG8_SB(0, 0), b2, voffB);
            PG8_BAR; PG8_WAIT_L(0); PG8_MMA(0, 1, At, B1); PG8_BAR;
            PG8_LDA(At, 0, 1); PG8_STAGE(PG8_SA(0, 0), a2, voffA);
            PG8_BAR; PG8_WAIT_L(0); PG8_MMA(1, 0, At, B0); PG8_BAR; PG8_SCHED;
            PG8_STAGE(PG8_SB(0, 1), b2 + hstep, voffB);
            PG8_WAIT_V(6); PG8_BAR; PG8_MMA(1, 1, At, B1); PG8_BAR;
            PG8_LDB(B0, 1, 0); PG8_SCHED; PG8_LDA(At, 1, 0); PG8_STAGE(PG8_SA(0, 1), a2 + hstep, voffA);
            PG8_WAIT_L(8); PG8_BAR; PG8_WAIT_L(0); PG8_MMA(0, 0, At, B0); PG8_BAR; PG8_SCHED;
            PG8_LDB(B1, 1, 1); PG8_STAGE(PG8_SB(1, 0), b3, voffB);
            PG8_BAR; PG8_WAIT_L(0); PG8_MMA(0, 1, At, B1); PG8_BAR;
            PG8_LDA(At, 1, 1); PG8_STAGE(PG8_SA(1, 0), a3, voffA);
            PG8_BAR; PG8_WAIT_L(0); PG8_MMA(1, 0, At, B0); PG8_BAR; PG8_SCHED;
            PG8_STAGE(PG8_SB(1, 1), b3 + hstep, voffB);
            PG8_WAIT_V(6); PG8_BAR; PG8_MMA(1, 1, At, B1); PG8_BAR;
            }
        }
        if constexpr (ALIGN_EPI) { if (wr == 0) PG8_BAR; }
        if constexpr (!Epi::AFTER_DRAIN) { E(acc, cur, wr, wc, fr, fq); S.done(cur); }
        if (!has_next) break;
#pragma unroll
        for (int a = 0; a < 2; ++a)
#pragma unroll
            for (int b = 0; b < 2; ++b)
#pragma unroll
                for (int m = 0; m < 4; ++m)
#pragma unroll
                    for (int n = 0; n < 2; ++n) acc[a][b][m][n] = (f32x4){0.f, 0.f, 0.f, 0.f};
        cur = nxt; cA = nA; cB = nB; ++ui;
        if constexpr (ALIGN_EPI) { if (wr == 1) PG8_BAR; }
    }
    PG8_WAIT_V(0);
    if constexpr (!ALIGN_EPI) { if (wr == 0) PG8_BAR; }
    PG8_BAR;
    if constexpr (Epi::AFTER_DRAIN) { E.fused(acc, cur, wr, wc, fr, fq, lds, wid, lane); S.done(cur); }
#undef PG8_SA
#undef PG8_SB
#undef PG8_STAGE
#undef PG8_LDA
#undef PG8_LDB
#undef PG8_MMA
#undef PG8_WAIT_V
#undef PG8_WAIT_L
#undef PG8_BAR
#undef PG8_SCHED
}
}
#include <hip/hip_bf16.h>
#include <cmath>
namespace attn_body {
using bf16=__hip_bfloat16;
using bf16x8=__attribute__((ext_vector_type(8)))short;
using s16x4=__attribute__((ext_vector_type(4)))short;
using f32x16=__attribute__((ext_vector_type(16)))float;
using u32x4=__attribute__((ext_vector_type(4)))unsigned;
constexpr int BATCH=8,NHEAD=8,SEQ=2048,D=64,DM=NHEAD*D,OPITCH=1024;
constexpr int NW=8,QBLK=32,QB=QBLK*NW,KVBLK=64,NQB=SEQ/QB;
constexpr int ATTN_PITCH=DM, ATTN_UNIT_ROWS=QB;
__device__ __forceinline__ int crow(int r,int hi){return (r&3)+8*(r>>2)+4*hi;}
#define SBAR() __builtin_amdgcn_sched_barrier(0)
__device__ __forceinline__ void cmask(f32x16&p0,f32x16&p1,int jb,int qrel,int hi){
  const float NEG=-INFINITY; int kb=64*jb+4*hi;
  #pragma unroll
  for(int r=0;r<16;++r){int kv=kb+(r&3)+8*(r>>2); if(kv>qrel)p0[r]=NEG; if(kv+32>qrel)p1[r]=NEG;}
}

constexpr int NSLOT=3, SLOTB=8192;
constexpr int LDS_K=0, LDS_V=NSLOT*SLOTB, LDS_WS=2*NSLOT*SLOTB, LDS_OST=LDS_WS+NW*64*4, LDS_KB=LDS_OST+NW*4096, LDS_BYTES=LDS_KB+SEQ*16;
constexpr float C2=0.125f*1.4426950408889634f;
__device__ __forceinline__ void glds16(const void*gsrc,unsigned lds_dst){unsigned keep;
  asm volatile("s_mov_b32 %0, m0\n\ts_mov_b32 m0, %2\n\ts_nop 0\n\tglobal_load_lds_dwordx4 %1, off\n\ts_mov_b32 m0, %0":"=&s"(keep):"v"(gsrc),"s"(lds_dst):"memory");}
__device__ __forceinline__ float max3f(float a,float b,float c){float r;asm("v_max3_f32 %0, %1, %2, %3":"=v"(r):"v"(a),"v"(b),"v"(c));return r;}
__device__ __forceinline__ float max2f(float a,float b){float r;asm("v_max_f32_e32 %0, %1, %2":"=v"(r):"v"(a),"v"(b));return r;}
__device__ __forceinline__ float fadd_s(float a,float b){float r;asm("v_add_f32_e32 %0, %1, %2":"=v"(r):"v"(a),"v"(b));return r;}
__device__ __forceinline__ float fsub_s(float a,float b){float r;asm("v_sub_f32_e32 %0, %1, %2":"=v"(r):"v"(a),"v"(b));return r;}
typedef float f32x2_t __attribute__((ext_vector_type(2))); typedef __bf16 bf16x2_t __attribute__((ext_vector_type(2)));
__device__ __forceinline__ unsigned cvtpk_s(float lo,float hi){f32x2_t v={lo,hi};bf16x2_t b=__builtin_convertvector(v,bf16x2_t);return __builtin_bit_cast(unsigned,b);}
#define WAIT_BAR(N) asm volatile("s_waitcnt vmcnt(" #N ") lgkmcnt(0)\n\ts_barrier":::"memory")

__device__ __forceinline__ void qkt(f32x16&p0,f32x16&p1,const char*Kslot,const bf16x8*qr,const bf16x8 ka0,const bf16x8 ka1,const bf16x8 qbf,int r32,int hi){
  p0=__builtin_amdgcn_mfma_f32_32x32x16_bf16(ka0,qbf,f32x16{},0,0,0);p1=__builtin_amdgcn_mfma_f32_32x32x16_bf16(ka1,qbf,f32x16{},0,0,0);
  const char*kb=Kslot+hi*1024+r32*16;
  #pragma unroll
  for(int d0=0;d0<4;++d0){
    const bf16x8 b0=*reinterpret_cast<const bf16x8*>(kb+d0*2048);
    const bf16x8 b1=*reinterpret_cast<const bf16x8*>(kb+d0*2048+512);
    p0=__builtin_amdgcn_mfma_f32_32x32x16_bf16(b0,qr[d0],p0,0,0,0);p1=__builtin_amdgcn_mfma_f32_32x32x16_bf16(b1,qr[d0],p1,0,0,0);}
}
typedef __attribute__((address_space(3))) const char* lds_cptr;
typedef short v4i16_t __attribute__((ext_vector_type(4)));
__device__ __forceinline__ void kload8(bf16x8*kf,lds_cptr kp){
  kf[0]=*(const __attribute__((address_space(3))) bf16x8*)(kp);      kf[1]=*(const __attribute__((address_space(3))) bf16x8*)(kp+512);
  kf[2]=*(const __attribute__((address_space(3))) bf16x8*)(kp+2048); kf[3]=*(const __attribute__((address_space(3))) bf16x8*)(kp+2560);
  kf[4]=*(const __attribute__((address_space(3))) bf16x8*)(kp+4096); kf[5]=*(const __attribute__((address_space(3))) bf16x8*)(kp+4608);
  kf[6]=*(const __attribute__((address_space(3))) bf16x8*)(kp+6144); kf[7]=*(const __attribute__((address_space(3))) bf16x8*)(kp+6656);
}
__device__ __forceinline__ void kload2(bf16x8*kf,lds_cptr kp,int j){ kf[2*j]=*(const __attribute__((address_space(3))) bf16x8*)(kp+j*2048); kf[2*j+1]=*(const __attribute__((address_space(3))) bf16x8*)(kp+j*2048+512); }
__device__ __forceinline__ s16x4 vtr(lds_cptr p){ return __builtin_bit_cast(s16x4,__builtin_amdgcn_ds_read_tr16_b64_v4i16((__attribute__((address_space(3))) v4i16_t*)p)); }
__device__ __forceinline__ float rowmax(const f32x16&p0,const f32x16&p1){
  float a=max3f(p0[0],p0[1],p1[0]),b=max3f(p0[2],p0[3],p1[1]);a=max3f(a,p1[2],p1[3]);
  #pragma unroll
  for(int r=4;r<16;r+=4){a=max3f(a,p0[r],p0[r+1]);b=max3f(b,p0[r+2],p0[r+3]);a=max3f(a,p1[r],p1[r+1]);b=max3f(b,p1[r+2],p1[r+3]);}
  const float m=max2f(a,b);
  auto rr=__builtin_amdgcn_permlane32_swap(__float_as_uint(m),__float_as_uint(m),false,false);
  return max2f(__uint_as_float(rr[0]),__uint_as_float(rr[1]));
}
__device__ __forceinline__ void pv(f32x16*o,int vb,bf16x8 pa0,bf16x8 pa1,bf16x8 pa2,bf16x8 pa3){
  #pragma unroll
  for(int d0=0;d0<2;++d0){s16x4 lo[4],hi[4];
    #pragma unroll
    for(int ks=0;ks<4;++ks){
      asm volatile("ds_read_b64_tr_b16 %0,%1 offset:%c2":"=&v"(lo[ks]):"v"(vb),"i"(d0*4096+ks*1024):"memory");
      asm volatile("ds_read_b64_tr_b16 %0,%1 offset:%c2":"=&v"(hi[ks]):"v"(vb),"i"(d0*4096+ks*1024+512):"memory");}
    asm volatile("s_waitcnt lgkmcnt(0)":::"memory");SBAR();
    #define PK(k) (bf16x8){lo[k][0],lo[k][1],lo[k][2],lo[k][3],hi[k][0],hi[k][1],hi[k][2],hi[k][3]}
    o[d0]=__builtin_amdgcn_mfma_f32_32x32x16_bf16(pa0,PK(0),o[d0],0,0,0);
    o[d0]=__builtin_amdgcn_mfma_f32_32x32x16_bf16(pa1,PK(1),o[d0],0,0,0);
    o[d0]=__builtin_amdgcn_mfma_f32_32x32x16_bf16(pa2,PK(2),o[d0],0,0,0);
    o[d0]=__builtin_amdgcn_mfma_f32_32x32x16_bf16(pa3,PK(3),o[d0],0,0,0);
    #undef PK
  }
}

#ifndef ATTN_STORE16
#define ATTN_STORE16(p,v) (*(u32x4*)(p)=(v))
#endif
__device__ __forceinline__ unsigned bfbits(float f){unsigned u=__builtin_bit_cast(unsigned,f);return (u+0x7fffu+((u>>16)&1u))>>16;}
__device__ __forceinline__ void split3(float x,unsigned&h1,unsigned&h2,unsigned&h3){h1=bfbits(x);const float r1=x-__uint_as_float(h1<<16);h2=bfbits(r1);const float r2=r1-__uint_as_float(h2<<16);h3=bfbits(r2);}
template<int THRL> __device__ __forceinline__ void attn_unit(int b,int h,int qb,const bf16*Q,const bf16*__restrict__ K,const bf16*__restrict__ V,bf16*O,const float*cumbh,const float*gnorm,char*shm,const int wid){
  const int lane=lane_id(),tid=wid*64+lane,r32=lane&31,hi=lane>>5;
  const long rowbase=(long)b*SEQ; const int q0=qb*QB;
  const bf16*Qw=Q+(rowbase+q0+wid*QBLK)*DM+h*D;
  const bf16*Kh=K+rowbase*DM+h*D,*Vh=V+rowbase*DM+h*D;
  const unsigned lds0=(unsigned)(uintptr_t)shm;
  float*wsf=(float*)(shm+LDS_WS)+wid*64;
  { const float cref=cumbh[q0]; u32x4*kbw=(u32x4*)(shm+LDS_KB);
    for(int i=tid;i<q0+QB;i+=NW*64){ const float kb=(cref-cumbh[i])*1.4426950408889634f; unsigned h1,h2,h3; split3(kb,h1,h2,h3); kbw[i]=(u32x4){h1|(h2<<16),h3|0x3F800000u,0x3F803F80u,0u}; } }
  const bf16*ksrc=Kh+(long)lane*DM+wid*8;
  const bf16*vsrc=Vh+(long)(16*(wid&3)+(lane>>2))*DM+(wid>>2)*32+(lane&3)*8;
  const unsigned kdst=lds0+LDS_K+wid*1024, vdst=lds0+LDS_V+wid*1024;
  #define DMA_K(t,slot) glds16(ksrc+(long)(t)*KVBLK*DM,(unsigned)__builtin_amdgcn_readfirstlane(kdst+(slot)))
  #define DMA_V(t,slot) glds16(vsrc+(long)(t)*KVBLK*DM,(unsigned)__builtin_amdgcn_readfirstlane(vdst+(slot)))
  const int vb0=(int)(lds0+LDS_V)+((lane>>4)&1)*32+(lane&3)*8+(4*hi+((lane&15)>>2))*64;
  const char*Kbase=shm+LDS_K; bf16x8 kf[8];
  const lds_cptr shm3=(lds_cptr)shm; const lds_cptr kp0=shm3+LDS_K+hi*1024+r32*16; const lds_cptr vp0=shm3+LDS_V+((lane>>4)&1)*32+(lane&3)*8+(4*hi+((lane&15)>>2))*64;
  const int NT=(q0+QB)/KVBLK;
  DMA_K(0,0);DMA_V(0,0);DMA_K(1,SLOTB);
  bf16x8 qr[4];
  #pragma unroll
  for(int d0=0;d0<4;++d0)qr[d0]=*reinterpret_cast<const bf16x8*>(&Qw[(long)r32*DM+d0*16+hi*8]);
  float mhat=0.f,l_reg=0.f;f32x16 o[2];o[0]=f32x16{};o[1]=f32x16{};u32x4 qbw=(u32x4){hi?0u:0x3F803F80u,hi?0u:0x3F80u,0u,0u};
  const lds_cptr kbp0=(lds_cptr)shm+LDS_KB+r32*16;
  #define QBF __builtin_bit_cast(bf16x8,qbw)
  #define KBLD(t,p) (*(const __attribute__((address_space(3))) bf16x8*)(kbp0+((t)*64+(p)*32)*16))
  #define SETQB() do{ unsigned h1_,h2_,h3_; split3(-mhat,h1_,h2_,h3_); qbw[1]=hi?0u:(0x3F80u|(h1_<<16)); qbw[2]=hi?0u:(h2_|(h3_<<16)); asm volatile("":"+v"(qbw)); }while(0)
  const int qrel=wid*QBLK+r32;
  #define CMASK(P0,P1,t) do{int jb_=(t)-(NT-4); if(jb_>=0)cmask(P0,P1,jb_,qrel,hi);}while(0)
  bool resc=false;
  #define START(P0,P1) do{ const float rm=rowmax(P0,P1); resc=false; \
    { const float dl=rm; mhat=fadd_s(mhat,dl); \
      _Pragma("unroll") for(int r=0;r<16;++r){P0[r]=fsub_s(P0[r],dl);P1[r]=fsub_s(P1[r],dl);} \
      SETQB(); } \
    _Pragma("unroll") for(int r=0;r<16;++r)P0[r]=__builtin_amdgcn_exp2f(P0[r]); }while(0)
  #define RESC() do{ if(resc){ asm volatile("s_waitcnt lgkmcnt(0)":::"memory"); \
      _Pragma("unroll") for(int d_=0;d_<2;++d_) _Pragma("unroll") for(int r=0;r<16;++r)o[d_][r]*=wsf[crow(r,hi)]; } }while(0)
  f32x16 pA0,pA1,pB0,pB1;
  int sl_prev=0,sl_cur=0,sl_next=SLOTB;
  #define ROT() do{sl_prev=sl_cur;sl_cur=sl_next;sl_next=(sl_next==(NSLOT-1)*SLOTB)?0:sl_next+SLOTB;}while(0)
  DMA_K(2,2*SLOTB);
  WAIT_BAR(3);
  qkt(pA0,pA1,Kbase,qr,KBLD(0,0),KBLD(0,1),QBF,r32,hi);asm volatile("s_nop 15\n\ts_nop 7":"+v"(pA0),"+v"(pA1));CMASK(pA0,pA1,0);
  START(pA0,pA1);
  _Pragma("unroll") for(int r=0;r<16;++r)pA1[r]=__builtin_amdgcn_exp2f(pA1[r]);
  WAIT_BAR(0);
  DMA_K(3,0);DMA_V(1,SLOTB);
  ROT();
  kload8(kf,kp0+sl_cur);
  WAIT_BAR(2);
  s16x4 vlo[8],vhi[8]; u32x4 pw0,pw1,pw2,pw3;
  #define PKW(P,B) cvtpk_s(P[B],P[B+1])
  #define PAF(k) __builtin_bit_cast(bf16x8,pw##k)
  #define VFR(i) (bf16x8){vlo[i][0],vlo[i][1],vlo[i][2],vlo[i][3],vhi[i][0],vhi[i][1],vhi[i][2],vhi[i][3]}
  #define PIN(x) asm volatile("":"+v"(x))
  #define MX3(a,b,c) __builtin_fmaxf(__builtin_fmaxf((a),(b)),(c))
  #define GAPA(MF,A0,A1,A2,A3,W0,W1,PW) do{ MF; sacc+=A0; sacc+=A1; sacc+=A2; sacc+=A3; PIN(sacc); W0; W1; PIN(PW); SBAR(); }while(0)
  #define EX(v) __builtin_amdgcn_exp2f(v)
  #define GAPB(MF,X,B) do{ MF; X[B]=EX(X[B]); X[B+1]=EX(X[B+1]); X[B+2]=EX(X[B+2]); X[B+3]=EX(X[B+3]); PIN(X); SBAR(); }while(0)
  #define VRD(i) do{ vlo[i]=vtr(vp_+(((i)>>2)*4096+((i)&3)*1024)); vhi[i]=vtr(vp_+(((i)>>2)*4096+((i)&3)*1024+512)); }while(0)
  #define KRD(G,j) do{ if(G){ kload2(kf,kp0+sl_next,j); SBAR(); } }while(0)
  #define STEP(C0,C1,P0,P1,t,GK,GV,GL) do{ SBAR(); \
    const lds_cptr vp_=vp0+sl_prev; \
    { const bf16x8 ka0_=KBLD(t,0), ka1_=KBLD(t,1); VRD(0); SBAR(); \
      C0=__builtin_amdgcn_mfma_f32_32x32x16_bf16(ka0_,QBF,f32x16{},0,0,0); C1=__builtin_amdgcn_mfma_f32_32x32x16_bf16(ka1_,QBF,f32x16{},0,0,0); SBAR(); } \
    float sacc=(P0[0]+P0[1]); \
    GAPA(C0=__builtin_amdgcn_mfma_f32_32x32x16_bf16(kf[0],qr[0],C0,0,0,0), P0[2],P0[3],P0[4],P0[5],     pw0[0]=PKW(P0,0), pw0[1]=PKW(P0,2), pw0); \
    VRD(4); SBAR(); GAPA(C1=__builtin_amdgcn_mfma_f32_32x32x16_bf16(kf[1],qr[0],C1,0,0,0), P0[6],P0[7],P0[8],P0[9],     pw0[2]=PKW(P0,4), pw0[3]=PKW(P0,6), pw0); \
    VRD(1); SBAR(); GAPA(C0=__builtin_amdgcn_mfma_f32_32x32x16_bf16(kf[2],qr[1],C0,0,0,0),   P0[10],P0[11],P0[12],P0[13], pw1[0]=PKW(P0,8), pw1[1]=PKW(P0,10), pw1); \
    VRD(5); SBAR(); GAPA(C1=__builtin_amdgcn_mfma_f32_32x32x16_bf16(kf[3],qr[1],C1,0,0,0),   P0[14],P0[15],P1[0],P1[1],   pw1[2]=PKW(P0,12),pw1[3]=PKW(P0,14), pw1); \
    VRD(2); SBAR(); GAPA(C0=__builtin_amdgcn_mfma_f32_32x32x16_bf16(kf[4],qr[2],C0,0,0,0),   P1[2],P1[3],P1[4],P1[5],     pw2[0]=PKW(P1,0), pw2[1]=PKW(P1,2), pw2); \
    VRD(6); SBAR(); GAPA(C1=__builtin_amdgcn_mfma_f32_32x32x16_bf16(kf[5],qr[2],C1,0,0,0),   P1[6],P1[7],P1[8],P1[9],     pw2[2]=PKW(P1,4), pw2[3]=PKW(P1,6), pw2); \
    VRD(3); SBAR(); GAPA(C0=__builtin_amdgcn_mfma_f32_32x32x16_bf16(kf[6],qr[3],C0,0,0,0),   P1[10],P1[11],P1[12],P1[13], pw3[0]=PKW(P1,8), pw3[1]=PKW(P1,10), pw3); \
    VRD(7); SBAR(); GAPA(C1=__builtin_amdgcn_mfma_f32_32x32x16_bf16(kf[7],qr[3],C1,0,0,0),   P1[14],P1[15],0.f,0.f,       pw3[2]=PKW(P1,12),pw3[3]=PKW(P1,14), pw3); \
    l_reg+=sacc; \
    if(GK){DMA_K((t)+3,sl_cur);} if(GV){DMA_V((t)+1,sl_next);} \
    CMASK(C0,C1,t); \
    { float a=MX3(C0[0],C0[1],C1[0]),b=MX3(C0[2],C0[3],C1[1]); a=MX3(a,C1[2],C1[3]); \
      _Pragma("unroll") for(int r=4;r<16;r+=4){a=MX3(a,C0[r],C0[r+1]);b=MX3(b,C0[r+2],C0[r+3]);a=MX3(a,C1[r],C1[r+1]);b=MX3(b,C1[r+2],C1[r+3]);} \
      float rm=__builtin_fmaxf(a,b); { auto rr=__builtin_amdgcn_permlane32_swap(__float_as_uint(rm),__float_as_uint(rm),false,false); rm=__builtin_fmaxf(__uint_as_float(rr[0]),__uint_as_float(rr[1])); } \
      resc=false; \
      if(__builtin_expect(__any(rm>(float)THRL),0)){ const float dl=__builtin_fmaxf(rm,0.f); mhat+=dl; \
        _Pragma("unroll") for(int r=0;r<16;++r){C0[r]-=dl;C1[r]-=dl;} \
        SETQB(); \
        const float f=__builtin_amdgcn_exp2f(-dl); l_reg*=f; if(hi==0)wsf[r32]=f; resc=true; } } \
    SBAR(); \
    GAPB(o[0]=__builtin_amdgcn_mfma_f32_32x32x16_bf16(PAF(0),VFR(0),o[0],0,0,0), C0,0); \
    GAPB(o[1]=__builtin_amdgcn_mfma_f32_32x32x16_bf16(PAF(0),VFR(4),o[1],0,0,0), C0,4); \
    KRD(GL,0); GAPB(o[0]=__builtin_amdgcn_mfma_f32_32x32x16_bf16(PAF(1),VFR(1),o[0],0,0,0), C0,8); \
    KRD(GL,1); GAPB(o[1]=__builtin_amdgcn_mfma_f32_32x32x16_bf16(PAF(1),VFR(5),o[1],0,0,0), C0,12); \
    KRD(GL,2); GAPB(o[0]=__builtin_amdgcn_mfma_f32_32x32x16_bf16(PAF(2),VFR(2),o[0],0,0,0), C1,0); \
    KRD(GL,3); GAPB(o[1]=__builtin_amdgcn_mfma_f32_32x32x16_bf16(PAF(2),VFR(6),o[1],0,0,0), C1,4); \
    GAPB(o[0]=__builtin_amdgcn_mfma_f32_32x32x16_bf16(PAF(3),VFR(3),o[0],0,0,0), C1,8); \
    GAPB(o[1]=__builtin_amdgcn_mfma_f32_32x32x16_bf16(PAF(3),VFR(7),o[1],0,0,0), C1,12); \
    }while(0)
  int t=1;
  #undef CMASK
  #define CMASK(P0,P1,t) do{}while(0)
  for(;t+5<NT;t+=2){
    STEP(pB0,pB1,pA0,pA1,t,true,true,true);     WAIT_BAR(2); RESC(); ROT();
    STEP(pA0,pA1,pB0,pB1,t+1,true,true,true);   WAIT_BAR(2); RESC(); ROT();
  }
  #undef CMASK
  #define CMASK(P0,P1,t) do{int jb_=(t)-(NT-4); if(jb_>=0)cmask(P0,P1,jb_,qrel,hi);}while(0)
  #define ENDW(tt) do{ if((tt)+3<NT){WAIT_BAR(2);} else if((tt)+2<NT){WAIT_BAR(1);} else {WAIT_BAR(0);} }while(0)
  for(;t+1<NT;t+=2){
    STEP(pB0,pB1,pA0,pA1,t,(t+3<NT),(t+1<NT),(t+1<NT));       ENDW(t);   RESC(); ROT();
    STEP(pA0,pA1,pB0,pB1,t+1,(t+4<NT),(t+2<NT),(t+2<NT));     ENDW(t+1); RESC(); ROT();
  }
  STEP(pB0,pB1,pA0,pA1,NT-1,false,false,false); RESC();
  { float sacc=pB0[0]+pB0[1]; _Pragma("unroll") for(int r=2;r<16;++r)sacc+=pB0[r]; _Pragma("unroll") for(int r=0;r<16;++r)sacc+=pB1[r]; l_reg+=sacc;
    pw0=(u32x4){PKW(pB0,0),PKW(pB0,2),PKW(pB0,4),PKW(pB0,6)};pw1=(u32x4){PKW(pB0,8),PKW(pB0,10),PKW(pB0,12),PKW(pB0,14)};pw2=(u32x4){PKW(pB1,0),PKW(pB1,2),PKW(pB1,4),PKW(pB1,6)};pw3=(u32x4){PKW(pB1,8),PKW(pB1,10),PKW(pB1,12),PKW(pB1,14)};
    SBAR(); pv(o,vb0+sl_cur,PAF(0),PAF(1),PAF(2),PAF(3)); }
  #undef PKW
  #undef PAF
  #undef VFR
  #undef PIN
  #undef MX3
  #undef GAPA
  #undef GAPB
  #undef EX
  #undef VRD
  #undef KRD
  #undef STEP
  #undef ENDW
  {auto rr=__builtin_amdgcn_permlane32_swap(__float_as_uint(l_reg),__float_as_uint(l_reg),false,false);l_reg=__uint_as_float(rr[0])+__uint_as_float(rr[1]);}
  if(hi==0)wsf[32+r32]=l_reg;asm volatile("s_waitcnt lgkmcnt(0)":::"memory");
  float rli[16];
  #pragma unroll
  for(int r=0;r<16;++r)rli[r]=__builtin_amdgcn_rcpf(wsf[32+crow(r,hi)]);
  bf16*Ow=O+(rowbase+q0+wid*QBLK)*OPITCH+h*D;
  float gn[8];
  #pragma unroll
  for(int j=0;j<8;++j)gn[j]=gnorm[(lane&7)*8+j];
  { bf16*stg=(bf16*)(shm+LDS_OST)+wid*2048;
    #pragma unroll
    for(int r=0;r<16;++r){const int orow=crow(r,hi);
      #pragma unroll
      for(int d0=0;d0<2;++d0)stg[orow*64+d0*32+r32]=__float2bfloat16(o[d0][r]*rli[r]);}
    asm volatile("s_waitcnt lgkmcnt(0)":::"memory");
    #pragma unroll
    for(int i=0;i<4;++i){const int row=i*8+(lane>>3),ch=lane&7; const u32x4 v=*(const u32x4*)(stg+row*64+ch*8);
      float f[8];
      #pragma unroll
      for(int j=0;j<4;++j){f[2*j]=__uint_as_float(v[j]<<16);f[2*j+1]=__uint_as_float(v[j]&0xffff0000u);}
      float ss=0.f;
      #pragma unroll
      for(int j=0;j<8;++j)ss+=f[j]*f[j];
      ss+=__shfl_xor(ss,1);ss+=__shfl_xor(ss,2);ss+=__shfl_xor(ss,4);
      const float rs=__builtin_amdgcn_rsqf(ss*(1.f/64.f)+1e-6f);
      u32x4 w;
      #pragma unroll
      for(int j=0;j<4;++j)w[j]=cvtpk_s(f[2*j]*rs*gn[2*j],f[2*j+1]*rs*gn[2*j+1]);
      ATTN_STORE16(Ow+(long)row*OPITCH+ch*8,w);} }
  asm volatile("s_waitcnt lgkmcnt(0)\n\ts_barrier":::"memory");
  #undef DMA_K
  #undef DMA_V
  #undef QBF
  #undef KBLD
  #undef SETQB
  #undef CMASK
  #undef START
  #undef RESC
  #undef ROT
}
constexpr int ATTN_LDS_BYTES=LDS_BYTES;
struct AttnTensors { const bf16* Q; const bf16* K; const bf16* V; bf16* O; const float* cum; const float* gnorm; };
struct AttnUnit { int bh; int qb; };
struct StaticOrder {
  int vcu;
  __device__ __forceinline__ explicit StaticOrder(int grid,int block):vcu((block%8)*(grid/8)+block/8){}
  __device__ __forceinline__ bool next(int i,AttnUnit&u)const{ if(i>=2)return false; const int s=vcu&3; u.bh=vcu>>2; u.qb=(i==0)?7-s:s; return true; }
  __device__ __forceinline__ void a_ready(const AttnUnit&)const{}
  __device__ __forceinline__ void done(const AttnUnit&)const{}
};
template<class Sched,int THRL=8> __device__ __forceinline__ void attn_phase(char*lds,const AttnTensors&T,const Sched&S,const int wv){
  AttnUnit u;
  for(int i=0;S.next(i,u);++i){ S.a_ready(u); attn_unit<THRL>(u.bh/NHEAD,u.bh%NHEAD,u.qb,T.Q,T.K,T.V,T.O,T.cum+(long)u.bh*SEQ,T.gnorm,lds,wv); S.done(u); }
}
#undef SBAR
#undef WAIT_BAR
}
namespace gdn {
typedef unsigned short bf16_t;
typedef short bf16x8 __attribute__((ext_vector_type(8)));
typedef float f32x16 __attribute__((ext_vector_type(16)));
typedef float f32x4 __attribute__((ext_vector_type(4)));
typedef float f32x2 __attribute__((ext_vector_type(2)));
typedef unsigned u32x4 __attribute__((ext_vector_type(4)));
typedef unsigned u32x2 __attribute__((ext_vector_type(2)));
typedef __bf16 bf16x2_t __attribute__((ext_vector_type(2)));
#define GLAS __attribute__((address_space(3)))
constexpr int CH = 64, DK = 128, NCH = 32, NITEM = 8 * 4 * NCH, FRAGS = 56, ITEM_ELEMS = FRAGS * 512;
constexpr float L2E = 1.4426950408889634f;
__device__ __forceinline__ int crow(int r, int hi) { return (r & 3) + 8 * (r >> 2) + 4 * hi; }
__device__ __forceinline__ float bf2f(unsigned short u) { return __uint_as_float((unsigned)u << 16); }
__device__ __forceinline__ unsigned cvtpk(float lo, float hi) { f32x2 v = {lo, hi}; bf16x2_t b = __builtin_convertvector(v, bf16x2_t); return __builtin_bit_cast(unsigned, b); }
__device__ __forceinline__ unsigned short f2bf1(float x) { return (unsigned short)(cvtpk(x, 0.f) & 0xffffu); }
__device__ __forceinline__ int frag_off(int r, int kl) { return ((((kl >> 2) & 1) * 32 + r) << 3) + ((kl >> 3) << 2) + (kl & 3); }
__device__ __forceinline__ float silu_f(float y) { return y * __builtin_amdgcn_rcpf(1.f + __expf(-y)); }

constexpr int L_QS = 0, L_KS = 16384, L_MM = 32768, MM_LD = 68, L_SC = L_MM + CH * MM_LD * 4, SLOT_BYTES = 65536;
static_assert(L_SC + 4 * 64 * 4 <= SLOT_BYTES, "gdn LDS slot");
__device__ __forceinline__ int swz(int row, int c16) { return row * 256 + ((c16 ^ (row & 15)) << 4); }

struct G1Args { const bf16_t *GQ, *GK, *GV; const float *small, *cw, *a_log, *dt_bias; float* U; bf16_t* FR; float* GL; };

__device__ __forceinline__ void conv64(const bf16_t* src, bool first, float c0, float c1, float c2, float c3, float (&y)[64]) {
    float x0 = 0.f, x1 = 0.f, x2 = 0.f;
    if (!first) { x0 = bf2f(src[-3 * 512]); x1 = bf2f(src[-2 * 512]); x2 = bf2f(src[-1 * 512]); }
#pragma unroll
    for (int g = 0; g < 4; ++g) {
#pragma unroll
        for (int i = 16 * g; i < 16 * g + 16; ++i) { const float xi = bf2f(src[i * 512]); y[i] = silu_f(c0 * x0 + c1 * x1 + c2 * x2 + c3 * xi); x0 = x1; x1 = x2; x2 = xi; }
    }
}
__device__ __forceinline__ void conv64_lds(const bf16_t* src, bool first, float c0, float c1, float c2, float c3, GLAS unsigned char* img, int c) {
    float x0 = 0.f, x1 = 0.f, x2 = 0.f;
    if (!first) { x0 = bf2f(src[-3 * 512]); x1 = bf2f(src[-2 * 512]); x2 = bf2f(src[-1 * 512]); }
#pragma unroll
    for (int g = 0; g < 4; ++g) {
#pragma unroll
        for (int i = 16 * g; i < 16 * g + 16; ++i) { const float xi = bf2f(src[i * 512]); *(GLAS bf16_t*)(img + swz(i, c >> 3) + (c & 7) * 2) = f2bf1(silu_f(c0 * x0 + c1 * x1 + c2 * x2 + c3 * xi)); x0 = x1; x1 = x2; x2 = xi; }
    }
}

__device__ __forceinline__ void g1_pair(const G1Args& A, int pair, GLAS unsigned char* lds0, const int wave) {
    const int lane = lane_id(), tid = wave * 64 + lane,
               isl = wave >> 2, lw = wave & 3, lt = tid & 255;
    const int item = pair * 2 + isl, bh = item >> 5, n = item & 31, b = bh >> 2, h = bh & 3;
    const size_t m0 = (size_t)b * 2048 + (size_t)n * 64;
    GLAS unsigned char* lds = lds0 + isl * SLOT_BYTES;
    GLAS float* SC = (GLAS float*)(lds + L_SC);
    GLAS float* MM = (GLAS float*)(lds + L_MM);
    bf16_t* fr = A.FR + (size_t)item * ITEM_ELEMS;
    const bool first = (n == 0);
    float y[64];
    {
        const int which = (lw < 2) ? 2 : 1, c = (lw & 1) * 64 + lane, cc = which * 512 + h * 128 + c;
        const bf16_t* src = ((lw < 2) ? A.GV : A.GK) + m0 * 512 + h * 128 + c;
        conv64(src, first, A.cw[cc], A.cw[1536 + cc], A.cw[2 * 1536 + cc], A.cw[3 * 1536 + cc], y);
        if (lw >= 2) {
#pragma unroll
            for (int i = 0; i < 64; ++i) *(GLAS bf16_t*)(lds + L_KS + swz(i, c >> 3) + (c & 7) * 2) = f2bf1(y[i]);
        }
    }
    if (lw < 2) {
        const int c = lw * 64 + lane, cc = h * 128 + c;
        conv64_lds(A.GQ + m0 * 512 + h * 128 + c, first, A.cw[cc], A.cw[1536 + cc], A.cw[2 * 1536 + cc], A.cw[3 * 1536 + cc], lds + L_QS, c);
    } else if (lw == 2) {
        const float gb = A.small[(m0 + lane) * 16 + 8 + h], ga = A.small[(m0 + lane) * 16 + 12 + h] + A.dt_bias[h];
        const float sp = fmaxf(ga, 0.f) + log1pf(__expf(-fabsf(ga)));
        float g = -__expf(A.a_log[h]) * sp;
#pragma unroll
        for (int o = 1; o < 64; o <<= 1) { const float t = __shfl_up(g, o); if (lane >= o) g += t; }
        SC[128 + lane] = 1.f / (1.f + __expf(-gb));
        SC[192 + lane] = g;
        if (lane == 63) A.GL[item] = __builtin_amdgcn_exp2f(g * L2E);
    }
    __syncthreads();
    {
        const int r = lt >> 2, qd = lt & 3; float sq = 0.f, sk = 0.f;
#pragma unroll
        for (int jj = 0; jj < 4; ++jj) {
            const u32x4 vq = *(const GLAS u32x4*)(lds + L_QS + swz(r, qd * 4 + jj)), vk = *(const GLAS u32x4*)(lds + L_KS + swz(r, qd * 4 + jj));
#pragma unroll
            for (int e = 0; e < 4; ++e) { const float a0 = __uint_as_float(vq[e] << 16), a1 = __uint_as_float(vq[e] & 0xffff0000u), b0 = __uint_as_float(vk[e] << 16), b1 = __uint_as_float(vk[e] & 0xffff0000u);
                sq += a0 * a0 + a1 * a1; sk += b0 * b0 + b1 * b1; }
        }
        sq += __shfl_xor(sq, 1); sq += __shfl_xor(sq, 2); sk += __shfl_xor(sk, 1); sk += __shfl_xor(sk, 2);
        if (qd == 0) { SC[r] = rsqrtf(sq + 1e-6f) * 0.08838834764831845f; SC[64 + r] = rsqrtf(sk + 1e-6f); }
    }
    __syncthreads();
    {
        const int ti = lw >> 1, tj = lw & 1, r32 = lane & 31, hi = lane >> 5;
        f32x16 kk = {}, qk = {};
#pragma unroll
        for (int s = 0; s < 8; ++s) {
            const bf16x8 aK = *(const GLAS bf16x8*)(lds + L_KS + swz(32 * ti + r32, 2 * s + hi)), aQ = *(const GLAS bf16x8*)(lds + L_QS + swz(32 * ti + r32, 2 * s + hi));
            const bf16x8 bK = *(const GLAS bf16x8*)(lds + L_KS + swz(32 * tj + r32, 2 * s + hi));
            kk = __builtin_amdgcn_mfma_f32_32x32x16_bf16(aK, bK, kk, 0, 0, 0); qk = __builtin_amdgcn_mfma_f32_32x32x16_bf16(aQ, bK, qk, 0, 0, 0);
        }
        const int j = 32 * tj + r32; const float rkj = SC[64 + j], gcj = SC[192 + j];
        bf16_t* af = fr + (32 + ti * 4 + (j >> 4)) * 512;
#pragma unroll
        for (int r = 0; r < 16; ++r) {
            const int il = crow(r, hi), i = 32 * ti + il;
            const float e = __builtin_amdgcn_exp2f(fminf(SC[192 + i] - gcj, 0.f) * L2E);
            const float mv = (i > j) ? SC[128 + i] * SC[64 + i] * rkj * kk[r] * e : 0.f;
            const float av = (i >= j) ? SC[i] * rkj * qk[r] * e : 0.f;
            MM[i * MM_LD + j] = mv;
            af[frag_off(il, j & 15)] = f2bf1(av);
        }
    }
    __syncthreads();
    {
        const int c = (lw & 1) * 64 + lane;
        if (lw >= 2) {
            const float gl = SC[192 + 63];
            const int T = c >> 5, r = c & 31;
#pragma unroll
            for (int ks = 0; ks < 4; ++ks)
#pragma unroll
                for (int hh = 0; hh < 2; ++hh) {
                    float kd[8];
#pragma unroll
                    for (int a = 0; a < 2; ++a)
#pragma unroll
                        for (int bq = 0; bq < 4; ++bq) { const int i = 16 * ks + 8 * a + 4 * hh + bq; kd[4 * a + bq] = y[i] * SC[64 + i] * __builtin_amdgcn_exp2f((gl - SC[192 + i]) * L2E); }
                    u32x4 w; w.x = cvtpk(kd[0], kd[1]); w.y = cvtpk(kd[2], kd[3]); w.z = cvtpk(kd[4], kd[5]); w.w = cvtpk(kd[6], kd[7]);
                    *(u32x4*)(fr + (40 + T * 4 + ks) * 512 + ((hh * 32 + r) << 3)) = w;
                }
#pragma unroll
            for (int i = 0; i < 64; ++i) y[i] = y[i] * SC[64 + i] * SC[128 + i] * __builtin_amdgcn_exp2f(SC[192 + i] * L2E);
        } else {
#pragma unroll
            for (int i = 0; i < 64; ++i) y[i] *= SC[128 + i];
        }
#pragma unroll
        for (int i = 1; i < 64; ++i) {
            float acc = y[i];
#pragma unroll
            for (int j4 = 0; j4 < (i + 3) / 4; ++j4) {
                const f32x4 m = *(const GLAS f32x4*)(MM + i * MM_LD + 4 * j4);
                acc -= m[0] * y[4 * j4];
                if (4 * j4 + 1 < i) acc -= m[1] * y[4 * j4 + 1];
                if (4 * j4 + 2 < i) acc -= m[2] * y[4 * j4 + 2];
                if (4 * j4 + 3 < i) acc -= m[3] * y[4 * j4 + 3];
            }
            y[i] = acc;
        }
        if (lw >= 2) {
            const int ks = c >> 4, kl = c & 15;
#pragma unroll
            for (int i = 0; i < 64; ++i) fr[((i >> 5) * 8 + ks) * 512 + frag_off(i & 31, kl)] = f2bf1(-y[i]);
        } else {
            float* up = A.U + (size_t)item * 8192 + (size_t)(c >> 5) * 2048 + (c & 31) * 4;
#pragma unroll
            for (int I = 0; I < 2; ++I)
#pragma unroll
                for (int g = 0; g < 4; ++g)
#pragma unroll
                    for (int hh = 0; hh < 2; ++hh) { const int i0 = 32 * I + 8 * g + 4 * hh; *(f32x4*)(up + ((I * 4 + g) * 64 + hh * 32) * 4) = (f32x4){y[i0], y[i0 + 1], y[i0 + 2], y[i0 + 3]}; }
        }
        const int r = lt >> 2, qd = lt & 3; const float sc = SC[r] * __builtin_amdgcn_exp2f(SC[192 + r] * L2E);
#pragma unroll
        for (int jj = 0; jj < 4; ++jj) {
            const int c16 = qd * 4 + jj; const u32x4 vq = *(const GLAS u32x4*)(lds + L_QS + swz(r, c16));
            float f[8];
#pragma unroll
            for (int e = 0; e < 4; ++e) { f[2 * e] = __uint_as_float(vq[e] << 16) * sc; f[2 * e + 1] = __uint_as_float(vq[e] & 0xffff0000u) * sc; }
            bf16_t* qf = fr + (16 + (r >> 5) * 8 + (c16 >> 1)) * 512;
            u32x2 w0, w1; w0.x = cvtpk(f[0], f[1]); w0.y = cvtpk(f[2], f[3]); w1.x = cvtpk(f[4], f[5]); w1.y = cvtpk(f[6], f[7]);
            *(u32x2*)(qf + frag_off(r & 31, 8 * (c16 & 1))) = w0;
            *(u32x2*)(qf + frag_off(r & 31, 8 * (c16 & 1) + 4)) = w1;
        }
    }
    __syncthreads();
}

__device__ __forceinline__ void glds16(const void* gsrc, unsigned lds_dst) { unsigned keep;
    asm volatile("s_mov_b32 %0, m0\n\ts_mov_b32 m0, %2\n\ts_nop 0\n\tglobal_load_lds_dwordx4 %1, off\n\ts_mov_b32 m0, %0" : "=&s"(keep) : "v"(gsrc), "s"(lds_dst) : "memory"); }
__device__ __forceinline__ void scan_block(int bh, float* U, const bf16_t* FR, const float* GL, GLAS unsigned char* lds, const int wave) {
    const int lane = lane_id(), lw = wave & 3, r32 = lane & 31, hi = lane >> 5;
    const bool loader = wave >= 4;
    const int b = bh >> 2, h = bh & 3;
    const unsigned lds0 = (unsigned)(uintptr_t)lds;
    const bf16_t* frl = FR + (size_t)bh * NCH * ITEM_ELEMS + lane * 8;
#define SCAN_BAR() asm volatile("s_waitcnt vmcnt(0) lgkmcnt(0)\n\ts_barrier" ::: "memory")
    { const bf16_t* src = frl + wave * 7 * 512; unsigned dst = (unsigned)__builtin_amdgcn_readfirstlane(lds0 + wave * 7 * 1024);
#pragma unroll 1
      for (int p = 0; p < 7; ++p) { glds16(src, dst); src += 512; dst += 1024; } }
    f32x16 S[4], UN[2];
    float* ub = U + (size_t)bh * NCH * 8192 + (size_t)lw * 2048 + lane * 4;
    if (!loader) {
#pragma unroll
        for (int T = 0; T < 4; ++T) S[T] = f32x16{};
#pragma unroll
        for (int I = 0; I < 2; ++I)
#pragma unroll
            for (int g = 0; g < 4; ++g) { const f32x4 t = *(const f32x4*)(ub + (I * 4 + g) * 256); UN[I][4 * g] = t[0]; UN[I][4 * g + 1] = t[1]; UN[I][4 * g + 2] = t[2]; UN[I][4 * g + 3] = t[3]; }
    }
    SCAN_BAR();
    for (int n = 0; n < NCH; ++n) {
        if (loader) {
            if (n + 1 < NCH) {
                const bf16_t* src = frl + (size_t)(n + 1) * ITEM_ELEMS + lw * 14 * 512; unsigned dst = (unsigned)__builtin_amdgcn_readfirstlane(lds0 + ((n + 1) & 1) * (FRAGS * 1024) + lw * 14 * 1024);
#pragma unroll 1
                for (int p = 0; p < 14; ++p) { glds16(src, dst); src += 512; dst += 1024; }
            }
        } else {
            const GLAS bf16x8* fb = (const GLAS bf16x8*)(lds + (n & 1) * (FRAGS * 1024)) + lane;
            float* ut = ub + (size_t)n * 8192;
            const float gl = GL[bh * NCH + n];
            bf16x8 sf[4][2];
#pragma unroll
            for (int T = 0; T < 4; ++T)
#pragma unroll
                for (int s = 0; s < 2; ++s) { u32x4 p;
#pragma unroll
                    for (int e = 0; e < 4; ++e) p[e] = cvtpk(S[T][8 * s + 2 * e], S[T][8 * s + 2 * e + 1]);
                    sf[T][s] = __builtin_bit_cast(bf16x8, p); }
            f32x16 VN[2];
#pragma unroll
            for (int I = 0; I < 2; ++I) {
                VN[I] = UN[I];
#pragma unroll
                for (int ks = 0; ks < 8; ++ks) VN[I] = __builtin_amdgcn_mfma_f32_32x32x16_bf16(fb[(I * 8 + ks) * 64], sf[ks >> 1][ks & 1], VN[I], 0, 0, 0);
            }
            if (n + 1 < NCH) {
#pragma unroll
                for (int I = 0; I < 2; ++I)
#pragma unroll
                    for (int g = 0; g < 4; ++g) { const f32x4 t = *(const f32x4*)(ut + 8192 + (I * 4 + g) * 256); UN[I][4 * g] = t[0]; UN[I][4 * g + 1] = t[1]; UN[I][4 * g + 2] = t[2]; UN[I][4 * g + 3] = t[3]; }
            }
            bf16x8 vf[2][2];
#pragma unroll
            for (int J = 0; J < 2; ++J)
#pragma unroll
                for (int s = 0; s < 2; ++s) { u32x4 p;
#pragma unroll
                    for (int e = 0; e < 4; ++e) p[e] = cvtpk(VN[J][8 * s + 2 * e], VN[J][8 * s + 2 * e + 1]);
                    vf[J][s] = __builtin_bit_cast(bf16x8, p); }
#pragma unroll
            for (int I = 0; I < 2; ++I) {
                f32x16 O = {};
#pragma unroll
                for (int ks = 0; ks < 8; ++ks) O = __builtin_amdgcn_mfma_f32_32x32x16_bf16(fb[(16 + I * 8 + ks) * 64], sf[ks >> 1][ks & 1], O, 0, 0, 0);
#pragma unroll
                for (int ks = 0; ks < 2 * (I + 1); ++ks) O = __builtin_amdgcn_mfma_f32_32x32x16_bf16(fb[(32 + I * 4 + ks) * 64], vf[ks >> 1][ks & 1], O, 0, 0, 0);
#pragma unroll
                for (int g = 0; g < 4; ++g) *(f32x4*)(ut + (I * 4 + g) * 256) = (f32x4){O[4 * g], O[4 * g + 1], O[4 * g + 2], O[4 * g + 3]};
            }
#pragma unroll
            for (int T = 0; T < 4; ++T) {
                S[T] = S[T] * gl;
#pragma unroll
                for (int ks = 0; ks < 4; ++ks) S[T] = __builtin_amdgcn_mfma_f32_32x32x16_bf16(fb[(40 + T * 4 + ks) * 64], vf[ks >> 1][ks & 1], S[T], 0, 0, 0);
            }
        }
        SCAN_BAR();
    }
#undef SCAN_BAR
}
#undef GLAS
}
#ifndef PG8_SP2
#define PG8_SP2 true
#endif
#ifndef PG8_ALIGN
#define PG8_ALIGN true
#endif
constexpr int NWAVES = 8;
constexpr int NB = 8, SEQ = 2048, D = 1024, M = NB * SEQ, FF = 4096;
constexpr int HF = 8, HG = 4;
constexpr int DPROJ = 3600, NPROJ = 3840;
constexpr float EPS = 1e-6f;
constexpr float LOG2E = 1.4426950408889634f;
constexpr float QSCALE = 0.125f * LOG2E;
constexpr int C_FF = 1536, C_GQ = 1544, C_GB = 3080, C_GA = 3084, C_GZ = 3088;
constexpr size_t MiB = 1u << 20;
constexpr size_t WS_CTL = 0, CTL_ZERO_BYTES = 1 * MiB;
constexpr size_t WS_WIN = 2 * MiB, WS_WOUT = 10 * MiB, WS_WUP = 12 * MiB, WS_WDN = 20 * MiB;
constexpr size_t WS_X = 28 * MiB;
constexpr size_t WS_XN = 32 * MiB;
constexpr size_t WS_FQ = 64 * MiB, WS_G512 = 16 * MiB;
constexpr size_t WS_SMALL = 176 * MiB;
constexpr size_t WS_CUM = 177 * MiB;
constexpr size_t WS_GU = 32 * MiB;
constexpr size_t WS_GL = 179 * MiB;
constexpr size_t WS_BETA = 178 * MiB, WS_GDEC = 178 * MiB + 512 * 1024;
constexpr size_t WS_MIXED = 192 * MiB;
constexpr size_t WS_H = 64 * MiB;
constexpr size_t WS_MIXOUT = 64 * MiB;
constexpr size_t WS_Y = 192 * MiB;
constexpr size_t WS_END = 256 * MiB;
constexpr int CW_TMO = 0, CW_CODE = 1;
constexpr int CW_BAR = 4096;
constexpr int CW_SEAM = 16384, SEAM_BANK = 128 * 64;
constexpr int RING_OFF = 0, RING_BYTES = 131072;
constexpr int LDSCTL_OFF = RING_BYTES, MISC_OFF = LDSCTL_OFF + 320;
constexpr int LDS_BYTES = 147456;
#define GAS __attribute__((address_space(1)))
#define LAS __attribute__((address_space(3)))
typedef unsigned short bf16;
typedef unsigned v4u __attribute__((ext_vector_type(4)));
typedef float f32x4 __attribute__((ext_vector_type(4)));
typedef short bf16x8 __attribute__((ext_vector_type(8)));
typedef GAS unsigned gu32;
typedef GAS unsigned long long gu64;
#define RLX_AGENT __ATOMIC_RELAXED, __HIP_MEMORY_SCOPE_AGENT
#define LDS_WAIT() asm volatile("s_waitcnt lgkmcnt(0)" ::: "memory")
#define VM_WAIT() asm volatile("s_waitcnt vmcnt(0)" ::: "memory")
__device__ __forceinline__ unsigned long long rt() { return __builtin_amdgcn_s_memrealtime(); }
__device__ __forceinline__ unsigned f2bf(float f) { unsigned u = __builtin_bit_cast(unsigned, f); return (u + 0x7fffu + ((u >> 16) & 1u)) >> 16; }
__device__ __forceinline__ unsigned pk2(float lo, float hi) { return f2bf(lo) | (f2bf(hi) << 16); }

#define XB_TMO      128
#define XB_XCNT(j)  (256  + 64 * (j))
#define XB_XSUB(j)  (1280 + 64 * (j))
#define XB_XGEN(j)  (2304 + 64 * (j))
#define XB_TOP      3328
#define XB_TOPGEN   3392
#define XCD_BAR_WORDS 3456
#define XB_SPIN_CAP (1u << 18)

__device__ __forceinline__ unsigned xb_ld(unsigned* p)              { return __hip_atomic_load(p, __ATOMIC_RELAXED, __HIP_MEMORY_SCOPE_AGENT); }
__device__ __forceinline__ unsigned xb_add(unsigned* p, unsigned v) { return __hip_atomic_fetch_add(p, v, __ATOMIC_RELAXED, __HIP_MEMORY_SCOPE_AGENT); }
__device__ __forceinline__ unsigned xb_xcc_id() { return (unsigned)__builtin_amdgcn_s_getreg((3 << 11) | 20) & 0xFu; }
#define XB_SPIN(cond, bar) do { unsigned _sp = 0; while (cond) { __builtin_amdgcn_s_sleep(1); \
    if ((++_sp & 255u) == 0u) { if (xb_ld(&(bar)[XB_TMO])) break; if (_sp > XB_SPIN_CAP) { atomicAdd(&(bar)[XB_TMO], 1u); break; } } } } while (0)

struct XcdBarrier {
    unsigned* bar; unsigned x;
    volatile LAS unsigned* st;
};

__device__ __forceinline__ XcdBarrier xcd_barrier_post(unsigned* bar, volatile LAS unsigned* st, const bool t0) {
    XcdBarrier b; b.bar = bar; b.x = xb_xcc_id(); b.st = st;
    if (t0) (void)xb_add(&bar[XB_XCNT(b.x)], 1u);
    return b;
}
__device__ __forceinline__ void xcd_barrier_complete(unsigned* bar, unsigned x, unsigned& nloc, unsigned& nx) {
    const unsigned G = gridDim.x * gridDim.y * gridDim.z;
    unsigned sum, cnt, mine, sp = 0u;
    for (;;) {
        sum = 0u; cnt = 0u; mine = 0u;
#pragma unroll
        for (unsigned j = 0; j < 16; ++j) { const unsigned c = xb_ld(&bar[XB_XCNT(j)]); sum += c; cnt += (c > 0u) ? 1u : 0u; mine = (j == x) ? c : mine; }
        if (sum == G) break;
        __builtin_amdgcn_s_sleep(1);
        if ((++sp & 255u) == 0u) { if (xb_ld(&bar[XB_TMO])) break; if (sp > XB_SPIN_CAP) { atomicAdd(&bar[XB_TMO], 1u); break; } }
    }
    nloc = mine > 0u ? mine : 1u; nx = cnt > 0u ? cnt : 1u;
}

__device__ __forceinline__ void xcd_barrier(const XcdBarrier& b, const bool t0) {
    asm volatile("s_waitcnt vmcnt(0)" ::: "memory");
    __syncthreads();
    if (t0) {
        unsigned* bar = b.bar;
        __builtin_amdgcn_s_waitcnt(0);
        unsigned nloc = b.st[0], nx = b.st[1];
        if (nloc == 0u) { xcd_barrier_complete(bar, b.x, nloc, nx); b.st[0] = nloc; b.st[1] = nx; }
        const unsigned old = xb_add(&bar[XB_XSUB(b.x)], 1u);
        const unsigned gen = old / nloc;
        if (old + 1u == (gen + 1u) * nloc) {
            __builtin_amdgcn_fence(__ATOMIC_RELEASE, "agent");
            asm volatile("s_waitcnt vmcnt(0)" ::: "memory");
            const unsigned og = xb_add(&bar[XB_TOP], 1u);
            const unsigned tg = og / nx;
            if (og + 1u == (tg + 1u) * nx) xb_add(&bar[XB_TOPGEN], 1u);
            else XB_SPIN(xb_ld(&bar[XB_TOPGEN]) == tg, bar);
            __builtin_amdgcn_fence(__ATOMIC_ACQUIRE, "agent");
            xb_add(&bar[XB_XGEN(b.x)], 1u);
            asm volatile("s_waitcnt vmcnt(0)" ::: "memory");
        } else {
            XB_SPIN(xb_ld(&bar[XB_XGEN(b.x)]) == gen, bar);
            __builtin_amdgcn_fence(__ATOMIC_ACQUIRE, "agent");
            asm volatile("s_waitcnt vmcnt(0)" ::: "memory");
        }
    }
    __syncthreads();
}
struct Frame {
    LAS unsigned char* lds;
    volatile LAS unsigned* MISC;
    gu32* ctl;
    int wave;
    int vcu, G;
};
__device__ __forceinline__ float wave_sum(float v) {
#pragma unroll
    for (int o = 1; o < 64; o <<= 1) v += __shfl_xor(v, o);
    return v;
}
__device__ __forceinline__ float bf2f(unsigned short u) { return __uint_as_float((unsigned)u << 16); }
__device__ __forceinline__ int proj_src_col(int n) {
    if (n < 1536) return n;
    if (n < 3072) return n + 8;
    if (n < 3584) return n + 16;
    if (n < 3592) return C_FF + (n - 3584);
    if (n < 3596) return C_GB + (n - 3592);
    if (n < 3600) return C_GA + (n - 3596);
    return -1;
}
template <bool REMAP>
__device__ __forceinline__ void p0_transpose_item(const float* W, int K, int N, int Ndst, bf16* WT, LAS float* scr, int item, int lane) {
    const int nblk = Ndst / 32, kb = item / nblk, nb = item % nblk, k0 = 64 * kb, n0 = 32 * nb;
    const int sc = REMAP ? proj_src_col(n0 + (lane & 31)) : n0 + (lane & 31);
#pragma unroll 8
    for (int i = 0; i < 32; ++i) { const int kk = 2 * i + (lane >> 5); scr[kk * 33 + (lane & 31)] = (sc >= 0) ? W[(size_t)(k0 + kk) * N + sc] : 0.f; }
    LDS_WAIT(); asm volatile("" ::: "memory");
    const int c = lane & 7;
#pragma unroll
    for (int j = 0; j < 4; ++j) { const int n = (lane >> 3) + 8 * j; const LAS float* s = scr + (8 * c) * 33 + n;
        v4u o; o.x = pk2(s[0 * 33], s[1 * 33]); o.y = pk2(s[2 * 33], s[3 * 33]); o.z = pk2(s[4 * 33], s[5 * 33]); o.w = pk2(s[6 * 33], s[7 * 33]);
        *(GAS v4u*)(WT + (size_t)(n0 + n) * K + k0 + 8 * c) = o; }
    LDS_WAIT(); asm volatile("" ::: "memory");
}
__device__ __forceinline__ void rms_row_to_bf16(int lane, const float* xrow, const float* g, bf16* orow) {
    const GAS f32x4* xr = (const GAS f32x4*)xrow + lane; const GAS f32x4* gr = (const GAS f32x4*)g + lane;
    f32x4 v[4]; float s = 0.f;
#pragma unroll
    for (int j = 0; j < 4; ++j) { v[j] = xr[64 * j]; s += (v[j].x * v[j].x + v[j].y * v[j].y) + (v[j].z * v[j].z + v[j].w * v[j].w); }
    const float r = rsqrtf(wave_sum(s) * (1.f / D) + EPS);
    GAS unsigned long long* o8 = (GAS unsigned long long*)orow + lane;
#pragma unroll
    for (int j = 0; j < 4; ++j) { const f32x4 gg = gr[64 * j];
        o8[64 * j] = (unsigned long long)pk2(v[j].x * r * gg.x, v[j].y * r * gg.y) | ((unsigned long long)pk2(v[j].z * r * gg.z, v[j].w * r * gg.w) << 32); }
}
__device__ __forceinline__ void resnorm_row(int lane, const float* yrow, const float* g1, const float* baserow, float* outrow, const float* g2, bf16* xnrow) {
    const GAS f32x4* yr = (const GAS f32x4*)yrow + lane; const GAS f32x4* gr = (const GAS f32x4*)g1 + lane; const GAS f32x4* br = (const GAS f32x4*)baserow + lane;
    f32x4 v[4]; float s = 0.f;
#pragma unroll
    for (int j = 0; j < 4; ++j) { v[j] = yr[64 * j]; s += (v[j].x * v[j].x + v[j].y * v[j].y) + (v[j].z * v[j].z + v[j].w * v[j].w); }
    const float r = rsqrtf(wave_sum(s) * (1.f / D) + EPS);
    float s2 = 0.f;
#pragma unroll
    for (int j = 0; j < 4; ++j) { const f32x4 gg = gr[64 * j], bb = br[64 * j]; v[j] = bb + v[j] * r * gg; s2 += (v[j].x * v[j].x + v[j].y * v[j].y) + (v[j].z * v[j].z + v[j].w * v[j].w);
        ((GAS f32x4*)outrow + lane)[64 * j] = v[j]; }
    if (xnrow) {
        const float r2 = rsqrtf(wave_sum(s2) * (1.f / D) + EPS); const GAS f32x4* g2r = (const GAS f32x4*)g2 + lane;
        GAS unsigned long long* o8 = (GAS unsigned long long*)xnrow + lane;
#pragma unroll
        for (int j = 0; j < 4; ++j) { const f32x4 gg = g2r[64 * j];
            o8[64 * j] = (unsigned long long)pk2(v[j].x * r2 * gg.x, v[j].y * r2 * gg.y) | ((unsigned long long)pk2(v[j].z * r2 * gg.z, v[j].w * r2 * gg.w) << 32); }
    }
}

typedef float f32x2v __attribute__((ext_vector_type(2)));
__device__ __forceinline__ void cum_item(int bh, const float* small, const float* fbias, float* cum, LAS float* part, int tid, int lane, int wave) {
    const int b = bh >> 3, h = bh & 7; const float bz = fbias[h];
    float loc[4]; float s = 0.f;
#pragma unroll
    for (int e = 0; e < 4; ++e) { const float z = small[((size_t)b * SEQ + tid * 4 + e) * 16 + h] + bz; s += fminf(z, 0.f) - log1pf(__expf(-fabsf(z))); loc[e] = s; }
    float inc = s;
#pragma unroll
    for (int o = 1; o < 64; o <<= 1) { const float t = __shfl_up(inc, o); if (lane >= o) inc += t; }
    if (lane == 63) part[wave] = inc;
    __syncthreads();
    float base = inc - s;
    for (int w = 0; w < wave; ++w) base += part[w];
#pragma unroll
    for (int e = 0; e < 4; ++e) cum[(size_t)bh * SEQ + tid * 4 + e] = loc[e] + base;
    __syncthreads();
}

__device__ __forceinline__ int opaque_lane() { return lane_id(); }
struct Args { const float* in[15]; float* out; unsigned char* ws; int ph_lo, ph_hi, li, pad; };
enum { PH_PRO = 0, PH_PROJ = 1, PH_MIX = 2, PH_WO = 3, PH_N1 = 4, PH_UP = 5, PH_DOWN = 6, PH_N2 = 7, PH_END = 8 };

__global__ void __launch_bounds__(NWAVES * 64, 2) skel_fwd(Args args) {
    extern __shared__ __attribute__((aligned(16))) unsigned char lds[];
    Frame F;
    F.lds = (LAS unsigned char*)lds;
    F.MISC = (volatile LAS unsigned*)(F.lds + MISC_OFF);
    F.wave = __builtin_amdgcn_readfirstlane((int)threadIdx.x >> 6);
    F.G = gridDim.x; { const int bx = blockIdx.x; F.vcu = (F.G % 8 == 0) ? (bx % 8) * (F.G / 8) + bx / 8 : bx; }
    unsigned char* ws = args.ws;
    F.ctl = (gu32*)(ws + WS_CTL);
    const float* x = args.in[0]; const float* g_premix = args.in[1]; const float* w_in = args.in[2];
    const float* w_out = args.in[9]; const float* g_postmix = args.in[10]; const float* g_premlp = args.in[11];
    const float* w_up = args.in[12]; const float* w_down = args.in[13]; const float* g_postmlp = args.in[14];
    bf16* Win_t = (bf16*)(ws + WS_WIN); bf16* Wout_t = (bf16*)(ws + WS_WOUT); bf16* Wup_t = (bf16*)(ws + WS_WUP); bf16* Wdn_t = (bf16*)(ws + WS_WDN);
    bf16* XN = (bf16*)(ws + WS_XN); bf16* FQ = (bf16*)(ws + WS_FQ); bf16* MIXED = (bf16*)(ws + WS_MIXED); bf16* HB = (bf16*)(ws + WS_H);
    float* SMALL = (float*)(ws + WS_SMALL); float* MIXOUT = (float*)(ws + WS_MIXOUT); float* Y = (float*)(ws + WS_Y);
    for (int u = F.wave * 64 + lane_id(); u < (LDS_BYTES - LDSCTL_OFF) / 4; u += NWAVES * 64) ((LAS unsigned*)(F.lds + LDSCTL_OFF))[u] = 0u;
    __syncthreads();
#define T0 (F.wave == 0 && lane_id() == 0)
    XcdBarrier bar = xcd_barrier_post((unsigned*)(F.ctl + CW_BAR) + args.li * XCD_BAR_WORDS, F.MISC + 8, T0);
    const int lo = args.ph_lo, hi = args.ph_hi;
#define IN(k) (lo <= (k) && (k) < hi)
#define BOTH(k) (IN(k) && IN((k) + 1))
#define GRID_BAR() xcd_barrier(bar, T0)
    const int gw = F.vcu * NWAVES + F.wave, NGW = F.G * NWAVES;

    if (IN(PH_PRO)) {
        LAS float* scr = (LAS float*)(F.lds + RING_OFF + F.wave * 16384);
        constexpr int I_IN = (D / 64) * (NPROJ / 32), I_O = (D / 64) * (D / 32), I_1 = (D / 64) * (FF / 32), I_2 = (FF / 64) * (D / 32);
        constexpr int NITEMS = I_IN + I_O + I_1 + I_2;
        for (int it = gw; it < NITEMS; it += NGW) {
            int r = it;
            if (r < I_IN) { p0_transpose_item<true>(w_in, D, DPROJ, NPROJ, Win_t, scr, r, lane_id()); continue; } r -= I_IN;
            if (r < I_O) { p0_transpose_item<false>(w_out, D, D, D, Wout_t, scr, r, lane_id()); continue; } r -= I_O;
            if (r < I_1) { p0_transpose_item<false>(w_up, D, FF, FF, Wup_t, scr, r, lane_id()); continue; } r -= I_1;
            p0_transpose_item<false>(w_down, FF, D, D, Wdn_t, scr, r, lane_id());
        }
        { const int ln = opaque_lane(); for (int m = gw; m < M; m += NGW) rms_row_to_bf16(ln, x + (size_t)m * D, g_premix, XN + (size_t)m * D); }
        if (BOTH(PH_PRO)) GRID_BAR();
    }
    if (IN(PH_PROJ)) {
        pg8::Gemm g{XN, Win_t, M, NPROJ, D}; pg8::StaticOrder S; S.init(M, NPROJ, F.G, (int)blockIdx.x);
        pg8::EpiProj E{FQ, (size_t)(WS_G512 / 2), SMALL, QSCALE};
        pg8::gemm_phase<pg8::EpiProj, pg8::StaticOrder, PG8_ALIGN, PG8_SP2>(F.lds + RING_OFF, g, S, E, F.wave);
        if (BOTH(PH_PROJ)) GRID_BAR();
    }
    if (IN(PH_MIX)) {
        float* CUM = (float*)(ws + WS_CUM); float* GU = (float*)(ws + WS_GU); float* GLp = (float*)(ws + WS_GL); bf16* FR = (bf16*)args.out;
        if (F.vcu < NB * HF) cum_item(F.vcu, SMALL, args.in[3], CUM, (LAS float*)(F.lds + RING_OFF), F.wave * 64 + lane_id(), lane_id(), F.wave);
        {
            const gdn::G1Args GA{FQ + 3 * (WS_G512 / 2), FQ + 4 * (WS_G512 / 2), FQ + 5 * (WS_G512 / 2), SMALL, args.in[5], args.in[6], args.in[7], GU, FR, GLp};
_Pragma("nounroll")
            for (int k = 0; k < 2 * ((gdn::NITEM / 2 + 2 * F.G - 1) / (2 * F.G)); ++k) { const int pr = (k >> 1) * 2 * F.G + F.vcu * 2 + (k & 1); if (pr < gdn::NITEM / 2) gdn::g1_pair(GA, pr, F.lds + RING_OFF, F.wave); }
        }
        GRID_BAR();
        {
            static_assert(attn_body::ATTN_LDS_BYTES <= RING_BYTES, "attention LDS");
            const attn_body::AttnTensors AT{(const attn_body::bf16*)FQ, (const attn_body::bf16*)(FQ + WS_G512 / 2), (const attn_body::bf16*)(FQ + 2 * (WS_G512 / 2)), (attn_body::bf16*)MIXED, CUM, args.in[4]};
            const attn_body::StaticOrder S((int)F.G, (int)blockIdx.x);
            attn_body::attn_phase<attn_body::StaticOrder>((char*)lds + RING_OFF, AT, S, F.wave);
        }
        if (F.vcu < NB * HG) gdn::scan_block(F.vcu, GU, FR, GLp, F.lds + RING_OFF, F.wave);
        GRID_BAR();
        {
            const bf16* GZ = FQ + 6 * (WS_G512 / 2); const float* gno = args.in[8]; const int ln = opaque_lane(), lc = ln & 31, hh = ln >> 5;
            for (int it = gw; it < gdn::NITEM * 8; it += NGW) {
                const int item = it >> 3, I = (it >> 2) & 1, g = it & 3, bh = item >> 5, n = item & 31, b = bh >> 2, h = bh & 3;
                const float* src = GU + (size_t)item * 8192 + ((I * 4 + g) * 64 + ln) * 4;
                f32x4 v[4]; float ss[4] = {0.f, 0.f, 0.f, 0.f};
#pragma unroll
                for (int w = 0; w < 4; ++w) { v[w] = *(const GAS f32x4*)(src + w * 2048);
#pragma unroll
                    for (int e = 0; e < 4; ++e) ss[e] += v[w][e] * v[w][e]; }
#pragma unroll
                for (int e = 0; e < 4; ++e) {
#pragma unroll
                    for (int o = 1; o < 32; o <<= 1) ss[e] += __shfl_xor(ss[e], o);
                    ss[e] = rsqrtf(ss[e] * (1.f / 128.f) + EPS); }
                const size_t m0 = (size_t)b * SEQ + n * 64 + 32 * I + 8 * g + 4 * hh;
#pragma unroll
                for (int w = 0; w < 4; ++w) { const int col = h * 128 + 32 * w + lc; const float gg = gno[32 * w + lc];
#pragma unroll
                    for (int e = 0; e < 4; ++e) { const float z = bf2f(GZ[(m0 + e) * 512 + col]);
                        MIXED[(m0 + e) * D + 512 + col] = (bf16)f2bf(v[w][e] * ss[e] * gg * z / (1.f + __expf(-z))); } }
            }
        }
        if (BOTH(PH_MIX)) GRID_BAR();
    }
    if (IN(PH_WO)) {
        pg8::Gemm g{MIXED, Wout_t, M, D, D}; pg8::StaticOrder S; S.init(M, D, F.G, (int)blockIdx.x);
        pg8::EpiF32 E{MIXOUT, D};
        pg8::gemm_phase<pg8::EpiF32, pg8::StaticOrder, false, PG8_SP2>(F.lds + RING_OFF, g, S, E, F.wave);
        if (BOTH(PH_WO)) GRID_BAR();
    }
    if (IN(PH_N1)) {
        { const int ln = opaque_lane(); for (int m = gw; m < M; m += NGW) resnorm_row(ln, MIXOUT + (size_t)m * D, g_postmix, x + (size_t)m * D, args.out + (size_t)m * D, g_premlp, XN + (size_t)m * D); }
        if (BOTH(PH_N1)) GRID_BAR();
    }
    if (IN(PH_UP)) {
        pg8::Gemm g{XN, Wup_t, M, FF, D}; pg8::StaticOrder S; S.init(M, FF, F.G, (int)blockIdx.x);
        pg8::EpiRelu2 E{HB, FF};
        pg8::gemm_phase<pg8::EpiRelu2, pg8::StaticOrder, PG8_ALIGN, PG8_SP2>(F.lds + RING_OFF, g, S, E, F.wave);
        if (BOTH(PH_UP)) GRID_BAR();
    }
    if (IN(PH_DOWN)) {
        pg8::Gemm g{HB, Wdn_t, M, D, FF}; pg8::StaticOrder S; S.init(M, D, F.G, (int)blockIdx.x);
        pg8::EpiF32 E{Y, D};
        pg8::gemm_phase<pg8::EpiF32, pg8::StaticOrder, false, PG8_SP2>(F.lds + RING_OFF, g, S, E, F.wave);
        if (BOTH(PH_DOWN)) GRID_BAR();
    }
    if (IN(PH_N2)) {
        { const int ln = opaque_lane(); for (int m = gw; m < M; m += NGW) resnorm_row(ln, Y + (size_t)m * D, g_postmlp, args.out + (size_t)m * D, args.out + (size_t)m * D, nullptr, nullptr); }
    }
#undef IN
#undef BOTH
#undef GRID_BAR
#undef T0
}
static void launch_skel(int grid, hipStream_t stream, Args a, int lo, int hi, int li) {
    a.ph_lo = lo; a.ph_hi = hi; a.li = li;
    hipLaunchKernelGGL(skel_fwd, dim3(grid), dim3(NWAVES * 64), LDS_BYTES, stream, a);
    const hipError_t le = hipPeekAtLastError();
    if (le != hipSuccess) fprintf(stderr, "kernel_launch: launch %d failed: %s\n", li, hipGetErrorName(le));
}
extern "C" void kernel_launch(void* const* d_in, const int* in_sizes, int n_in, void* d_out, int out_size, void* d_ws, size_t ws_size, hipStream_t stream) {
    static int grid = 0;
    if (grid == 0) {
        if (n_in != 15 || in_sizes[0] != M * D || out_size != M * D || ws_size < WS_END) { fprintf(stderr, "kernel_launch: unexpected shapes (n_in %d, in0 %d, out %d, ws %zu); nothing launched\n", n_in, n_in > 0 ? in_sizes[0] : -1, out_size, ws_size); grid = -1; return; }
        int dev = 0, cus = 0, per_cu = 0;
        if (hipGetDevice(&dev) != hipSuccess || hipDeviceGetAttribute(&cus, hipDeviceAttributeMultiprocessorCount, dev) != hipSuccess) { grid = -1; return; }
        if (hipFuncSetAttribute((const void*)skel_fwd, hipFuncAttributeMaxDynamicSharedMemorySize, LDS_BYTES) != hipSuccess) { fprintf(stderr, "kernel_launch: hipFuncSetAttribute failed\n"); grid = -1; return; }
        if (hipOccupancyMaxActiveBlocksPerMultiprocessor(&per_cu, (const void*)skel_fwd, NWAVES * 64, LDS_BYTES) != hipSuccess || per_cu < 1)
            fprintf(stderr, "kernel_launch: note: occupancy query reports %d workgroups per CU\n", per_cu);
        (void)hipGetLastError();
        grid = cus;
    }
    if (grid < 0) return;
    if (hipMemsetAsync((char*)d_ws + WS_CTL, 0, CTL_ZERO_BYTES, stream) != hipSuccess) { fprintf(stderr, "kernel_launch: hipMemsetAsync failed\n"); return; }
    Args a{};
    for (int i = 0; i < 15; ++i) a.in[i] = (const float*)d_in[i];
    a.out = (float*)d_out; a.ws = (unsigned char*)d_ws;
    HOST_LAUNCH_PROGRAM
}
```

```cpp
#include <hip/hip_runtime.h>
#include <cstdio>
#include <cstdint>
__device__ __forceinline__ int lane_id() { int l = (int)__builtin_amdgcn_mbcnt_hi(~0u, __builtin_amdgcn_mbcnt_lo(~0u, 0u)); asm volatile("" : "+v"(l)); return l; }
#define HOST_LAUNCH_PROGRAM launch_skel(grid, stream, a, PH_PRO, PH_END, 0);
namespace pg8 {
#define PG8_LAS __attribute__((address_space(3)))
typedef unsigned short bf16_t;
typedef short bf16x8 __attribute__((ext_vector_type(8)));
typedef float f32x4 __attribute__((ext_vector_type(4)));
typedef unsigned u32x4 __attribute__((ext_vector_type(4)));
constexpr int BM = 256, BK = 64, HALF = 128, HTB = HALF * BK * 2  , STAGE_BYTES = 8 * HTB, NXCD = 8, WGM = 8;

__host__ __device__ __forceinline__ int lds_byte(int r, int c) { const int st = (r >> 4) * 2 + (c >> 5), rr = r & 15, cc = c & 31, ob = rr * 64 + cc * 2; return st * 1024 + (ob ^ (((ob >> 9) & 1) << 5)); }
__host__ __device__ __forceinline__ void stage_rc(int b, int& R, int& C) { const int st = b / 1024, sb = b % 1024, swz = sb ^ (((sb >> 9) & 1) << 5); R = (st >> 1) * 16 + swz / 64; C = (st & 1) * 32 + (swz % 64) / 2; }
__host__ __device__ __forceinline__ int perm32(int rho) { const int n = rho >> 4, i = rho & 15; return 8 * (i >> 2) + 4 * n + (i & 3); }

struct Unit { int pm, pn; };
struct Gemm { const bf16_t* A; const bf16_t* Bt; int M, N, K; };

struct StaticOrder {
    int nM, nN, nwg, G, c;
    __host__ __device__ void init(int M, int N, int G_, int c_) { nM = M / BM; nN = N / BM; nwg = nM * nN; G = G_; c = c_; }
    __host__ __device__ bool next(int i, Unit& u) const {
        const long L = (long)i * G + c; if (L >= nwg) return false;
        int wgid = (int)L; { const int q = nwg / NXCD, r = nwg % NXCD, xcd = wgid % NXCD, off = wgid / NXCD; wgid = (xcd < r ? xcd * (q + 1) : r * (q + 1) + (xcd - r) * q) + off; }
        const int nig = WGM * nN, gid = wgid / nig, fm = gid * WGM, gsz = (nM - fm) < WGM ? (nM - fm) : WGM;
        u.pm = fm + ((wgid % nig) % gsz); u.pn = (wgid % nig) / gsz; return true;
    }
    __device__ __forceinline__ void a_ready(const Unit&) const {}
    __device__ __forceinline__ void done(const Unit&) const {}
};

__device__ __forceinline__ unsigned cvt_pk_bf16(float lo, float hi) { unsigned r; asm volatile("v_cvt_pk_bf16_f32 %0, %1, %2" : "=v"(r) : "v"(lo), "v"(hi)); return r; }
typedef float f32x2 __attribute__((ext_vector_type(2)));
struct EpiProj {
    static constexpr bool PERM = true, AFTER_DRAIN = false;
    bf16_t* O; size_t gstride; float* small; float qscale;
    __device__ __forceinline__ void operator()(const f32x4 (&acc)[2][2][4][2], const Unit& u, int wr, int wc, int fr, int fq) const {
        const int row0 = u.pm * BM + wr * 64 + fr;
        if (u.pn < 14) {
            const int t = u.pn >> 1; bf16_t* base = O + (size_t)t * gstride; const float sc = (t == 0) ? qscale : 1.f;
            const int col0 = (u.pn & 1) * 256 + wc * 32 + 8 * fq;
#pragma unroll
            for (int ai = 0; ai < 2; ++ai)
#pragma unroll
                for (int m = 0; m < 4; ++m) { bf16_t* rowp = base + (size_t)(row0 + ai * HALF + m * 16) * 512 + col0;
#pragma unroll
                    for (int bj = 0; bj < 2; ++bj) { const f32x4 v0 = acc[ai][bj][m][0] * sc, v1 = acc[ai][bj][m][1] * sc;
                        u32x4 w; w.x = cvt_pk_bf16(v0[0], v0[1]); w.y = cvt_pk_bf16(v0[2], v0[3]); w.z = cvt_pk_bf16(v1[0], v1[1]); w.w = cvt_pk_bf16(v1[2], v1[3]);
                        *(u32x4*)(rowp + bj * HALF) = w; } }
        } else {
            if (wc == 0 && fq < 2) {
#pragma unroll
                for (int ai = 0; ai < 2; ++ai)
#pragma unroll
                    for (int m = 0; m < 4; ++m) { float* rowp = small + (size_t)(row0 + ai * HALF + m * 16) * 16 + 8 * fq;
                        *(f32x4*)(rowp) = acc[ai][0][m][0]; *(f32x4*)(rowp + 4) = acc[ai][0][m][1]; }
            }
        }
    }
};
struct EpiRelu2 {
    static constexpr bool PERM = true, AFTER_DRAIN = false;
    bf16_t* O; int ldc;
    __device__ __forceinline__ void operator()(const f32x4 (&acc)[2][2][4][2], const Unit& u, int wr, int wc, int fr, int fq) const {
        const int row0 = u.pm * BM + wr * 64 + fr, col0 = u.pn * BM + wc * 32 + 8 * fq;
#pragma unroll
        for (int ai = 0; ai < 2; ++ai)
#pragma unroll
            for (int m = 0; m < 4; ++m) { bf16_t* rowp = O + (size_t)(row0 + ai * HALF + m * 16) * ldc + col0;
#pragma unroll
                for (int bj = 0; bj < 2; ++bj) { f32x4 v0 = acc[ai][bj][m][0], v1 = acc[ai][bj][m][1];
#pragma unroll
                    for (int e = 0; e < 4; ++e) { const float a = fmaxf(v0[e], 0.f), b = fmaxf(v1[e], 0.f); v0[e] = a * a; v1[e] = b * b; }
                    u32x4 w; w.x = cvt_pk_bf16(v0[0], v0[1]); w.y = cvt_pk_bf16(v0[2], v0[3]); w.z = cvt_pk_bf16(v1[0], v1[1]); w.w = cvt_pk_bf16(v1[2], v1[3]);
                    *(u32x4*)(rowp + bj * HALF) = w; } }
    }
};
struct EpiF32 {
    static constexpr bool PERM = false, AFTER_DRAIN = false;
    float* O; int ldc;
    __device__ __forceinline__ void operator()(const f32x4 (&acc)[2][2][4][2], const Unit& u, int wr, int wc, int fr, int fq) const {
        const int row0 = u.pm * BM + wr * 64 + fr, col0 = u.pn * BM + wc * 32 + 4 * fq;
#pragma unroll
        for (int ai = 0; ai < 2; ++ai)
#pragma unroll
            for (int m = 0; m < 4; ++m) { float* rowp = O + (size_t)(row0 + ai * HALF + m * 16) * ldc + col0;
#pragma unroll
                for (int bj = 0; bj < 2; ++bj)
#pragma unroll
                    for (int n = 0; n < 2; ++n) *(f32x4*)(rowp + bj * HALF + n * 16) = acc[ai][bj][m][n]; }
    }
};
template <class Epi, class Sched, bool ALIGN_EPI = false, bool SP2 = false>
__device__ __forceinline__ void gemm_phase(PG8_LAS unsigned char* lds, const Gemm g, const Sched& S, const Epi& E, const int wv) {
    const int lane = lane_id(), wid = wv, tid = wv * 64 + lane, wr = wid >> 2, wc = wid & 3, fr = lane & 15, fq = lane >> 4;
    const int K = g.K, nt = K / BK;
    unsigned voffA[2], voffB[2];
#pragma unroll
    for (int i = 0; i < 2; ++i) { int R, C; stage_rc(tid * 16 + i * 8192, R, C); const int Rb = Epi::PERM ? ((R & ~31) + perm32(R & 31)) : R;
        voffA[i] = (unsigned)(R * K + C) * 2u; voffB[i] = (unsigned)(Rb * K + C) * 2u; }
    const size_t kstep = (size_t)(BK * 2);
    const size_t hstep = (size_t)HALF * K * 2;
    const size_t tstep = 2 * hstep;
    const unsigned ldsw = (unsigned)wid * 1024u;
    const int aoff = lds_byte(wr * 64 + fr, fq * 8), boff = lds_byte(wc * 32 + fr, fq * 8);
#define PG8_SA(b, h) (((b) * 2 + (h)) * HTB)
#define PG8_SB(b, h) ((4 + (b) * 2 + (h)) * HTB)
#define PG8_STAGE(bufoff, gbase, voff) do { _Pragma("unroll") for (int _i = 0; _i < 2; ++_i) \
        __builtin_amdgcn_global_load_lds((const unsigned*)((const char*)(gbase) + (voff)[_i]), (PG8_LAS unsigned*)(lds + (bufoff) + ldsw + _i * 8192), 16, 0, 0); } while (0)
#define PG8_LDA(dst, b, h) do { _Pragma("unroll") for (int m = 0; m < 4; ++m) _Pragma("unroll") for (int k = 0; k < 2; ++k) dst[m][k] = *(const PG8_LAS bf16x8*)(lds + PG8_SA(b, h) + aoff + m * 2048 + k * 1024); } while (0)
#define PG8_LDB(dst, b, h) do { _Pragma("unroll") for (int n = 0; n < 2; ++n) _Pragma("unroll") for (int k = 0; k < 2; ++k) dst[n][k] = *(const PG8_LAS bf16x8*)(lds + PG8_SB(b, h) + boff + n * 2048 + k * 1024); } while (0)
#define PG8_MMA(ai, bj, At, Bt) do { __builtin_amdgcn_s_setprio(1); _Pragma("unroll") for (int m = 0; m < 4; ++m) _Pragma("unroll") for (int n = 0; n < 2; ++n) _Pragma("unroll") for (int k = 0; k < 2; ++k) \
        acc[ai][bj][m][n] = __builtin_amdgcn_mfma_f32_16x16x32_bf16(Bt[n][k], At[m][k], acc[ai][bj][m][n], 0, 0, 0); __builtin_amdgcn_s_setprio(0); } while (0)
#define PG8_WAIT_V(n) asm volatile("s_waitcnt vmcnt(" #n ")" ::: "memory")
#define PG8_WAIT_L(n) asm volatile("s_waitcnt lgkmcnt(" #n ")" ::: "memory")
#define PG8_BAR __builtin_amdgcn_s_barrier()
#define PG8_SCHED __builtin_amdgcn_sched_barrier(0)
    Unit cur, nxt; int ui = 0;
    if (!S.next(0, cur)) return;
    f32x4 acc[2][2][4][2];
#pragma unroll
    for (int a = 0; a < 2; ++a)
#pragma unroll
        for (int b = 0; b < 2; ++b)
#pragma unroll
            for (int m = 0; m < 4; ++m)
#pragma unroll
                for (int n = 0; n < 2; ++n) acc[a][b][m][n] = (f32x4){0.f, 0.f, 0.f, 0.f};
    bf16x8 At[4][2], B0[2][2], B1[2][2];
    const char* cA = (const char*)g.A + (size_t)cur.pm * tstep; const char* cB = (const char*)g.Bt + (size_t)cur.pn * tstep;
    S.a_ready(cur);
    if constexpr (SP2) {
        PG8_STAGE(PG8_SB(0, 0), cB, voffB); PG8_STAGE(PG8_SB(0, 1), cB + hstep, voffB); PG8_STAGE(PG8_SA(0, 0), cA, voffA); PG8_STAGE(PG8_SA(0, 1), cA + hstep, voffA);
        if (wr == 1) PG8_BAR;
        PG8_WAIT_V(2); PG8_BAR;
        PG8_STAGE(PG8_SB(1, 0), cB + kstep, voffB); PG8_STAGE(PG8_SA(1, 0), cA + kstep, voffA); PG8_STAGE(PG8_SB(1, 1), cB + hstep + kstep, voffB);
        PG8_WAIT_V(6); PG8_BAR;
    } else {
        PG8_STAGE(PG8_SB(0, 0), cB, voffB); PG8_STAGE(PG8_SA(0, 0), cA, voffA); PG8_STAGE(PG8_SB(0, 1), cB + hstep, voffB); PG8_STAGE(PG8_SA(0, 1), cA + hstep, voffA);
        if (wr == 1) PG8_BAR;
        PG8_WAIT_V(4); PG8_BAR;
        PG8_STAGE(PG8_SB(1, 0), cB + kstep, voffB); PG8_STAGE(PG8_SA(1, 0), cA + kstep, voffA); PG8_STAGE(PG8_SB(1, 1), cB + hstep + kstep, voffB);
        PG8_WAIT_V(6); PG8_BAR;
    }
    for (;;) {
        const bool has_next = S.next(ui + 1, nxt);
        const char* nA = has_next ? (const char*)g.A + (size_t)nxt.pm * tstep : cA; const char* nB = has_next ? (const char*)g.Bt + (size_t)nxt.pn * tstep : cB;
        for (int t = 0; t < nt; t += 2) {
            const bool last = (t == nt - 2);
            const char* a1 = cA + (size_t)(t + 1) * kstep;
            const char* a2 = last ? nA : cA + (size_t)(t + 2) * kstep; const char* b2 = last ? nB : cB + (size_t)(t + 2) * kstep;
            const char* a3 = a2 + kstep; const char* b3 = b2 + kstep;
            if (last && has_next) S.a_ready(nxt);
            if constexpr (SP2) {
            PG8_LDB(B0, 0, 0); PG8_LDB(B1, 0, 1); PG8_SCHED; PG8_LDA(At, 0, 0); PG8_STAGE(PG8_SA(1, 1), a1 + hstep, voffA);
            PG8_WAIT_V(8); PG8_WAIT_L(0); PG8_BAR; PG8_MMA(0, 0, At, B0); PG8_MMA(0, 1, At, B1); PG8_BAR; PG8_SCHED;
            PG8_LDA(At, 0, 1); PG8_STAGE(PG8_SB(0, 0), b2, voffB); PG8_STAGE(PG8_SB(0, 1), b2 + hstep, voffB); PG8_STAGE(PG8_SA(0, 0), a2, voffA);
            PG8_WAIT_V(8); PG8_WAIT_L(0); PG8_BAR; PG8_MMA(1, 0, At, B0); PG8_MMA(1, 1, At, B1); PG8_BAR; PG8_SCHED;
            PG8_LDB(B0, 1, 0); PG8_LDB(B1, 1, 1); PG8_SCHED; PG8_LDA(At, 1, 0); PG8_STAGE(PG8_SA(0, 1), a2 + hstep, voffA);
            PG8_WAIT_V(8); PG8_WAIT_L(0); PG8_BAR; PG8_MMA(0, 0, At, B0); PG8_MMA(0, 1, At, B1); PG8_BAR; PG8_SCHED;
            PG8_LDA(At, 1, 1); PG8_STAGE(PG8_SB(1, 0), b3, voffB); PG8_STAGE(PG8_SB(1, 1), b3 + hstep, voffB); PG8_STAGE(PG8_SA(1, 0), a3, voffA);
            PG8_WAIT_V(8); PG8_WAIT_L(0); PG8_BAR; PG8_MMA(1, 0, At, B0); PG8_MMA(1, 1, At, B1); PG8_BAR; PG8_SCHED;
            } else {
            PG8_LDB(B0, 0, 0); PG8_SCHED; PG8_LDA(At, 0, 0); PG8_STAGE(PG8_SA(1, 1), a1 + hstep, voffA);
            PG8_WAIT_L(8); PG8_BAR; PG8_WAIT_L(0); PG8_MMA(0, 0, At, B0); PG8_BAR; PG8_SCHED;
            PG8_LDB(B1, 0, 1); PG8_STAGE(PG8_SB(0, 0), b2, voffB);
            PG8_BAR; PG8_WAIT_L(0); PG8_MMA(0, 1, At, B1); PG8_BAR;
            PG8_LDA(At, 0, 1); PG8_STAGE(PG8_SA(0, 0), a2, voffA);
            PG8_BAR; PG8_WAIT_L(0); PG8_MMA(1, 0, At, B0); PG8_BAR; PG8_SCHED;
            PG8_STAGE(PG8_SB(0, 1), b2 + hstep, voffB);
            PG8_WAIT_V(6); PG8_BAR; PG8_MMA(1, 1, At, B1); PG8_BAR;
            PG8_LDB(B0, 1, 0); PG8_SCHED; PG8_LDA(At, 1, 0); PG8_STAGE(PG8_SA(0, 1), a2 + hstep, voffA);
            PG8_WAIT_L(8); PG8_BAR; PG8_WAIT_L(0); PG8_MMA(0, 0, At, B0); PG8_BAR; PG8_SCHED;
            PG8_LDB(B1, 1, 1); PG8_STAGE(PG8_SB(1, 0), b3, voffB);
            PG8_BAR; PG8_WAIT_L(0); PG8_MMA(0, 1, At, B1); PG8_BAR;
            PG8_LDA(At, 1, 1); PG8_STAGE(PG8_SA(1, 0), a3, voffA);
            PG8_BAR; PG8_WAIT_L(0); PG8_MMA(1, 0, At, B0); PG8_BAR; PG8_SCHED;
            PG8_STAGE(PG8_SB(1, 1), b3 + hstep, voffB);
            PG8_WAIT_V(6); PG8_BAR; PG8_MMA(1, 1, At, B1); PG8_BAR;
            }
        }
        if constexpr (ALIGN_EPI) { if (wr == 0) PG8_BAR; }
        if constexpr (!Epi::AFTER_DRAIN) { E(acc, cur, wr, wc, fr, fq); S.done(cur); }
        if (!has_next) break;
#pragma unroll
        for (int a = 0; a < 2; ++a)
#pragma unroll
            for (int b = 0; b < 2; ++b)
#pragma unroll
                for (int m = 0; m < 4; ++m)
#pragma unroll
                    for (int n = 0; n < 2; ++n) acc[a][b][m][n] = (f32x4){0.f, 0.f, 0.f, 0.f};
        cur = nxt; cA = nA; cB = nB; ++ui;
        if constexpr (ALIGN_EPI) { if (wr == 1) PG8_BAR; }
    }
    PG8_WAIT_V(0);
    if constexpr (!ALIGN_EPI) { if (wr == 0) PG8_BAR; }
    PG8_BAR;
    if constexpr (Epi::AFTER_DRAIN) { E.fused(acc, cur, wr, wc, fr, fq, lds, wid, lane); S.done(cur); }
#undef PG8_SA
#undef PG8_SB
#undef PG8_STAGE
#undef PG8_LDA
#undef PG8_LDB
#undef PG8_MMA
#undef PG8_WAIT_V
#undef PG8_WAIT_L
#undef PG8_BAR
#undef PG8_SCHED
}
}
#include <hip/hip_bf16.h>
#include <cmath>
namespace attn_body {
using bf16=__hip_bfloat16;
using bf16x8=__attribute__((ext_vector_type(8)))short;
using s16x4=__attribute__((ext_vector_type(4)))short;
using f32x16=__attribute__((ext_vector_type(16)))float;
using u32x4=__attribute__((ext_vector_type(4)))unsigned;
constexpr int BATCH=8,NHEAD=8,SEQ=2048,D=64,DM=NHEAD*D,OPITCH=1024;
constexpr int NW=8,QBLK=32,QB=QBLK*NW,KVBLK=64,NQB=SEQ/QB;
constexpr int ATTN_PITCH=DM, ATTN_UNIT_ROWS=QB;
__device__ __forceinline__ int crow(int r,int hi){return (r&3)+8*(r>>2)+4*hi;}
#define SBAR() __builtin_amdgcn_sched_barrier(0)
__device__ __forceinline__ void cmask(f32x16&p0,f32x16&p1,int jb,int qrel,int hi){
  const float NEG=-INFINITY; int kb=64*jb+4*hi;
  #pragma unroll
  for(int r=0;r<16;++r){int kv=kb+(r&3)+8*(r>>2); if(kv>qrel)p0[r]=NEG; if(kv+32>qrel)p1[r]=NEG;}
}

constexpr int NSLOT=3, SLOTB=8192;
constexpr int LDS_K=0, LDS_V=NSLOT*SLOTB, LDS_WS=2*NSLOT*SLOTB, LDS_OST=LDS_WS+NW*64*4, LDS_KB=LDS_OST+NW*4096, LDS_BYTES=LDS_KB+SEQ*16;
constexpr float C2=0.125f*1.4426950408889634f;
__device__ __forceinline__ void glds16(const void*gsrc,unsigned lds_dst){unsigned keep;
  asm volatile("s_mov_b32 %0, m0\n\ts_mov_b32 m0, %2\n\ts_nop 0\n\tglobal_load_lds_dwordx4 %1, off\n\ts_mov_b32 m0, %0":"=&s"(keep):"v"(gsrc),"s"(lds_dst):"memory");}
__device__ __forceinline__ float max3f(float a,float b,float c){float r;asm("v_max3_f32 %0, %1, %2, %3":"=v"(r):"v"(a),"v"(b),"v"(c));return r;}
__device__ __forceinline__ float max2f(float a,float b){float r;asm("v_max_f32_e32 %0, %1, %2":"=v"(r):"v"(a),"v"(b));return r;}
__device__ __forceinline__ float fadd_s(float a,float b){float r;asm("v_add_f32_e32 %0, %1, %2":"=v"(r):"v"(a),"v"(b));return r;}
__device__ __forceinline__ float fsub_s(float a,float b){float r;asm("v_sub_f32_e32 %0, %1, %2":"=v"(r):"v"(a),"v"(b));return r;}
typedef float f32x2_t __attribute__((ext_vector_type(2))); typedef __bf16 bf16x2_t __attribute__((ext_vector_type(2)));
__device__ __forceinline__ unsigned cvtpk_s(float lo,float hi){f32x2_t v={lo,hi};bf16x2_t b=__builtin_convertvector(v,bf16x2_t);return __builtin_bit_cast(unsigned,b);}
#define WAIT_BAR(N) asm volatile("s_waitcnt vmcnt(" #N ") lgkmcnt(0)\n\ts_barrier":::"memory")

__device__ __forceinline__ void qkt(f32x16&p0,f32x16&p1,const char*Kslot,const bf16x8*qr,const bf16x8 ka0,const bf16x8 ka1,const bf16x8 qbf,int r32,int hi){
  p0=__builtin_amdgcn_mfma_f32_32x32x16_bf16(ka0,qbf,f32x16{},0,0,0);p1=__builtin_amdgcn_mfma_f32_32x32x16_bf16(ka1,qbf,f32x16{},0,0,0);
  const char*kb=Kslot+hi*1024+r32*16;
  #pragma unroll
  for(int d0=0;d0<4;++d0){
    const bf16x8 b0=*reinterpret_cast<const bf16x8*>(kb+d0*2048);
    const bf16x8 b1=*reinterpret_cast<const bf16x8*>(kb+d0*2048+512);
    p0=__builtin_amdgcn_mfma_f32_32x32x16_bf16(b0,qr[d0],p0,0,0,0);p1=__builtin_amdgcn_mfma_f32_32x32x16_bf16(b1,qr[d0],p1,0,0,0);}
}
typedef __attribute__((address_space(3))) const char* lds_cptr;
typedef short v4i16_t __attribute__((ext_vector_type(4)));
__device__ __forceinline__ void kload8(bf16x8*kf,lds_cptr kp){
  kf[0]=*(const __attribute__((address_space(3))) bf16x8*)(kp);      kf[1]=*(const __attribute__((address_space(3))) bf16x8*)(kp+512);
  kf[2]=*(const __attribute__((address_space(3))) bf16x8*)(kp+2048); kf[3]=*(const __attribute__((address_space(3))) bf16x8*)(kp+2560);
  kf[4]=*(const __attribute__((address_space(3))) bf16x8*)(kp+4096); kf[5]=*(const __attribute__((address_space(3))) bf16x8*)(kp+4608);
  kf[6]=*(const __attribute__((address_space(3))) bf16x8*)(kp+6144); kf[7]=*(const __attribute__((address_space(3))) bf16x8*)(kp+6656);
}
__device__ __forceinline__ void kload2(bf16x8*kf,lds_cptr kp,int j){ kf[2*j]=*(const __attribute__((address_space(3))) bf16x8*)(kp+j*2048); kf[2*j+1]=*(const __attribute__((address_space(3))) bf16x8*)(kp+j*2048+512); }
__device__ __forceinline__ s16x4 vtr(lds_cptr p){ return __builtin_bit_cast(s16x4,__builtin_amdgcn_ds_read_tr16_b64_v4i16((__attribute__((address_space(3))) v4i16_t*)p)); }
__device__ __forceinline__ float rowmax(const f32x16&p0,const f32x16&p1){
  float a=max3f(p0[0],p0[1],p1[0]),b=max3f(p0[2],p0[3],p1[1]);a=max3f(a,p1[2],p1[3]);
  #pragma unroll
  for(int r=4;r<16;r+=4){a=max3f(a,p0[r],p0[r+1]);b=max3f(b,p0[r+2],p0[r+3]);a=max3f(a,p1[r],p1[r+1]);b=max3f(b,p1[r+2],p1[r+3]);}
  const float m=max2f(a,b);
  auto rr=__builtin_amdgcn_permlane32_swap(__float_as_uint(m),__float_as_uint(m),false,false);
  return max2f(__uint_as_float(rr[0]),__uint_as_float(rr[1]));
}
__device__ __forceinline__ void pv(f32x16*o,int vb,bf16x8 pa0,bf16x8 pa1,bf16x8 pa2,bf16x8 pa3){
  #pragma unroll
  for(int d0=0;d0<2;++d0){s16x4 lo[4],hi[4];
    #pragma unroll
    for(int ks=0;ks<4;++ks){
      asm volatile("ds_read_b64_tr_b16 %0,%1 offset:%c2":"=&v"(lo[ks]):"v"(vb),"i"(d0*4096+ks*1024):"memory");
      asm volatile("ds_read_b64_tr_b16 %0,%1 offset:%c2":"=&v"(hi[ks]):"v"(vb),"i"(d0*4096+ks*1024+512):"memory");}
    asm volatile("s_waitcnt lgkmcnt(0)":::"memory");SBAR();
    #define PK(k) (bf16x8){lo[k][0],lo[k][1],lo[k][2],lo[k][3],hi[k][0],hi[k][1],hi[k][2],hi[k][3]}
    o[d0]=__builtin_amdgcn_mfma_f32_32x32x16_bf16(pa0,PK(0),o[d0],0,0,0);
    o[d0]=__builtin_amdgcn_mfma_f32_32x32x16_bf16(pa1,PK(1),o[d0],0,0,0);
    o[d0]=__builtin_amdgcn_mfma_f32_32x32x16_bf16(pa2,PK(2),o[d0],0,0,0);
    o[d0]=__builtin_amdgcn_mfma_f32_32x32x16_bf16(pa3,PK(3),o[d0],0,0,0);
    #undef PK
  }
}

#ifndef ATTN_STORE16
#define ATTN_STORE16(p,v) (*(u32x4*)(p)=(v))
#endif
__device__ __forceinline__ unsigned bfbits(float f){unsigned u=__builtin_bit_cast(unsigned,f);return (u+0x7fffu+((u>>16)&1u))>>16;}
__device__ __forceinline__ void split3(float x,unsigned&h1,unsigned&h2,unsigned&h3){h1=bfbits(x);const float r1=x-__uint_as_float(h1<<16);h2=bfbits(r1);const float r2=r1-__uint_as_float(h2<<16);h3=bfbits(r2);}
template<int THRL> __device__ __forceinline__ void attn_unit(int b,int h,int qb,const bf16*Q,const bf16*__restrict__ K,const bf16*__restrict__ V,bf16*O,const float*cumbh,const float*gnorm,char*shm,const int wid){
  const int lane=lane_id(),tid=wid*64+lane,r32=lane&31,hi=lane>>5;
  const long rowbase=(long)b*SEQ; const int q0=qb*QB;
  const bf16*Qw=Q+(rowbase+q0+wid*QBLK)*DM+h*D;
  const bf16*Kh=K+rowbase*DM+h*D,*Vh=V+rowbase*DM+h*D;
  const unsigned lds0=(unsigned)(uintptr_t)shm;
  float*wsf=(float*)(shm+LDS_WS)+wid*64;
  { const float cref=cumbh[q0]; u32x4*kbw=(u32x4*)(shm+LDS_KB);
    for(int i=tid;i<q0+QB;i+=NW*64){ const float kb=(cref-cumbh[i])*1.4426950408889634f; unsigned h1,h2,h3; split3(kb,h1,h2,h3); kbw[i]=(u32x4){h1|(h2<<16),h3|0x3F800000u,0x3F803F80u,0u}; } }
  const bf16*ksrc=Kh+(long)lane*DM+wid*8;
  const bf16*vsrc=Vh+(long)(16*(wid&3)+(lane>>2))*DM+(wid>>2)*32+(lane&3)*8;
  const unsigned kdst=lds0+LDS_K+wid*1024, vdst=lds0+LDS_V+wid*1024;
  #define DMA_K(t,slot) glds16(ksrc+(long)(t)*KVBLK*DM,(unsigned)__builtin_amdgcn_readfirstlane(kdst+(slot)))
  #define DMA_V(t,slot) glds16(vsrc+(long)(t)*KVBLK*DM,(unsigned)__builtin_amdgcn_readfirstlane(vdst+(slot)))
  const int vb0=(int)(lds0+LDS_V)+((lane>>4)&1)*32+(lane&3)*8+(4*hi+((lane&15)>>2))*64;
  const char*Kbase=shm+LDS_K; bf16x8 kf[8];
  const lds_cptr shm3=(lds_cptr)shm; const lds_cptr kp0=shm3+LDS_K+hi*1024+r32*16; const lds_cptr vp0=shm3+LDS_V+((lane>>4)&1)*32+(lane&3)*8+(4*hi+((lane&15)>>2))*64;
  const int NT=(q0+QB)/KVBLK;
  DMA_K(0,0);DMA_V(0,0);DMA_K(1,SLOTB);
  bf16x8 qr[4];
  #pragma unroll
  for(int d0=0;d0<4;++d0)qr[d0]=*reinterpret_cast<const bf16x8*>(&Qw[(long)r32*DM+d0*16+hi*8]);
  float mhat=0.f,l_reg=0.f;f32x16 o[2];o[0]=f32x16{};o[1]=f32x16{};u32x4 qbw=(u32x4){hi?0u:0x3F803F80u,hi?0u:0x3F80u,0u,0u};
  const lds_cptr kbp0=(lds_cptr)shm+LDS_KB+r32*16;
  #define QBF __builtin_bit_cast(bf16x8,qbw)
  #define KBLD(t,p) (*(const __attribute__((address_space(3))) bf16x8*)(kbp0+((t)*64+(p)*32)*16))
  #define SETQB() do{ unsigned h1_,h2_,h3_; split3(-mhat,h1_,h2_,h3_); qbw[1]=hi?0u:(0x3F80u|(h1_<<16)); qbw[2]=hi?0u:(h2_|(h3_<<16)); asm volatile("":"+v"(qbw)); }while(0)
  const int qrel=wid*QBLK+r32;
  #define CMASK(P0,P1,t) do{int jb_=(t)-(NT-4); if(jb_>=0)cmask(P0,P1,jb_,qrel,hi);}while(0)
  bool resc=false;
  #define START(P0,P1) do{ const float rm=rowmax(P0,P1); resc=false; \
    { const float dl=rm; mhat=fadd_s(mhat,dl); \
      _Pragma("unroll") for(int r=0;r<16;++r){P0[r]=fsub_s(P0[r],dl);P1[r]=fsub_s(P1[r],dl);} \
      SETQB(); } \
    _Pragma("unroll") for(int r=0;r<16;++r)P0[r]=__builtin_amdgcn_exp2f(P0[r]); }while(0)
  #define RESC() do{ if(resc){ asm volatile("s_waitcnt lgkmcnt(0)":::"memory"); \
      _Pragma("unroll") for(int d_=0;d_<2;++d_) _Pragma("unroll") for(int r=0;r<16;++r)o[d_][r]*=wsf[crow(r,hi)]; } }while(0)
  f32x16 pA0,pA1,pB0,pB1;
  int sl_prev=0,sl_cur=0,sl_next=SLOTB;
  #define ROT() do{sl_prev=sl_cur;sl_cur=sl_next;sl_next=(sl_next==(NSLOT-1)*SLOTB)?0:sl_next+SLOTB;}while(0)
  DMA_K(2,2*SLOTB);
  WAIT_BAR(3);
  qkt(pA0,pA1,Kbase,qr,KBLD(0,0),KBLD(0,1),QBF,r32,hi);asm volatile("s_nop 15\n\ts_nop 7":"+v"(pA0),"+v"(pA1));CMASK(pA0,pA1,0);
  START(pA0,pA1);
  _Pragma("unroll") for(int r=0;r<16;++r)pA1[r]=__builtin_amdgcn_exp2f(pA1[r]);
  WAIT_BAR(0);
  DMA_K(3,0);DMA_V(1,SLOTB);
  ROT();
  kload8(kf,kp0+sl_cur);
  WAIT_BAR(2);
  s16x4 vlo[8],vhi[8]; u32x4 pw0,pw1,pw2,pw3;
  #define PKW(P,B) cvtpk_s(P[B],P[B+1])
  #define PAF(k) __builtin_bit_cast(bf16x8,pw##k)
  #define VFR(i) (bf16x8){vlo[i][0],vlo[i][1],vlo[i][2],vlo[i][3],vhi[i][0],vhi[i][1],vhi[i][2],vhi[i][3]}
  #define PIN(x) asm volatile("":"+v"(x))
  #define MX3(a,b,c) __builtin_fmaxf(__builtin_fmaxf((a),(b)),(c))
  #define GAPA(MF,A0,A1,A2,A3,W0,W1,PW) do{ MF; sacc+=A0; sacc+=A1; sacc+=A2; sacc+=A3; PIN(sacc); W0; W1; PIN(PW); SBAR(); }while(0)
  #define EX(v) __builtin_amdgcn_exp2f(v)
  #define GAPB(MF,X,B) do{ MF; X[B]=EX(X[B]); X[B+1]=EX(X[B+1]); X[B+2]=EX(X[B+2]); X[B+3]=EX(X[B+3]); PIN(X); SBAR(); }while(0)
  #define VRD(i) do{ vlo[i]=vtr(vp_+(((i)>>2)*4096+((i)&3)*1024)); vhi[i]=vtr(vp_+(((i)>>2)*4096+((i)&3)*1024+512)); }while(0)
  #define KRD(G,j) do{ if(G){ kload2(kf,kp0+sl_next,j); SBAR(); } }while(0)
  #define STEP(C0,C1,P0,P1,t,GK,GV,GL) do{ SBAR(); \
    const lds_cptr vp_=vp0+sl_prev; \
    { const bf16x8 ka0_=KBLD(t,0), ka1_=KBLD(t,1); VRD(0); SBAR(); \
      C0=__builtin_amdgcn_mfma_f32_32x32x16_bf16(ka0_,QBF,f32x16{},0,0,0); C1=__builtin_amdgcn_mfma_f32_32x32x16_bf16(ka1_,QBF,f32x16{},0,0,0); SBAR(); } \
    float sacc=(P0[0]+P0[1]); \
    GAPA(C0=__builtin_amdgcn_mfma_f32_32x32x16_bf16(kf[0],qr[0],C0,0,0,0), P0[2],P0[3],P0[4],P0[5],     pw0[0]=PKW(P0,0), pw0[1]=PKW(P0,2), pw0); \
    VRD(4); SBAR(); GAPA(C1=__builtin_amdgcn_mfma_f32_32x32x16_bf16(kf[1],qr[0],C1,0,0,0), P0[6],P0[7],P0[8],P0[9],     pw0[2]=PKW(P0,4), pw0[3]=PKW(P0,6), pw0); \
    VRD(1); SBAR(); GAPA(C0=__builtin_amdgcn_mfma_f32_32x32x16_bf16(kf[2],qr[1],C0,0,0,0),   P0[10],P0[11],P0[12],P0[13], pw1[0]=PKW(P0,8), pw1[1]=PKW(P0,10), pw1); \
    VRD(5); SBAR(); GAPA(C1=__builtin_amdgcn_mfma_f32_32x32x16_bf16(kf[3],qr[1],C1,0,0,0),   P0[14],P0[15],P1[0],P1[1],   pw1[2]=PKW(P0,12),pw1[3]=PKW(P0,14), pw1); \
    VRD(2); SBAR(); GAPA(C0=__builtin_amdgcn_mfma_f32_32x32x16_bf16(kf[4],qr[2],C0,0,0,0),   P1[2],P1[3],P1[4],P1[5],     pw2[0]=PKW(P1,0), pw2[1]=PKW(P1,2), pw2); \
    VRD(6); SBAR(); GAPA(C1=__builtin_amdgcn_mfma_f32_32x32x16_bf16(kf[5],qr[2],C1,0,0,0),   P1[6],P1[7],P1[8],P1[9],     pw2[2]=PKW(P1,4), pw2[3]=PKW(P1,6), pw2); \
    VRD(3); SBAR(); GAPA(C0=__builtin_amdgcn_mfma_f32_32x32x16_bf16(kf[6],qr[3],C0,0,0,0),   P1[10],P1[11],P1[12],P1[13], pw3[0]=PKW(P1,8), pw3[1]=PKW(P1,10), pw3); \
    VRD(7); SBAR(); GAPA(C1=__builtin_amdgcn_mfma_f32_32x32x16_bf16(kf[7],qr[3],C1,0,0,0),   P1[14],P1[15],0.f,0.f,       pw3[2]=PKW(P1,12),pw3[3]=PKW(P1,14), pw3); \
    l_reg+=sacc; \
    if(GK){DMA_K((t)+3,sl_cur);} if(GV){DMA_V((t)+1,sl_next);} \
    CMASK(C0,C1,t); \
    { float a=MX3(C0[0],C0[1],C1[0]),b=MX3(C0[2],C0[3],C1[1]); a=MX3(a,C1[2],C1[3]); \
      _Pragma("unroll") for(int r=4;r<16;r+=4){a=MX3(a,C0[r],C0[r+1]);b=MX3(b,C0[r+2],C0[r+3]);a=MX3(a,C1[r],C1[r+1]);b=MX3(b,C1[r+2],C1[r+3]);} \
      float rm=__builtin_fmaxf(a,b); { auto rr=__builtin_amdgcn_permlane32_swap(__float_as_uint(rm),__float_as_uint(rm),false,false); rm=__builtin_fmaxf(__uint_as_float(rr[0]),__uint_as_float(rr[1])); } \
      resc=false; \
      if(__builtin_expect(__any(rm>(float)THRL),0)){ const float dl=__builtin_fmaxf(rm,0.f); mhat+=dl; \
        _Pragma("unroll") for(int r=0;r<16;++r){C0[r]-=dl;C1[r]-=dl;} \
        SETQB(); \
        const float f=__builtin_amdgcn_exp2f(-dl); l_reg*=f; if(hi==0)wsf[r32]=f; resc=true; } } \
    SBAR(); \
    GAPB(o[0]=__builtin_amdgcn_mfma_f32_32x32x16_bf16(PAF(0),VFR(0),o[0],0,0,0), C0,0); \
    GAPB(o[1]=__builtin_amdgcn_mfma_f32_32x32x16_bf16(PAF(0),VFR(4),o[1],0,0,0), C0,4); \
    KRD(GL,0); GAPB(o[0]=__builtin_amdgcn_mfma_f32_32x32x16_bf16(PAF(1),VFR(1),o[0],0,0,0), C0,8); \
    KRD(GL,1); GAPB(o[1]=__builtin_amdgcn_mfma_f32_32x32x16_bf16(PAF(1),VFR(5),o[1],0,0,0), C0,12); \
    KRD(GL,2); GAPB(o[0]=__builtin_amdgcn_mfma_f32_32x32x16_bf16(PAF(2),VFR(2),o[0],0,0,0), C1,0); \
    KRD(GL,3); GAPB(o[1]=__builtin_amdgcn_mfma_f32_32x32x16_bf16(PAF(2),VFR(6),o[1],0,0,0), C1,4); \
    GAPB(o[0]=__builtin_amdgcn_mfma_f32_32x32x16_bf16(PAF(3),VFR(3),o[0],0,0,0), C1,8); \
    GAPB(o[1]=__builtin_amdgcn_mfma_f32_32x32x16_bf16(PAF(3),VFR(7),o[1],0,0,0), C1,12); \
    }while(0)
  int t=1;
  #undef CMASK
  #define CMASK(P0,P1,t) do{}while(0)
  for(;t+5<NT;t+=2){
    STEP(pB0,pB1,pA0,pA1,t,true,true,true);     WAIT_BAR(2); RESC(); ROT();
    STEP(pA0,pA1,pB0,pB1,t+1,true,true,true);   WAIT_BAR(2); RESC(); ROT();
  }
  #undef CMASK
  #define CMASK(P0,P1,t) do{int jb_=(t)-(NT-4); if(jb_>=0)cmask(P0,P1,jb_,qrel,hi);}while(0)
  #define ENDW(tt) do{ if((tt)+3<NT){WAIT_BAR(2);} else if((tt)+2<NT){WAIT_BAR(1);} else {WAIT_BAR(0);} }while(0)
  for(;t+1<NT;t+=2){
    STEP(pB0,pB1,pA0,pA1,t,(t+3<NT),(t+1<NT),(t+1<NT));       ENDW(t);   RESC(); ROT();
    STEP(pA0,pA1,pB0,pB1,t+1,(t+4<NT),(t+2<NT),(t+2<NT));     ENDW(t+1); RESC(); ROT();
  }
  STEP(pB0,pB1,pA0,pA1,NT-1,false,false,false); RESC();
  { float sacc=pB0[0]+pB0[1]; _Pragma("unroll") for(int r=2;r<16;++r)sacc+=pB0[r]; _Pragma("unroll") for(int r=0;r<16;++r)sacc+=pB1[r]; l_reg+=sacc;
    pw0=(u32x4){PKW(pB0,0),PKW(pB0,2),PKW(pB0,4),PKW(pB0,6)};pw1=(u32x4){PKW(pB0,8),PKW(pB0,10),PKW(pB0,12),PKW(pB0,14)};pw2=(u32x4){PKW(pB1,0),PKW(pB1,2),PKW(pB1,4),PKW(pB1,6)};pw3=(u32x4){PKW(pB1,8),PKW(pB1,10),PKW(pB1,12),PKW(pB1,14)};
    SBAR(); pv(o,vb0+sl_cur,PAF(0),PAF(1),PAF(2),PAF(3)); }
  #undef PKW
  #undef PAF
  #undef VFR
  #undef PIN
  #undef MX3
  #undef GAPA
  #undef GAPB
  #undef EX
  #undef VRD
  #undef KRD
  #undef STEP
  #undef ENDW
  {auto rr=__builtin_amdgcn_permlane32_swap(__float_as_uint(l_reg),__float_as_uint(l_reg),false,false);l_reg=__uint_as_float(rr[0])+__uint_as_float(rr[1]);}
  if(hi==0)wsf[32+r32]=l_reg;asm volatile("s_waitcnt lgkmcnt(0)":::"memory");
  float rli[16];
  #pragma unroll
  for(int r=0;r<16;++r)rli[r]=__builtin_amdgcn_rcpf(wsf[32+crow(r,hi)]);
  bf16*Ow=O+(rowbase+q0+wid*QBLK)*OPITCH+h*D;
  float gn[8];
  #pragma unroll
  for(int j=0;j<8;++j)gn[j]=gnorm[(lane&7)*8+j];
  { bf16*stg=(bf16*)(shm+LDS_OST)+wid*2048;
    #pragma unroll
    for(int r=0;r<16;++r){const int orow=crow(r,hi);
      #pragma unroll
      for(int d0=0;d0<2;++d0)stg[orow*64+d0*32+r32]=__float2bfloat16(o[d0][r]*rli[r]);}
    asm volatile("s_waitcnt lgkmcnt(0)":::"memory");
    #pragma unroll
    for(int i=0;i<4;++i){const int row=i*8+(lane>>3),ch=lane&7; const u32x4 v=*(const u32x4*)(stg+row*64+ch*8);
      float f[8];
      #pragma unroll
      for(int j=0;j<4;++j){f[2*j]=__uint_as_float(v[j]<<16);f[2*j+1]=__uint_as_float(v[j]&0xffff0000u);}
      float ss=0.f;
      #pragma unroll
      for(int j=0;j<8;++j)ss+=f[j]*f[j];
      ss+=__shfl_xor(ss,1);ss+=__shfl_xor(ss,2);ss+=__shfl_xor(ss,4);
      const float rs=__builtin_amdgcn_rsqf(ss*(1.f/64.f)+1e-6f);
      u32x4 w;
      #pragma unroll
      for(int j=0;j<4;++j)w[j]=cvtpk_s(f[2*j]*rs*gn[2*j],f[2*j+1]*rs*gn[2*j+1]);
      ATTN_STORE16(Ow+(long)row*OPITCH+ch*8,w);} }
  asm volatile("s_waitcnt lgkmcnt(0)\n\ts_barrier":::"memory");
  #undef DMA_K
  #undef DMA_V
  #undef QBF
  #undef KBLD
  #undef SETQB
  #undef CMASK
  #undef START
  #undef RESC
  #undef ROT
}
constexpr int ATTN_LDS_BYTES=LDS_BYTES;
struct AttnTensors { const bf16* Q; const bf16* K; const bf16* V; bf16* O; const float* cum; const float* gnorm; };
struct AttnUnit { int bh; int qb; };
struct StaticOrder {
  int vcu;
  __device__ __forceinline__ explicit StaticOrder(int grid,int block):vcu((block%8)*(grid/8)+block/8){}
  __device__ __forceinline__ bool next(int i,AttnUnit&u)const{ if(i>=2)return false; const int s=vcu&3; u.bh=vcu>>2; u.qb=(i==0)?7-s:s; return true; }
  __device__ __forceinline__ void a_ready(const AttnUnit&)const{}
  __device__ __forceinline__ void done(const AttnUnit&)const{}
};
struct QueueOrder {
  unsigned* ctr; volatile __attribute__((address_space(3))) unsigned* slot; int grp; int wv;
  __device__ __forceinline__ bool next(int,AttnUnit&u)const{
    if(wv==0&&lane_id()==0)slot[0]=__hip_atomic_fetch_add(ctr+64*grp,1u,__ATOMIC_RELAXED,__HIP_MEMORY_SCOPE_AGENT);
    __syncthreads(); const unsigned i=slot[0]; __syncthreads();
    if(i>=64u)return false; u.qb=7-(int)(i>>3); u.bh=(int)((i&7u)<<3)|grp; return true; }
  __device__ __forceinline__ void a_ready(const AttnUnit&)const{}
  __device__ __forceinline__ void done(const AttnUnit&)const{}
};
template<class Sched,int THRL=8> __device__ __forceinline__ void attn_phase(char*lds,const AttnTensors&T,const Sched&S,const int wv){
  AttnUnit u;
  for(int i=0;S.next(i,u);++i){ S.a_ready(u); attn_unit<THRL>(u.bh/NHEAD,u.bh%NHEAD,u.qb,T.Q,T.K,T.V,T.O,T.cum+(long)u.bh*SEQ,T.gnorm,lds,wv); S.done(u); }
}
#undef SBAR
#undef WAIT_BAR
}
namespace gdn {
typedef unsigned short bf16_t;
typedef short bf16x8 __attribute__((ext_vector_type(8)));
typedef float f32x16 __attribute__((ext_vector_type(16)));
typedef float f32x4 __attribute__((ext_vector_type(4)));
typedef float f32x2 __attribute__((ext_vector_type(2)));
typedef unsigned u32x4 __attribute__((ext_vector_type(4)));
typedef unsigned u32x2 __attribute__((ext_vector_type(2)));
typedef __bf16 bf16x2_t __attribute__((ext_vector_type(2)));
#define GLAS __attribute__((address_space(3)))
constexpr int CH = 64, DK = 128, NCH = 32, NITEM = 8 * 4 * NCH, FRAGS = 56, ITEM_ELEMS = FRAGS * 512;
constexpr float L2E = 1.4426950408889634f;
__device__ __forceinline__ int crow(int r, int hi) { return (r & 3) + 8 * (r >> 2) + 4 * hi; }
__device__ __forceinline__ float bf2f(unsigned short u) { return __uint_as_float((unsigned)u << 16); }
__device__ __forceinline__ unsigned cvtpk(float lo, float hi) { f32x2 v = {lo, hi}; bf16x2_t b = __builtin_convertvector(v, bf16x2_t); return __builtin_bit_cast(unsigned, b); }
__device__ __forceinline__ unsigned short f2bf1(float x) { return (unsigned short)(cvtpk(x, 0.f) & 0xffffu); }
__device__ __forceinline__ int frag_off(int r, int kl) { return ((((kl >> 2) & 1) * 32 + r) << 3) + ((kl >> 3) << 2) + (kl & 3); }
__device__ __forceinline__ float silu_f(float y) { return y * __builtin_amdgcn_rcpf(1.f + __expf(-y)); }

constexpr int L_QS = 0, L_KS = 16384, L_MM = 32768, MM_LD = 68, L_SC = L_MM + CH * MM_LD * 4, SLOT_BYTES = 65536;
static_assert(L_SC + 4 * 64 * 4 <= SLOT_BYTES, "gdn LDS slot");
__device__ __forceinline__ int swz(int row, int c16) { return row * 256 + ((c16 ^ (row & 15)) << 4); }

struct G1Args { const bf16_t *GQ, *GK, *GV; const float *small, *cw, *a_log, *dt_bias; float* U; bf16_t* FR; float* GL; };

__device__ __forceinline__ void conv64(const bf16_t* src, bool first, float c0, float c1, float c2, float c3, float (&y)[64]) {
    float x0 = 0.f, x1 = 0.f, x2 = 0.f;
    if (!first) { x0 = bf2f(src[-3 * 512]); x1 = bf2f(src[-2 * 512]); x2 = bf2f(src[-1 * 512]); }
#pragma unroll
    for (int g = 0; g < 4; ++g) {
#pragma unroll
        for (int i = 16 * g; i < 16 * g + 16; ++i) { const float xi = bf2f(src[i * 512]); y[i] = silu_f(c0 * x0 + c1 * x1 + c2 * x2 + c3 * xi); x0 = x1; x1 = x2; x2 = xi; }
    }
}
__device__ __forceinline__ void conv64_lds(const bf16_t* src, bool first, float c0, float c1, float c2, float c3, GLAS unsigned char* img, int c) {
    float x0 = 0.f, x1 = 0.f, x2 = 0.f;
    if (!first) { x0 = bf2f(src[-3 * 512]); x1 = bf2f(src[-2 * 512]); x2 = bf2f(src[-1 * 512]); }
#pragma unroll
    for (int g = 0; g < 4; ++g) {
#pragma unroll
        for (int i = 16 * g; i < 16 * g + 16; ++i) { const float xi = bf2f(src[i * 512]); *(GLAS bf16_t*)(img + swz(i, c >> 3) + (c & 7) * 2) = f2bf1(silu_f(c0 * x0 + c1 * x1 + c2 * x2 + c3 * xi)); x0 = x1; x1 = x2; x2 = xi; }
    }
}

__device__ __forceinline__ void g1_pair(const G1Args& A, int pair, GLAS unsigned char* lds0, const int wave) {
    const int lane = lane_id(), tid = wave * 64 + lane,
               isl = wave >> 2, lw = wave & 3, lt = tid & 255;
    const int item = pair * 2 + isl, bh = item >> 5, n = item & 31, b = bh >> 2, h = bh & 3;
    const size_t m0 = (size_t)b * 2048 + (size_t)n * 64;
    GLAS unsigned char* lds = lds0 + isl * SLOT_BYTES;
    GLAS float* SC = (GLAS float*)(lds + L_SC);
    GLAS float* MM = (GLAS float*)(lds + L_MM);
    bf16_t* fr = A.FR + (size_t)item * ITEM_ELEMS;
    const bool first = (n == 0);
    float y[64];
    {
        const int which = (lw < 2) ? 2 : 1, c = (lw & 1) * 64 + lane, cc = which * 512 + h * 128 + c;
        const bf16_t* src = ((lw < 2) ? A.GV : A.GK) + m0 * 512 + h * 128 + c;
        conv64(src, first, A.cw[cc], A.cw[1536 + cc], A.cw[2 * 1536 + cc], A.cw[3 * 1536 + cc], y);
        if (lw >= 2) {
#pragma unroll
            for (int i = 0; i < 64; ++i) *(GLAS bf16_t*)(lds + L_KS + swz(i, c >> 3) + (c & 7) * 2) = f2bf1(y[i]);
        }
    }
    if (lw < 2) {
        const int c = lw * 64 + lane, cc = h * 128 + c;
        conv64_lds(A.GQ + m0 * 512 + h * 128 + c, first, A.cw[cc], A.cw[1536 + cc], A.cw[2 * 1536 + cc], A.cw[3 * 1536 + cc], lds + L_QS, c);
    } else if (lw == 2) {
        const float gb = A.small[(m0 + lane) * 16 + 8 + h], ga = A.small[(m0 + lane) * 16 + 12 + h] + A.dt_bias[h];
        const float sp = fmaxf(ga, 0.f) + log1pf(__expf(-fabsf(ga)));
        float g = -__expf(A.a_log[h]) * sp;
#pragma unroll
        for (int o = 1; o < 64; o <<= 1) { const float t = __shfl_up(g, o); if (lane >= o) g += t; }
        SC[128 + lane] = 1.f / (1.f + __expf(-gb));
        SC[192 + lane] = g;
        if (lane == 63) A.GL[item] = __builtin_amdgcn_exp2f(g * L2E);
    }
    __syncthreads();
    {
        const int r = lt >> 2, qd = lt & 3; float sq = 0.f, sk = 0.f;
#pragma unroll
        for (int jj = 0; jj < 4; ++jj) {
            const u32x4 vq = *(const GLAS u32x4*)(lds + L_QS + swz(r, qd * 4 + jj)), vk = *(const GLAS u32x4*)(lds + L_KS + swz(r, qd * 4 + jj));
#pragma unroll
            for (int e = 0; e < 4; ++e) { const float a0 = __uint_as_float(vq[e] << 16), a1 = __uint_as_float(vq[e] & 0xffff0000u), b0 = __uint_as_float(vk[e] << 16), b1 = __uint_as_float(vk[e] & 0xffff0000u);
                sq += a0 * a0 + a1 * a1; sk += b0 * b0 + b1 * b1; }
        }
        sq += __shfl_xor(sq, 1); sq += __shfl_xor(sq, 2); sk += __shfl_xor(sk, 1); sk += __shfl_xor(sk, 2);
        if (qd == 0) { SC[r] = rsqrtf(sq + 1e-6f) * 0.08838834764831845f; SC[64 + r] = rsqrtf(sk + 1e-6f); }
    }
    __syncthreads();
    {
        const int ti = lw >> 1, tj = lw & 1, r32 = lane & 31, hi = lane >> 5;
        f32x16 kk = {}, qk = {};
#pragma unroll
        for (int s = 0; s < 8; ++s) {
            const bf16x8 aK = *(const GLAS bf16x8*)(lds + L_KS + swz(32 * ti + r32, 2 * s + hi)), aQ = *(const GLAS bf16x8*)(lds + L_QS + swz(32 * ti + r32, 2 * s + hi));
            const bf16x8 bK = *(const GLAS bf16x8*)(lds + L_KS + swz(32 * tj + r32, 2 * s + hi));
            kk = __builtin_amdgcn_mfma_f32_32x32x16_bf16(aK, bK, kk, 0, 0, 0); qk = __builtin_amdgcn_mfma_f32_32x32x16_bf16(aQ, bK, qk, 0, 0, 0);
        }
        const int j = 32 * tj + r32; const float rkj = SC[64 + j], gcj = SC[192 + j];
        bf16_t* af = fr + (32 + ti * 4 + (j >> 4)) * 512;
#pragma unroll
        for (int r = 0; r < 16; ++r) {
            const int il = crow(r, hi), i = 32 * ti + il;
            const float e = __builtin_amdgcn_exp2f(fminf(SC[192 + i] - gcj, 0.f) * L2E);
            const float mv = (i > j) ? SC[128 + i] * SC[64 + i] * rkj * kk[r] * e : 0.f;
            const float av = (i >= j) ? SC[i] * rkj * qk[r] * e : 0.f;
            MM[i * MM_LD + j] = mv;
            af[frag_off(il, j & 15)] = f2bf1(av);
        }
    }
    __syncthreads();
    {
        const int c = (lw & 1) * 64 + lane;
        if (lw >= 2) {
            const float gl = SC[192 + 63];
            const int T = c >> 5, r = c & 31;
#pragma unroll
            for (int ks = 0; ks < 4; ++ks)
#pragma unroll
                for (int hh = 0; hh < 2; ++hh) {
                    float kd[8];
#pragma unroll
                    for (int a = 0; a < 2; ++a)
#pragma unroll
                        for (int bq = 0; bq < 4; ++bq) { const int i = 16 * ks + 8 * a + 4 * hh + bq; kd[4 * a + bq] = y[i] * SC[64 + i] * __builtin_amdgcn_exp2f((gl - SC[192 + i]) * L2E); }
                    u32x4 w; w.x = cvtpk(kd[0], kd[1]); w.y = cvtpk(kd[2], kd[3]); w.z = cvtpk(kd[4], kd[5]); w.w = cvtpk(kd[6], kd[7]);
                    *(u32x4*)(fr + (40 + T * 4 + ks) * 512 + ((hh * 32 + r) << 3)) = w;
                }
#pragma unroll
            for (int i = 0; i < 64; ++i) y[i] = y[i] * SC[64 + i] * SC[128 + i] * __builtin_amdgcn_exp2f(SC[192 + i] * L2E);
        } else {
#pragma unroll
            for (int i = 0; i < 64; ++i) y[i] *= SC[128 + i];
        }
#pragma unroll
        for (int i = 1; i < 64; ++i) {
            float acc = y[i];
#pragma unroll
            for (int j4 = 0; j4 < (i + 3) / 4; ++j4) {
                const f32x4 m = *(const GLAS f32x4*)(MM + i * MM_LD + 4 * j4);
                acc -= m[0] * y[4 * j4];
                if (4 * j4 + 1 < i) acc -= m[1] * y[4 * j4 + 1];
                if (4 * j4 + 2 < i) acc -= m[2] * y[4 * j4 + 2];
                if (4 * j4 + 3 < i) acc -= m[3] * y[4 * j4 + 3];
            }
            y[i] = acc;
        }
        if (lw >= 2) {
            const int ks = c >> 4, kl = c & 15;
#pragma unroll
            for (int i = 0; i < 64; ++i) fr[((i >> 5) * 8 + ks) * 512 + frag_off(i & 31, kl)] = f2bf1(-y[i]);
        } else {
            float* up = A.U + (size_t)item * 8192 + (size_t)(c >> 5) * 2048 + (c & 31) * 4;
#pragma unroll
            for (int I = 0; I < 2; ++I)
#pragma unroll
                for (int g = 0; g < 4; ++g)
#pragma unroll
                    for (int hh = 0; hh < 2; ++hh) { const int i0 = 32 * I + 8 * g + 4 * hh; *(f32x4*)(up + ((I * 4 + g) * 64 + hh * 32) * 4) = (f32x4){y[i0], y[i0 + 1], y[i0 + 2], y[i0 + 3]}; }
        }
        const int r = lt >> 2, qd = lt & 3; const float sc = SC[r] * __builtin_amdgcn_exp2f(SC[192 + r] * L2E);
#pragma unroll
        for (int jj = 0; jj < 4; ++jj) {
            const int c16 = qd * 4 + jj; const u32x4 vq = *(const GLAS u32x4*)(lds + L_QS + swz(r, c16));
            float f[8];
#pragma unroll
            for (int e = 0; e < 4; ++e) { f[2 * e] = __uint_as_float(vq[e] << 16) * sc; f[2 * e + 1] = __uint_as_float(vq[e] & 0xffff0000u) * sc; }
            bf16_t* qf = fr + (16 + (r >> 5) * 8 + (c16 >> 1)) * 512;
            u32x2 w0, w1; w0.x = cvtpk(f[0], f[1]); w0.y = cvtpk(f[2], f[3]); w1.x = cvtpk(f[4], f[5]); w1.y = cvtpk(f[6], f[7]);
            *(u32x2*)(qf + frag_off(r & 31, 8 * (c16 & 1))) = w0;
            *(u32x2*)(qf + frag_off(r & 31, 8 * (c16 & 1) + 4)) = w1;
        }
    }
    __syncthreads();
}

__device__ __forceinline__ void glds16(const void* gsrc, unsigned lds_dst) { unsigned keep;
    asm volatile("s_mov_b32 %0, m0\n\ts_mov_b32 m0, %2\n\ts_nop 0\n\tglobal_load_lds_dwordx4 %1, off\n\ts_mov_b32 m0, %0" : "=&s"(keep) : "v"(gsrc), "s"(lds_dst) : "memory"); }
__device__ __forceinline__ void scan_block(int bh, float* U, const bf16_t* FR, const float* GL, GLAS unsigned char* lds, const int wave) {
    const int lane = lane_id(), lw = wave & 3, r32 = lane & 31, hi = lane >> 5;
    const bool loader = wave >= 4;
    const int b = bh >> 2, h = bh & 3;
    const unsigned lds0 = (unsigned)(uintptr_t)lds;
    const bf16_t* frl = FR + (size_t)bh * NCH * ITEM_ELEMS + lane * 8;
#define SCAN_BAR() asm volatile("s_waitcnt vmcnt(0) lgkmcnt(0)\n\ts_barrier" ::: "memory")
    { const bf16_t* src = frl + wave * 7 * 512; unsigned dst = (unsigned)__builtin_amdgcn_readfirstlane(lds0 + wave * 7 * 1024);
#pragma unroll 1
      for (int p = 0; p < 7; ++p) { glds16(src, dst); src += 512; dst += 1024; } }
    f32x16 S[4], UN[2];
    float* ub = U + (size_t)bh * NCH * 8192 + (size_t)lw * 2048 + lane * 4;
    if (!loader) {
#pragma unroll
        for (int T = 0; T < 4; ++T) S[T] = f32x16{};
#pragma unroll
        for (int I = 0; I < 2; ++I)
#pragma unroll
            for (int g = 0; g < 4; ++g) { const f32x4 t = *(const f32x4*)(ub + (I * 4 + g) * 256); UN[I][4 * g] = t[0]; UN[I][4 * g + 1] = t[1]; UN[I][4 * g + 2] = t[2]; UN[I][4 * g + 3] = t[3]; }
    }
    SCAN_BAR();
    for (int n = 0; n < NCH; ++n) {
        if (loader) {
            if (n + 1 < NCH) {
                const bf16_t* src = frl + (size_t)(n + 1) * ITEM_ELEMS + lw * 14 * 512; unsigned dst = (unsigned)__builtin_amdgcn_readfirstlane(lds0 + ((n + 1) & 1) * (FRAGS * 1024) + lw * 14 * 1024);
#pragma unroll 1
                for (int p = 0; p < 14; ++p) { glds16(src, dst); src += 512; dst += 1024; }
            }
        } else {
            const GLAS bf16x8* fb = (const GLAS bf16x8*)(lds + (n & 1) * (FRAGS * 1024)) + lane;
            float* ut = ub + (size_t)n * 8192;
            const float gl = GL[bh * NCH + n];
            bf16x8 sf[4][2];
#pragma unroll
            for (int T = 0; T < 4; ++T)
#pragma unroll
                for (int s = 0; s < 2; ++s) { u32x4 p;
#pragma unroll
                    for (int e = 0; e < 4; ++e) p[e] = cvtpk(S[T][8 * s + 2 * e], S[T][8 * s + 2 * e + 1]);
                    sf[T][s] = __builtin_bit_cast(bf16x8, p); }
            f32x16 VN[2];
#pragma unroll
            for (int I = 0; I < 2; ++I) {
                VN[I] = UN[I];
#pragma unroll
                for (int ks = 0; ks < 8; ++ks) VN[I] = __builtin_amdgcn_mfma_f32_32x32x16_bf16(fb[(I * 8 + ks) * 64], sf[ks >> 1][ks & 1], VN[I], 0, 0, 0);
            }
            if (n + 1 < NCH) {
#pragma unroll
                for (int I = 0; I < 2; ++I)
#pragma unroll
                    for (int g = 0; g < 4; ++g) { const f32x4 t = *(const f32x4*)(ut + 8192 + (I * 4 + g) * 256); UN[I][4 * g] = t[0]; UN[I][4 * g + 1] = t[1]; UN[I][4 * g + 2] = t[2]; UN[I][4 * g + 3] = t[3]; }
            }
            bf16x8 vf[2][2];
#pragma unroll
            for (int J = 0; J < 2; ++J)
#pragma unroll
                for (int s = 0; s < 2; ++s) { u32x4 p;
#pragma unroll
                    for (int e = 0; e < 4; ++e) p[e] = cvtpk(VN[J][8 * s + 2 * e], VN[J][8 * s + 2 * e + 1]);
                    vf[J][s] = __builtin_bit_cast(bf16x8, p); }
#pragma unroll
            for (int I = 0; I < 2; ++I) {
                f32x16 O = {};
#pragma unroll
                for (int ks = 0; ks < 8; ++ks) O = __builtin_amdgcn_mfma_f32_32x32x16_bf16(fb[(16 + I * 8 + ks) * 64], sf[ks >> 1][ks & 1], O, 0, 0, 0);
#pragma unroll
                for (int ks = 0; ks < 2 * (I + 1); ++ks) O = __builtin_amdgcn_mfma_f32_32x32x16_bf16(fb[(32 + I * 4 + ks) * 64], vf[ks >> 1][ks & 1], O, 0, 0, 0);
#pragma unroll
                for (int g = 0; g < 4; ++g) *(f32x4*)(ut + (I * 4 + g) * 256) = (f32x4){O[4 * g], O[4 * g + 1], O[4 * g + 2], O[4 * g + 3]};
            }
#pragma unroll
            for (int T = 0; T < 4; ++T) {
                S[T] = S[T] * gl;
#pragma unroll
                for (int ks = 0; ks < 4; ++ks) S[T] = __builtin_amdgcn_mfma_f32_32x32x16_bf16(fb[(40 + T * 4 + ks) * 64], vf[ks >> 1][ks & 1], S[T], 0, 0, 0);
            }
        }
        SCAN_BAR();
    }
#undef SCAN_BAR
}
#undef GLAS
}
#ifndef PG8_SP2
#define PG8_SP2 true
#endif
#ifndef PG8_ALIGN
#define PG8_ALIGN true
#endif
constexpr int NWAVES = 8;
constexpr int NB = 8, SEQ = 2048, D = 1024, M = NB * SEQ, FF = 4096;
constexpr int HF = 8, HG = 4;
constexpr int DPROJ = 3600, NPROJ = 3840;
constexpr float EPS = 1e-6f;
constexpr float LOG2E = 1.4426950408889634f;
constexpr float QSCALE = 0.125f * LOG2E;
constexpr int C_FF = 1536, C_GQ = 1544, C_GB = 3080, C_GA = 3084, C_GZ = 3088;
constexpr size_t MiB = 1u << 20;
constexpr size_t WS_CTL = 0, CTL_ZERO_BYTES = 1 * MiB;
constexpr size_t WS_WIN = 2 * MiB, WS_WOUT = 10 * MiB, WS_WUP = 12 * MiB, WS_WDN = 20 * MiB;
constexpr size_t WS_X = 28 * MiB;
constexpr size_t WS_XN = 32 * MiB;
constexpr size_t WS_FQ = 64 * MiB, WS_G512 = 16 * MiB;
constexpr size_t WS_SMALL = 176 * MiB;
constexpr size_t WS_CUM = 177 * MiB;
constexpr size_t WS_GU = 32 * MiB;
constexpr size_t WS_GL = 179 * MiB;
constexpr size_t WS_BETA = 178 * MiB, WS_GDEC = 178 * MiB + 512 * 1024;
constexpr size_t WS_MIXED = 192 * MiB;
constexpr size_t WS_H = 64 * MiB;
constexpr size_t WS_MIXOUT = 64 * MiB;
constexpr size_t WS_Y = 192 * MiB;
constexpr size_t WS_END = 256 * MiB;
constexpr int CW_TMO = 0, CW_CODE = 1;
constexpr int CW_BAR = 4096;
constexpr int CW_QUEUE = 12288;
constexpr int CW_SEAM = 16384, SEAM_BANK = 128 * 64;
constexpr int RING_OFF = 0, RING_BYTES = 131072;
constexpr int LDSCTL_OFF = RING_BYTES, MISC_OFF = LDSCTL_OFF + 320;
constexpr int LDS_BYTES = 147456;
#define GAS __attribute__((address_space(1)))
#define LAS __attribute__((address_space(3)))
typedef unsigned short bf16;
typedef unsigned v4u __attribute__((ext_vector_type(4)));
typedef float f32x4 __attribute__((ext_vector_type(4)));
typedef short bf16x8 __attribute__((ext_vector_type(8)));
typedef GAS unsigned gu32;
typedef GAS unsigned long long gu64;
#define RLX_AGENT __ATOMIC_RELAXED, __HIP_MEMORY_SCOPE_AGENT
#define LDS_WAIT() asm volatile("s_waitcnt lgkmcnt(0)" ::: "memory")
#define VM_WAIT() asm volatile("s_waitcnt vmcnt(0)" ::: "memory")
__device__ __forceinline__ unsigned long long rt() { return __builtin_amdgcn_s_memrealtime(); }
__device__ __forceinline__ unsigned f2bf(float f) { unsigned u = __builtin_bit_cast(unsigned, f); return (u + 0x7fffu + ((u >> 16) & 1u)) >> 16; }
__device__ __forceinline__ unsigned pk2(float lo, float hi) { return f2bf(lo) | (f2bf(hi) << 16); }

#define XB_TMO      128
#define XB_XCNT(j)  (256  + 64 * (j))
#define XB_XSUB(j)  (1280 + 64 * (j))
#define XB_XGEN(j)  (2304 + 64 * (j))
#define XB_TOP      3328
#define XB_TOPGEN   3392
#define XCD_BAR_WORDS 3456
#define XB_SPIN_CAP (1u << 18)

__device__ __forceinline__ unsigned xb_ld(unsigned* p)              { return __hip_atomic_load(p, __ATOMIC_RELAXED, __HIP_MEMORY_SCOPE_AGENT); }
__device__ __forceinline__ unsigned xb_add(unsigned* p, unsigned v) { return __hip_atomic_fetch_add(p, v, __ATOMIC_RELAXED, __HIP_MEMORY_SCOPE_AGENT); }
__device__ __forceinline__ unsigned xb_xcc_id() { return (unsigned)__builtin_amdgcn_s_getreg((3 << 11) | 20) & 0xFu; }
#define XB_SPIN(cond, bar) do { unsigned _sp = 0; while (cond) { __builtin_amdgcn_s_sleep(1); \
    if ((++_sp & 255u) == 0u) { if (xb_ld(&(bar)[XB_TMO])) break; if (_sp > XB_SPIN_CAP) { atomicAdd(&(bar)[XB_TMO], 1u); break; } } } } while (0)

struct XcdBarrier {
    unsigned* bar; unsigned x;
    volatile LAS unsigned* st;
};

__device__ __forceinline__ XcdBarrier xcd_barrier_post(unsigned* bar, volatile LAS unsigned* st, const bool t0) {
    XcdBarrier b; b.bar = bar; b.x = xb_xcc_id(); b.st = st;
    if (t0) (void)xb_add(&bar[XB_XCNT(b.x)], 1u);
    return b;
}
__device__ __forceinline__ void xcd_barrier_complete(unsigned* bar, unsigned x, unsigned& nloc, unsigned& nx) {
    const unsigned G = gridDim.x * gridDim.y * gridDim.z;
    unsigned sum, cnt, mine, sp = 0u;
    for (;;) {
        sum = 0u; cnt = 0u; mine = 0u;
#pragma unroll
        for (unsigned j = 0; j < 16; ++j) { const unsigned c = xb_ld(&bar[XB_XCNT(j)]); sum += c; cnt += (c > 0u) ? 1u : 0u; mine = (j == x) ? c : mine; }
        if (sum == G) break;
        __builtin_amdgcn_s_sleep(1);
        if ((++sp & 255u) == 0u) { if (xb_ld(&bar[XB_TMO])) break; if (sp > XB_SPIN_CAP) { atomicAdd(&bar[XB_TMO], 1u); break; } }
    }
    nloc = mine > 0u ? mine : 1u; nx = cnt > 0u ? cnt : 1u;
}

__device__ __forceinline__ void xcd_barrier(const XcdBarrier& b, const bool t0) {
    asm volatile("s_waitcnt vmcnt(0)" ::: "memory");
    __syncthreads();
    if (t0) {
        unsigned* bar = b.bar;
        __builtin_amdgcn_s_waitcnt(0);
        unsigned nloc = b.st[0], nx = b.st[1];
        if (nloc == 0u) { xcd_barrier_complete(bar, b.x, nloc, nx); b.st[0] = nloc; b.st[1] = nx; }
        const unsigned old = xb_add(&bar[XB_XSUB(b.x)], 1u);
        const unsigned gen = old / nloc;
        if (old + 1u == (gen + 1u) * nloc) {
            __builtin_amdgcn_fence(__ATOMIC_RELEASE, "agent");
            asm volatile("s_waitcnt vmcnt(0)" ::: "memory");
            const unsigned og = xb_add(&bar[XB_TOP], 1u);
            const unsigned tg = og / nx;
            if (og + 1u == (tg + 1u) * nx) xb_add(&bar[XB_TOPGEN], 1u);
            else XB_SPIN(xb_ld(&bar[XB_TOPGEN]) == tg, bar);
            __builtin_amdgcn_fence(__ATOMIC_ACQUIRE, "agent");
            xb_add(&bar[XB_XGEN(b.x)], 1u);
            asm volatile("s_waitcnt vmcnt(0)" ::: "memory");
        } else {
            XB_SPIN(xb_ld(&bar[XB_XGEN(b.x)]) == gen, bar);
            __builtin_amdgcn_fence(__ATOMIC_ACQUIRE, "agent");
            asm volatile("s_waitcnt vmcnt(0)" ::: "memory");
        }
    }
    __syncthreads();
}
struct Frame {
    LAS unsigned char* lds;
    volatile LAS unsigned* MISC;
    gu32* ctl;
    int wave;
    int vcu, G;
};
__device__ __forceinline__ float wave_sum(float v) {
#pragma unroll
    for (int o = 1; o < 64; o <<= 1) v += __shfl_xor(v, o);
    return v;
}
__device__ __forceinline__ float bf2f(unsigned short u) { return __uint_as_float((unsigned)u << 16); }
__device__ __forceinline__ int proj_src_col(int n) {
    if (n < 1536) return n;
    if (n < 3072) return n + 8;
    if (n < 3584) return n + 16;
    if (n < 3592) return C_FF + (n - 3584);
    if (n < 3596) return C_GB + (n - 3592);
    if (n < 3600) return C_GA + (n - 3596);
    return -1;
}
template <bool REMAP>
__device__ __forceinline__ void p0_transpose_item(const float* W, int K, int N, int Ndst, bf16* WT, LAS float* scr, int item, int lane) {
    const int nblk = Ndst / 32, kb = item / nblk, nb = item % nblk, k0 = 64 * kb, n0 = 32 * nb;
    const int sc = REMAP ? proj_src_col(n0 + (lane & 31)) : n0 + (lane & 31);
#pragma unroll 8
    for (int i = 0; i < 32; ++i) { const int kk = 2 * i + (lane >> 5); scr[kk * 33 + (lane & 31)] = (sc >= 0) ? W[(size_t)(k0 + kk) * N + sc] : 0.f; }
    LDS_WAIT(); asm volatile("" ::: "memory");
    const int c = lane & 7;
#pragma unroll
    for (int j = 0; j < 4; ++j) { const int n = (lane >> 3) + 8 * j; const LAS float* s = scr + (8 * c) * 33 + n;
        v4u o; o.x = pk2(s[0 * 33], s[1 * 33]); o.y = pk2(s[2 * 33], s[3 * 33]); o.z = pk2(s[4 * 33], s[5 * 33]); o.w = pk2(s[6 * 33], s[7 * 33]);
        *(GAS v4u*)(WT + (size_t)(n0 + n) * K + k0 + 8 * c) = o; }
    LDS_WAIT(); asm volatile("" ::: "memory");
}
__device__ __forceinline__ void rms_row_to_bf16(int lane, const float* xrow, const float* g, bf16* orow) {
    const GAS f32x4* xr = (const GAS f32x4*)xrow + lane; const GAS f32x4* gr = (const GAS f32x4*)g + lane;
    f32x4 v[4]; float s = 0.f;
#pragma unroll
    for (int j = 0; j < 4; ++j) { v[j] = xr[64 * j]; s += (v[j].x * v[j].x + v[j].y * v[j].y) + (v[j].z * v[j].z + v[j].w * v[j].w); }
    const float r = rsqrtf(wave_sum(s) * (1.f / D) + EPS);
    GAS unsigned long long* o8 = (GAS unsigned long long*)orow + lane;
#pragma unroll
    for (int j = 0; j < 4; ++j) { const f32x4 gg = gr[64 * j];
        o8[64 * j] = (unsigned long long)pk2(v[j].x * r * gg.x, v[j].y * r * gg.y) | ((unsigned long long)pk2(v[j].z * r * gg.z, v[j].w * r * gg.w) << 32); }
}
__device__ __forceinline__ void resnorm_row(int lane, const float* yrow, const float* g1, const float* baserow, float* outrow, const float* g2, bf16* xnrow) {
    const GAS f32x4* yr = (const GAS f32x4*)yrow + lane; const GAS f32x4* gr = (const GAS f32x4*)g1 + lane; const GAS f32x4* br = (const GAS f32x4*)baserow + lane;
    f32x4 v[4]; float s = 0.f;
#pragma unroll
    for (int j = 0; j < 4; ++j) { v[j] = yr[64 * j]; s += (v[j].x * v[j].x + v[j].y * v[j].y) + (v[j].z * v[j].z + v[j].w * v[j].w); }
    const float r = rsqrtf(wave_sum(s) * (1.f / D) + EPS);
    float s2 = 0.f;
#pragma unroll
    for (int j = 0; j < 4; ++j) { const f32x4 gg = gr[64 * j], bb = br[64 * j]; v[j] = bb + v[j] * r * gg; s2 += (v[j].x * v[j].x + v[j].y * v[j].y) + (v[j].z * v[j].z + v[j].w * v[j].w);
        ((GAS f32x4*)outrow + lane)[64 * j] = v[j]; }
    if (xnrow) {
        const float r2 = rsqrtf(wave_sum(s2) * (1.f / D) + EPS); const GAS f32x4* g2r = (const GAS f32x4*)g2 + lane;
        GAS unsigned long long* o8 = (GAS unsigned long long*)xnrow + lane;
#pragma unroll
        for (int j = 0; j < 4; ++j) { const f32x4 gg = g2r[64 * j];
            o8[64 * j] = (unsigned long long)pk2(v[j].x * r2 * gg.x, v[j].y * r2 * gg.y) | ((unsigned long long)pk2(v[j].z * r2 * gg.z, v[j].w * r2 * gg.w) << 32); }
    }
}

typedef float f32x2v __attribute__((ext_vector_type(2)));
__device__ __forceinline__ void cum_item(int bh, const float* small, const float* fbias, float* cum, LAS float* part, int tid, int lane, int wave) {
    const int b = bh >> 3, h = bh & 7; const float bz = fbias[h];
    float loc[4]; float s = 0.f;
#pragma unroll
    for (int e = 0; e < 4; ++e) { const float z = small[((size_t)b * SEQ + tid * 4 + e) * 16 + h] + bz; s += fminf(z, 0.f) - log1pf(__expf(-fabsf(z))); loc[e] = s; }
    float inc = s;
#pragma unroll
    for (int o = 1; o < 64; o <<= 1) { const float t = __shfl_up(inc, o); if (lane >= o) inc += t; }
    if (lane == 63) part[wave] = inc;
    __syncthreads();
    float base = inc - s;
    for (int w = 0; w < wave; ++w) base += part[w];
#pragma unroll
    for (int e = 0; e < 4; ++e) cum[(size_t)bh * SEQ + tid * 4 + e] = loc[e] + base;
    __syncthreads();
}

__device__ __forceinline__ int opaque_lane() { return lane_id(); }
struct Args { const float* in[15]; float* out; unsigned char* ws; int ph_lo, ph_hi, li, pad; };
enum { PH_PRO = 0, PH_PROJ = 1, PH_MIX = 2, PH_WO = 3, PH_N1 = 4, PH_UP = 5, PH_DOWN = 6, PH_N2 = 7, PH_END = 8 };

__global__ void __launch_bounds__(NWAVES * 64, 2) skel_fwd(Args args) {
    extern __shared__ __attribute__((aligned(16))) unsigned char lds[];
    Frame F;
    F.lds = (LAS unsigned char*)lds;
    F.MISC = (volatile LAS unsigned*)(F.lds + MISC_OFF);
    F.wave = __builtin_amdgcn_readfirstlane((int)threadIdx.x >> 6);
    F.G = gridDim.x; { const int bx = blockIdx.x; F.vcu = (F.G % 8 == 0) ? (bx % 8) * (F.G / 8) + bx / 8 : bx; }
    unsigned char* ws = args.ws;
    F.ctl = (gu32*)(ws + WS_CTL);
    const float* x = args.in[0]; const float* g_premix = args.in[1]; const float* w_in = args.in[2];
    const float* w_out = args.in[9]; const float* g_postmix = args.in[10]; const float* g_premlp = args.in[11];
    const float* w_up = args.in[12]; const float* w_down = args.in[13]; const float* g_postmlp = args.in[14];
    bf16* Win_t = (bf16*)(ws + WS_WIN); bf16* Wout_t = (bf16*)(ws + WS_WOUT); bf16* Wup_t = (bf16*)(ws + WS_WUP); bf16* Wdn_t = (bf16*)(ws + WS_WDN);
    bf16* XN = (bf16*)(ws + WS_XN); bf16* FQ = (bf16*)(ws + WS_FQ); bf16* MIXED = (bf16*)(ws + WS_MIXED); bf16* HB = (bf16*)(ws + WS_H);
    float* SMALL = (float*)(ws + WS_SMALL); float* MIXOUT = (float*)(ws + WS_MIXOUT); float* Y = (float*)(ws + WS_Y);
    for (int u = F.wave * 64 + lane_id(); u < (LDS_BYTES - LDSCTL_OFF) / 4; u += NWAVES * 64) ((LAS unsigned*)(F.lds + LDSCTL_OFF))[u] = 0u;
    __syncthreads();
#define T0 (F.wave == 0 && lane_id() == 0)
    XcdBarrier bar = xcd_barrier_post((unsigned*)(F.ctl + CW_BAR) + args.li * XCD_BAR_WORDS, F.MISC + 8, T0);
    const int lo = args.ph_lo, hi = args.ph_hi;
#define IN(k) (lo <= (k) && (k) < hi)
#define BOTH(k) (IN(k) && IN((k) + 1))
#define GRID_BAR() xcd_barrier(bar, T0)
    const int gw = F.vcu * NWAVES + F.wave, NGW = F.G * NWAVES;

    if (IN(PH_PRO)) {
        LAS float* scr = (LAS float*)(F.lds + RING_OFF + F.wave * 16384);
        constexpr int I_IN = (D / 64) * (NPROJ / 32), I_O = (D / 64) * (D / 32), I_1 = (D / 64) * (FF / 32), I_2 = (FF / 64) * (D / 32);
        constexpr int NITEMS = I_IN + I_O + I_1 + I_2;
        for (int it = gw; it < NITEMS; it += NGW) {
            int r = it;
            if (r < I_IN) { p0_transpose_item<true>(w_in, D, DPROJ, NPROJ, Win_t, scr, r, lane_id()); continue; } r -= I_IN;
            if (r < I_O) { p0_transpose_item<false>(w_out, D, D, D, Wout_t, scr, r, lane_id()); continue; } r -= I_O;
            if (r < I_1) { p0_transpose_item<false>(w_up, D, FF, FF, Wup_t, scr, r, lane_id()); continue; } r -= I_1;
            p0_transpose_item<false>(w_down, FF, D, D, Wdn_t, scr, r, lane_id());
        }
        { const int ln = opaque_lane(); for (int m = gw; m < M; m += NGW) rms_row_to_bf16(ln, x + (size_t)m * D, g_premix, XN + (size_t)m * D); }
        if (BOTH(PH_PRO)) GRID_BAR();
    }
    if (IN(PH_PROJ)) {
        pg8::Gemm g{XN, Win_t, M, NPROJ, D}; pg8::StaticOrder S; S.init(M, NPROJ, F.G, (int)blockIdx.x);
        pg8::EpiProj E{FQ, (size_t)(WS_G512 / 2), SMALL, QSCALE};
        pg8::gemm_phase<pg8::EpiProj, pg8::StaticOrder, PG8_ALIGN, PG8_SP2>(F.lds + RING_OFF, g, S, E, F.wave);
        if (BOTH(PH_PROJ)) GRID_BAR();
    }
    if (IN(PH_MIX)) {
        float* CUM = (float*)(ws + WS_CUM); float* GU = (float*)(ws + WS_GU); float* GLp = (float*)(ws + WS_GL); bf16* FR = (bf16*)args.out;
        if (F.vcu < NB * HF) cum_item(F.vcu, SMALL, args.in[3], CUM, (LAS float*)(F.lds + RING_OFF), F.wave * 64 + lane_id(), lane_id(), F.wave);
        {
            const gdn::G1Args GA{FQ + 3 * (WS_G512 / 2), FQ + 4 * (WS_G512 / 2), FQ + 5 * (WS_G512 / 2), SMALL, args.in[5], args.in[6], args.in[7], GU, FR, GLp};
_Pragma("nounroll")
            for (int k = 0; k < 2 * ((gdn::NITEM / 2 + 2 * F.G - 1) / (2 * F.G)); ++k) { const int pr = (k >> 1) * 2 * F.G + F.vcu * 2 + (k & 1); if (pr < gdn::NITEM / 2) gdn::g1_pair(GA, pr, F.lds + RING_OFF, F.wave); }
        }
        GRID_BAR();
        if ((int)blockIdx.x < NB * HG) gdn::scan_block((int)blockIdx.x, GU, FR, GLp, F.lds + RING_OFF, F.wave);
        {
            static_assert(attn_body::ATTN_LDS_BYTES <= RING_BYTES, "attention LDS");
            const attn_body::AttnTensors AT{(const attn_body::bf16*)FQ, (const attn_body::bf16*)(FQ + WS_G512 / 2), (const attn_body::bf16*)(FQ + 2 * (WS_G512 / 2)), (attn_body::bf16*)MIXED, CUM, args.in[4]};
            const attn_body::QueueOrder S{(unsigned*)(F.ctl + CW_QUEUE), F.MISC + 12, (int)(blockIdx.x & 7), F.wave};
            attn_body::attn_phase<attn_body::QueueOrder>((char*)lds + RING_OFF, AT, S, F.wave);
        }
        GRID_BAR();
        {
            const bf16* GZ = FQ + 6 * (WS_G512 / 2); const float* gno = args.in[8]; const int ln = opaque_lane(), lc = ln & 31, hh = ln >> 5;
            for (int it = gw; it < gdn::NITEM * 8; it += NGW) {
                const int item = it >> 3, I = (it >> 2) & 1, g = it & 3, bh = item >> 5, n = item & 31, b = bh >> 2, h = bh & 3;
                const float* src = GU + (size_t)item * 8192 + ((I * 4 + g) * 64 + ln) * 4;
                f32x4 v[4]; float ss[4] = {0.f, 0.f, 0.f, 0.f};
#pragma unroll
                for (int w = 0; w < 4; ++w) { v[w] = *(const GAS f32x4*)(src + w * 2048);
#pragma unroll
                    for (int e = 0; e < 4; ++e) ss[e] += v[w][e] * v[w][e]; }
#pragma unroll
                for (int e = 0; e < 4; ++e) {
#pragma unroll
                    for (int o = 1; o < 32; o <<= 1) ss[e] += __shfl_xor(ss[e], o);
                    ss[e] = rsqrtf(ss[e] * (1.f / 128.f) + EPS); }
                const size_t m0 = (size_t)b * SEQ + n * 64 + 32 * I + 8 * g + 4 * hh;
#pragma unroll
                for (int w = 0; w < 4; ++w) { const int col = h * 128 + 32 * w + lc; const float gg = gno[32 * w + lc];
#pragma unroll
                    for (int e = 0; e < 4; ++e) { const float z = bf2f(GZ[(m0 + e) * 512 + col]);
                        MIXED[(m0 + e) * D + 512 + col] = (bf16)f2bf(v[w][e] * ss[e] * gg * z / (1.f + __expf(-z))); } }
            }
        }
        if (BOTH(PH_MIX)) GRID_BAR();
    }
    if (IN(PH_WO)) {
        pg8::Gemm g{MIXED, Wout_t, M, D, D}; pg8::StaticOrder S; S.init(M, D, F.G, (int)blockIdx.x);
        pg8::EpiF32 E{MIXOUT, D};
        pg8::gemm_phase<pg8::EpiF32, pg8::StaticOrder, false, PG8_SP2>(F.lds + RING_OFF, g, S, E, F.wave);
        if (BOTH(PH_WO)) GRID_BAR();
    }
    if (IN(PH_N1)) {
        { const int ln = opaque_lane(); for (int m = gw; m < M; m += NGW) resnorm_row(ln, MIXOUT + (size_t)m * D, g_postmix, x + (size_t)m * D, args.out + (size_t)m * D, g_premlp, XN + (size_t)m * D); }
        if (BOTH(PH_N1)) GRID_BAR();
    }
    if (IN(PH_UP)) {
        pg8::Gemm g{XN, Wup_t, M, FF, D}; pg8::StaticOrder S; S.init(M, FF, F.G, (int)blockIdx.x);
        pg8::EpiRelu2 E{HB, FF};
        pg8::gemm_phase<pg8::EpiRelu2, pg8::StaticOrder, PG8_ALIGN, PG8_SP2>(F.lds + RING_OFF, g, S, E, F.wave);
        if (BOTH(PH_UP)) GRID_BAR();
    }
    if (IN(PH_DOWN)) {
        pg8::Gemm g{HB, Wdn_t, M, D, FF}; pg8::StaticOrder S; S.init(M, D, F.G, (int)blockIdx.x);
        pg8::EpiF32 E{Y, D};
        pg8::gemm_phase<pg8::EpiF32, pg8::StaticOrder, false, PG8_SP2>(F.lds + RING_OFF, g, S, E, F.wave);
        if (BOTH(PH_DOWN)) GRID_BAR();
    }
    if (IN(PH_N2)) {
        { const int ln = opaque_lane(); for (int m = gw; m < M; m += NGW) resnorm_row(ln, Y + (size_t)m * D, g_postmlp, args.out + (size_t)m * D, args.out + (size_t)m * D, nullptr, nullptr); }
    }
#undef IN
#undef BOTH
#undef GRID_BAR
#undef T0
}
static void launch_skel(int grid, hipStream_t stream, Args a, int lo, int hi, int li) {
    a.ph_lo = lo; a.ph_hi = hi; a.li = li;
    hipLaunchKernelGGL(skel_fwd, dim3(grid), dim3(NWAVES * 64), LDS_BYTES, stream, a);
    const hipError_t le = hipPeekAtLastError();
    if (le != hipSuccess) fprintf(stderr, "kernel_launch: launch %d failed: %s\n", li, hipGetErrorName(le));
}
extern "C" void kernel_launch(void* const* d_in, const int* in_sizes, int n_in, void* d_out, int out_size, void* d_ws, size_t ws_size, hipStream_t stream) {
    static int grid = 0;
    if (grid == 0) {
        if (n_in != 15 || in_sizes[0] != M * D || out_size != M * D || ws_size < WS_END) { fprintf(stderr, "kernel_launch: unexpected shapes (n_in %d, in0 %d, out %d, ws %zu); nothing launched\n", n_in, n_in > 0 ? in_sizes[0] : -1, out_size, ws_size); grid = -1; return; }
        int dev = 0, cus = 0, per_cu = 0;
        if (hipGetDevice(&dev) != hipSuccess || hipDeviceGetAttribute(&cus, hipDeviceAttributeMultiprocessorCount, dev) != hipSuccess) { grid = -1; return; }
        if (hipFuncSetAttribute((const void*)skel_fwd, hipFuncAttributeMaxDynamicSharedMemorySize, LDS_BYTES) != hipSuccess) { fprintf(stderr, "kernel_launch: hipFuncSetAttribute failed\n"); grid = -1; return; }
        if (hipOccupancyMaxActiveBlocksPerMultiprocessor(&per_cu, (const void*)skel_fwd, NWAVES * 64, LDS_BYTES) != hipSuccess || per_cu < 1)
            fprintf(stderr, "kernel_launch: note: occupancy query reports %d workgroups per CU\n", per_cu);
        (void)hipGetLastError();
        grid = cus;
    }
    if (grid < 0) return;
    if (hipMemsetAsync((char*)d_ws + WS_CTL, 0, CTL_ZERO_BYTES, stream) != hipSuccess) { fprintf(stderr, "kernel_launch: hipMemsetAsync failed\n"); return; }
    Args a{};
    for (int i = 0; i < 15; ++i) a.in[i] = (const float*)d_in[i];
    a.out = (float*)d_out; a.ws = (unsigned char*)d_ws;
    HOST_LAUNCH_PROGRAM
}
```

```cpp
#include <hip/hip_runtime.h>
#include <cstdio>
#include <cstdint>
__device__ __forceinline__ int lane_id() { int l = (int)__builtin_amdgcn_mbcnt_hi(~0u, __builtin_amdgcn_mbcnt_lo(~0u, 0u)); asm volatile("" : "+v"(l)); return l; }
#define HOST_LAUNCH_PROGRAM launch_skel(grid, stream, a, PH_PRO, PH_END, 0);
namespace pg8 {
#define PG8_LAS __attribute__((address_space(3)))
typedef unsigned short bf16_t;
typedef short bf16x8 __attribute__((ext_vector_type(8)));
typedef float f32x4 __attribute__((ext_vector_type(4)));
typedef unsigned u32x4 __attribute__((ext_vector_type(4)));
constexpr int BM = 256, BK = 64, HALF = 128, HTB = HALF * BK * 2  , STAGE_BYTES = 8 * HTB, NXCD = 8, WGM = 8;

__host__ __device__ __forceinline__ int lds_byte(int r, int c) { const int st = (r >> 4) * 2 + (c >> 5), rr = r & 15, cc = c & 31, ob = rr * 64 + cc * 2; return st * 1024 + (ob ^ (((ob >> 9) & 1) << 5)); }
__host__ __device__ __forceinline__ void stage_rc(int b, int& R, int& C) { const int st = b / 1024, sb = b % 1024, swz = sb ^ (((sb >> 9) & 1) << 5); R = (st >> 1) * 16 + swz / 64; C = (st & 1) * 32 + (swz % 64) / 2; }
__host__ __device__ __forceinline__ int perm32(int rho) { const int n = rho >> 4, i = rho & 15; return 8 * (i >> 2) + 4 * n + (i & 3); }

struct Unit { int pm, pn; };
struct Gemm { const bf16_t* A; const bf16_t* Bt; int M, N, K; };

struct StaticOrder {
    int nM, nN, nwg, G, c;
    __host__ __device__ void init(int M, int N, int G_, int c_) { nM = M / BM; nN = N / BM; nwg = nM * nN; G = G_; c = c_; }
    __host__ __device__ bool next(int i, Unit& u) const {
        const long L = (long)i * G + c; if (L >= nwg) return false;
        int wgid = (int)L; { const int q = nwg / NXCD, r = nwg % NXCD, xcd = wgid % NXCD, off = wgid / NXCD; wgid = (xcd < r ? xcd * (q + 1) : r * (q + 1) + (xcd - r) * q) + off; }
        const int nig = WGM * nN, gid = wgid / nig, fm = gid * WGM, gsz = (nM - fm) < WGM ? (nM - fm) : WGM;
        u.pm = fm + ((wgid % nig) % gsz); u.pn = (wgid % nig) / gsz; return true;
    }
    __device__ __forceinline__ void a_ready(const Unit&) const {}
    __device__ __forceinline__ void done(const Unit&) const {}
};

__device__ __forceinline__ unsigned cvt_pk_bf16(float lo, float hi) { unsigned r; asm volatile("v_cvt_pk_bf16_f32 %0, %1, %2" : "=v"(r) : "v"(lo), "v"(hi)); return r; }
typedef float f32x2 __attribute__((ext_vector_type(2)));
struct EpiProj {
    static constexpr bool PERM = true, AFTER_DRAIN = false;
    bf16_t* O; size_t gstride; float* small; float qscale;
    __device__ __forceinline__ void operator()(const f32x4 (&acc)[2][2][4][2], const Unit& u, int wr, int wc, int fr, int fq) const {
        const int row0 = u.pm * BM + wr * 64 + fr;
        if (u.pn < 14) {
            const int t = u.pn >> 1; bf16_t* base = O + (size_t)t * gstride; const float sc = (t == 0) ? qscale : 1.f;
            const int col0 = (u.pn & 1) * 256 + wc * 32 + 8 * fq;
#pragma unroll
            for (int ai = 0; ai < 2; ++ai)
#pragma unroll
                for (int m = 0; m < 4; ++m) { bf16_t* rowp = base + (size_t)(row0 + ai * HALF + m * 16) * 512 + col0;
#pragma unroll
                    for (int bj = 0; bj < 2; ++bj) { const f32x4 v0 = acc[ai][bj][m][0] * sc, v1 = acc[ai][bj][m][1] * sc;
                        u32x4 w; w.x = cvt_pk_bf16(v0[0], v0[1]); w.y = cvt_pk_bf16(v0[2], v0[3]); w.z = cvt_pk_bf16(v1[0], v1[1]); w.w = cvt_pk_bf16(v1[2], v1[3]);
                        *(u32x4*)(rowp + bj * HALF) = w; } }
        } else {
            if (wc == 0 && fq < 2) {
#pragma unroll
                for (int ai = 0; ai < 2; ++ai)
#pragma unroll
                    for (int m = 0; m < 4; ++m) { float* rowp = small + (size_t)(row0 + ai * HALF + m * 16) * 16 + 8 * fq;
                        *(f32x4*)(rowp) = acc[ai][0][m][0]; *(f32x4*)(rowp + 4) = acc[ai][0][m][1]; }
            }
        }
    }
};
struct EpiRelu2 {
    static constexpr bool PERM = true, AFTER_DRAIN = false;
    bf16_t* O; int ldc;
    __device__ __forceinline__ void operator()(const f32x4 (&acc)[2][2][4][2], const Unit& u, int wr, int wc, int fr, int fq) const {
        const int row0 = u.pm * BM + wr * 64 + fr, col0 = u.pn * BM + wc * 32 + 8 * fq;
#pragma unroll
        for (int ai = 0; ai < 2; ++ai)
#pragma unroll
            for (int m = 0; m < 4; ++m) { bf16_t* rowp = O + (size_t)(row0 + ai * HALF + m * 16) * ldc + col0;
#pragma unroll
                for (int bj = 0; bj < 2; ++bj) { f32x4 v0 = acc[ai][bj][m][0], v1 = acc[ai][bj][m][1];
#pragma unroll
                    for (int e = 0; e < 4; ++e) { const float a = fmaxf(v0[e], 0.f), b = fmaxf(v1[e], 0.f); v0[e] = a * a; v1[e] = b * b; }
                    u32x4 w; w.x = cvt_pk_bf16(v0[0], v0[1]); w.y = cvt_pk_bf16(v0[2], v0[3]); w.z = cvt_pk_bf16(v1[0], v1[1]); w.w = cvt_pk_bf16(v1[2], v1[3]);
                    *(u32x4*)(rowp + bj * HALF) = w; } }
    }
};
struct EpiF32 {
    static constexpr bool PERM = false, AFTER_DRAIN = false;
    float* O; int ldc;
    __device__ __forceinline__ void operator()(const f32x4 (&acc)[2][2][4][2], const Unit& u, int wr, int wc, int fr, int fq) const {
        const int row0 = u.pm * BM + wr * 64 + fr, col0 = u.pn * BM + wc * 32 + 4 * fq;
#pragma unroll
        for (int ai = 0; ai < 2; ++ai)
#pragma unroll
            for (int m = 0; m < 4; ++m) { float* rowp = O + (size_t)(row0 + ai * HALF + m * 16) * ldc + col0;
#pragma unroll
                for (int bj = 0; bj < 2; ++bj)
#pragma unroll
                    for (int n = 0; n < 2; ++n) *(f32x4*)(rowp + bj * HALF + n * 16) = acc[ai][bj][m][n]; }
    }
};
template <class Epi, class Sched, bool ALIGN_EPI = false, bool SP2 = false>
__device__ __forceinline__ void gemm_phase(PG8_LAS unsigned char* lds, const Gemm g, const Sched& S, const Epi& E, const int wv) {
    const int lane = lane_id(), wid = wv, tid = wv * 64 + lane, wr = wid >> 2, wc = wid & 3, fr = lane & 15, fq = lane >> 4;
    const int K = g.K, nt = K / BK;
    unsigned voffA[2], voffB[2];
#pragma unroll
    for (int i = 0; i < 2; ++i) { int R, C; stage_rc(tid * 16 + i * 8192, R, C); const int Rb = Epi::PERM ? ((R & ~31) + perm32(R & 31)) : R;
        voffA[i] = (unsigned)(R * K + C) * 2u; voffB[i] = (unsigned)(Rb * K + C) * 2u; }
    const size_t kstep = (size_t)(BK * 2);
    const size_t hstep = (size_t)HALF * K * 2;
    const size_t tstep = 2 * hstep;
    const unsigned ldsw = (unsigned)wid * 1024u;
    const int aoff = lds_byte(wr * 64 + fr, fq * 8), boff = lds_byte(wc * 32 + fr, fq * 8);
#define PG8_SA(b, h) (((b) * 2 + (h)) * HTB)
#define PG8_SB(b, h) ((4 + (b) * 2 + (h)) * HTB)
#define PG8_STAGE(bufoff, gbase, voff) do { _Pragma("unroll") for (int _i = 0; _i < 2; ++_i) \
        __builtin_amdgcn_global_load_lds((const unsigned*)((const char*)(gbase) + (voff)[_i]), (PG8_LAS unsigned*)(lds + (bufoff) + ldsw + _i * 8192), 16, 0, 0); } while (0)
#define PG8_LDA(dst, b, h) do { _Pragma("unroll") for (int m = 0; m < 4; ++m) _Pragma("unroll") for (int k = 0; k < 2; ++k) dst[m][k] = *(const PG8_LAS bf16x8*)(lds + PG8_SA(b, h) + aoff + m * 2048 + k * 1024); } while (0)
#define PG8_LDB(dst, b, h) do { _Pragma("unroll") for (int n = 0; n < 2; ++n) _Pragma("unroll") for (int k = 0; k < 2; ++k) dst[n][k] = *(const PG8_LAS bf16x8*)(lds + PG8_SB(b, h) + boff + n * 2048 + k * 1024); } while (0)
#define PG8_MMA(ai, bj, At, Bt) do { __builtin_amdgcn_s_setprio(1); _Pragma("unroll") for (int m = 0; m < 4; ++m) _Pragma("unroll") for (int n = 0; n < 2; ++n) _Pragma("unroll") for (int k = 0; k < 2; ++k) \
        acc[ai][bj][m][n] = __builtin_amdgcn_mfma_f32_16x16x32_bf16(Bt[n][k], At[m][k], acc[ai][bj][m][n], 0, 0, 0); __builtin_amdgcn_s_setprio(0); } while (0)
#define PG8_WAIT_V(n) asm volatile("s_waitcnt vmcnt(" #n ")" ::: "memory")
#define PG8_WAIT_L(n) asm volatile("s_waitcnt lgkmcnt(" #n ")" ::: "memory")
#define PG8_BAR __builtin_amdgcn_s_barrier()
#define PG8_SCHED __builtin_amdgcn_sched_barrier(0)
    Unit cur, nxt; int ui = 0;
    if (!S.next(0, cur)) return;
    f32x4 acc[2][2][4][2];
#pragma unroll
    for (int a = 0; a < 2; ++a)
#pragma unroll
        for (int b = 0; b < 2; ++b)
#pragma unroll
            for (int m = 0; m < 4; ++m)
#pragma unroll
                for (int n = 0; n < 2; ++n) acc[a][b][m][n] = (f32x4){0.f, 0.f, 0.f, 0.f};
    bf16x8 At[4][2], B0[2][2], B1[2][2];
    const char* cA = (const char*)g.A + (size_t)cur.pm * tstep; const char* cB = (const char*)g.Bt + (size_t)cur.pn * tstep;
    S.a_ready(cur);
    if constexpr (SP2) {
        PG8_STAGE(PG8_SB(0, 0), cB, voffB); PG8_STAGE(PG8_SB(0, 1), cB + hstep, voffB); PG8_STAGE(PG8_SA(0, 0), cA, voffA); PG8_STAGE(PG8_SA(0, 1), cA + hstep, voffA);
        if (wr == 1) PG8_BAR;
        PG8_WAIT_V(2); PG8_BAR;
        PG8_STAGE(PG8_SB(1, 0), cB + kstep, voffB); PG8_STAGE(PG8_SA(1, 0), cA + kstep, voffA); PG8_STAGE(PG8_SB(1, 1), cB + hstep + kstep, voffB);
        PG8_WAIT_V(6); PG8_BAR;
    } else {
        PG8_STAGE(PG8_SB(0, 0), cB, voffB); PG8_STAGE(PG8_SA(0, 0), cA, voffA); PG8_STAGE(PG8_SB(0, 1), cB + hstep, voffB); PG8_STAGE(PG8_SA(0, 1), cA + hstep, voffA);
        if (wr == 1) PG8_BAR;
        PG8_WAIT_V(4); PG8_BAR;
        PG8_STAGE(PG8_SB(1, 0), cB + kstep, voffB); PG8_STAGE(PG8_SA(1, 0), cA + kstep, voffA); PG8_STAGE(PG8_SB(1, 1), cB + hstep + kstep, voffB);
        PG8_WAIT_V(6); PG8_BAR;
    }
    for (;;) {
        const bool has_next = S.next(ui + 1, nxt);
        const char* nA = has_next ? (const char*)g.A + (size_t)nxt.pm * tstep : cA; const char* nB = has_next ? (const char*)g.Bt + (size_t)nxt.pn * tstep : cB;
        for (int t = 0; t < nt; t += 2) {
            const bool last = (t == nt - 2);
            const char* a1 = cA + (size_t)(t + 1) * kstep;
            const char* a2 = last ? nA : cA + (size_t)(t + 2) * kstep; const char* b2 = last ? nB : cB + (size_t)(t + 2) * kstep;
            const char* a3 = a2 + kstep; const char* b3 = b2 + kstep;
            if (last && has_next) S.a_ready(nxt);
            if constexpr (SP2) {
            PG8_LDB(B0, 0, 0); PG8_LDB(B1, 0, 1); PG8_SCHED; PG8_LDA(At, 0, 0); PG8_STAGE(PG8_SA(1, 1), a1 + hstep, voffA);
            PG8_WAIT_V(8); PG8_WAIT_L(0); PG8_BAR; PG8_MMA(0, 0, At, B0); PG8_MMA(0, 1, At, B1); PG8_BAR; PG8_SCHED;
            PG8_LDA(At, 0, 1); PG8_STAGE(PG8_SB(0, 0), b2, voffB); PG8_STAGE(PG8_SB(0, 1), b2 + hstep, voffB); PG8_STAGE(PG8_SA(0, 0), a2, voffA);
            PG8_WAIT_V(8); PG8_WAIT_L(0); PG8_BAR; PG8_MMA(1, 0, At, B0); PG8_MMA(1, 1, At, B1); PG8_BAR; PG8_SCHED;
            PG8_LDB(B0, 1, 0); PG8_LDB(B1, 1, 1); PG8_SCHED; PG8_LDA(At, 1, 0); PG8_STAGE(PG8_SA(0, 1), a2 + hstep, voffA);
            PG8_WAIT_V(8); PG8_WAIT_L(0); PG8_BAR; PG8_MMA(0, 0, At, B0); PG8_MMA(0, 1, At, B1); PG8_BAR; PG8_SCHED;
            PG8_LDA(At, 1, 1); PG8_STAGE(PG8_SB(1, 0), b3, voffB); PG8_STAGE(PG8_SB(1, 1), b3 + hstep, voffB); PG8_STAGE(PG8_SA(1, 0), a3, voffA);
            PG8_WAIT_V(8); PG8_WAIT_L(0); PG8_BAR; PG8_MMA(1, 0, At, B0); PG8_MMA(1, 1, At, B1); PG8_BAR; PG8_SCHED;
            } else {
            PG8_LDB(B0, 0, 0); PG8_SCHED; PG8_LDA(At, 0, 0); PG8_STAGE(PG8_SA(1, 1), a1 + hstep, voffA);
            PG8_WAIT_L(8); PG8_BAR; PG8_WAIT_L(0); PG8_MMA(0, 0, At, B0); PG8_BAR; PG8_SCHED;
            PG8_LDB(B1, 0, 1); PG8_STAGE(PG8_SB(0, 0), b2, voffB);
            PG8_BAR; PG8_WAIT_L(0); PG8_MMA(0, 1, At, B1); PG8_BAR;
            PG8_LDA(At, 0, 1); PG8_STAGE(PG8_SA(0, 0), a2, voffA);
            PG8_BAR; PG8_WAIT_L(0); PG8_MMA(1, 0, At, B0); PG8_BAR; PG8_SCHED;
            PG8_STAGE(PG8_SB(0, 1), b2 + hstep, voffB);
            PG8_WAIT_V(6); PG8_BAR; PG8_MMA(1, 1, At, B1); PG8_BAR;
            PG8_LDB(B0, 1, 0); PG8_SCHED; PG8_LDA(At, 1, 0); PG8_STAGE(PG8_SA(0, 1), a2 + hstep, voffA);
            PG8_WAIT_L(8); PG8_BAR; PG8_WAIT_L(0); PG8_MMA(0, 0, At, B0); PG8_BAR; PG8_SCHED;
            PG8_LDB(B1, 1, 1); PG8_STAGE(PG8_SB(1, 0), b3, voffB);
            PG8_BAR; PG8_WAIT_L(0); PG8_MMA(0, 1, At, B1); PG8_BAR;
            PG8_LDA(At, 1, 1); PG8_STAGE(PG8_SA(1, 0), a3, voffA);
            PG8_BAR; PG8_WAIT_L(0); PG8_MMA(1, 0, At, B0); PG8_BAR; PG8_SCHED;
            PG8_STAGE(PG8_SB(1, 1), b3 + hstep, voffB);
            PG8_WAIT_V(6); PG8_BAR; PG8_MMA(1, 1, At, B1); PG8_BAR;
            }
        }
        if constexpr (ALIGN_EPI) { if (wr == 0) PG8_BAR; }
        if constexpr (!Epi::AFTER_DRAIN) { E(acc, cur, wr, wc, fr, fq); S.done(cur); }
        if (!has_next) break;
#pragma unroll
        for (int a = 0; a < 2; ++a)
#pragma unroll
            for (int b = 0; b < 2; ++b)
#pragma unroll
                for (int m = 0; m < 4; ++m)
#pragma unroll
                    for (int n = 0; n < 2; ++n) acc[a][b][m][n] = (f32x4){0.f, 0.f, 0.f, 0.f};
        cur = nxt; cA = nA; cB = nB; ++ui;
        if constexpr (ALIGN_EPI) { if (wr == 1) PG8_BAR; }
    }
    PG8_WAIT_V(0);
    if constexpr (!ALIGN_EPI) { if (wr == 0) PG8_BAR; }
    PG8_BAR;
    if constexpr (Epi::AFTER_DRAIN) { E.fused(acc, cur, wr, wc, fr, fq, lds, wid, lane); S.done(cur); }
#undef PG8_SA
#undef PG8_SB
#undef PG8_STAGE
#undef PG8_LDA
#undef PG8_LDB
#undef PG8_MMA
#undef PG8_WAIT_V
#undef PG8_WAIT_L
#undef PG8_BAR
#undef PG8_SCHED
}
}
#include <hip/hip_bf16.h>
#include <cmath>
namespace attn_body {
using bf16=__hip_bfloat16;
using bf16x8=__attribute__((ext_vector_type(8)))short;
using s16x4=__attribute__((ext_vector_type(4)))short;
using f32x16=__attribute__((ext_vector_type(16)))float;
using u32x4=__attribute__((ext_vector_type(4)))unsigned;
constexpr int BATCH=8,NHEAD=8,SEQ=2048,D=64,DM=NHEAD*D,OPITCH=1024;
constexpr int NW=8,QBLK=32,QB=QBLK*NW,KVBLK=64,NQB=SEQ/QB;
constexpr int ATTN_PITCH=DM, ATTN_UNIT_ROWS=QB;
__device__ __forceinline__ int crow(int r,int hi){return (r&3)+8*(r>>2)+4*hi;}
#define SBAR() __builtin_amdgcn_sched_barrier(0)
__device__ __forceinline__ void cmask(f32x16&p0,f32x16&p1,int jb,int qrel,int hi){
  const float NEG=-INFINITY; int kb=64*jb+4*hi;
  #pragma unroll
  for(int r=0;r<16;++r){int kv=kb+(r&3)+8*(r>>2); if(kv>qrel)p0[r]=NEG; if(kv+32>qrel)p1[r]=NEG;}
}

constexpr int NSLOT=3, SLOTB=8192;
constexpr int LDS_K=0, LDS_V=NSLOT*SLOTB, LDS_WS=2*NSLOT*SLOTB, LDS_OST=LDS_WS+NW*64*4, LDS_KB=LDS_OST+NW*4096, LDS_BYTES=LDS_KB+SEQ*16;
constexpr float C2=0.125f*1.4426950408889634f;
__device__ __forceinline__ void glds16(const void*gsrc,unsigned lds_dst){unsigned keep;
  asm volatile("s_mov_b32 %0, m0\n\ts_mov_b32 m0, %2\n\ts_nop 0\n\tglobal_load_lds_dwordx4 %1, off\n\ts_mov_b32 m0, %0":"=&s"(keep):"v"(gsrc),"s"(lds_dst):"memory");}
__device__ __forceinline__ float max3f(float a,float b,float c){float r;asm("v_max3_f32 %0, %1, %2, %3":"=v"(r):"v"(a),"v"(b),"v"(c));return r;}
__device__ __forceinline__ float max2f(float a,float b){float r;asm("v_max_f32_e32 %0, %1, %2":"=v"(r):"v"(a),"v"(b));return r;}
__device__ __forceinline__ float fadd_s(float a,float b){float r;asm("v_add_f32_e32 %0, %1, %2":"=v"(r):"v"(a),"v"(b));return r;}
__device__ __forceinline__ float fsub_s(float a,float b){float r;asm("v_sub_f32_e32 %0, %1, %2":"=v"(r):"v"(a),"v"(b));return r;}
typedef float f32x2_t __attribute__((ext_vector_type(2))); typedef __bf16 bf16x2_t __attribute__((ext_vector_type(2)));
__device__ __forceinline__ unsigned cvtpk_s(float lo,float hi){f32x2_t v={lo,hi};bf16x2_t b=__builtin_convertvector(v,bf16x2_t);return __builtin_bit_cast(unsigned,b);}
#define WAIT_BAR(N) asm volatile("s_waitcnt vmcnt(" #N ") lgkmcnt(0)\n\ts_barrier":::"memory")

__device__ __forceinline__ void qkt(f32x16&p0,f32x16&p1,const char*Kslot,const bf16x8*qr,const bf16x8 ka0,const bf16x8 ka1,const bf16x8 qbf,int r32,int hi){
  p0=__builtin_amdgcn_mfma_f32_32x32x16_bf16(ka0,qbf,f32x16{},0,0,0);p1=__builtin_amdgcn_mfma_f32_32x32x16_bf16(ka1,qbf,f32x16{},0,0,0);
  const char*kb=Kslot+hi*1024+r32*16;
  #pragma unroll
  for(int d0=0;d0<4;++d0){
    const bf16x8 b0=*reinterpret_cast<const bf16x8*>(kb+d0*2048);
    const bf16x8 b1=*reinterpret_cast<const bf16x8*>(kb+d0*2048+512);
    p0=__builtin_amdgcn_mfma_f32_32x32x16_bf16(b0,qr[d0],p0,0,0,0);p1=__builtin_amdgcn_mfma_f32_32x32x16_bf16(b1,qr[d0],p1,0,0,0);}
}
typedef __attribute__((address_space(3))) const char* lds_cptr;
typedef short v4i16_t __attribute__((ext_vector_type(4)));
__device__ __forceinline__ void kload8(bf16x8*kf,lds_cptr kp){
  kf[0]=*(const __attribute__((address_space(3))) bf16x8*)(kp);      kf[1]=*(const __attribute__((address_space(3))) bf16x8*)(kp+512);
  kf[2]=*(const __attribute__((address_space(3))) bf16x8*)(kp+2048); kf[3]=*(const __attribute__((address_space(3))) bf16x8*)(kp+2560);
  kf[4]=*(const __attribute__((address_space(3))) bf16x8*)(kp+4096); kf[5]=*(const __attribute__((address_space(3))) bf16x8*)(kp+4608);
  kf[6]=*(const __attribute__((address_space(3))) bf16x8*)(kp+6144); kf[7]=*(const __attribute__((address_space(3))) bf16x8*)(kp+6656);
}
__device__ __forceinline__ void kload2(bf16x8*kf,lds_cptr kp,int j){ kf[2*j]=*(const __attribute__((address_space(3))) bf16x8*)(kp+j*2048); kf[2*j+1]=*(const __attribute__((address_space(3))) bf16x8*)(kp+j*2048+512); }
__device__ __forceinline__ s16x4 vtr(lds_cptr p){ return __builtin_bit_cast(s16x4,__builtin_amdgcn_ds_read_tr16_b64_v4i16((__attribute__((address_space(3))) v4i16_t*)p)); }
__device__ __forceinline__ float rowmax(const f32x16&p0,const f32x16&p1){
  float a=max3f(p0[0],p0[1],p1[0]),b=max3f(p0[2],p0[3],p1[1]);a=max3f(a,p1[2],p1[3]);
  #pragma unroll
  for(int r=4;r<16;r+=4){a=max3f(a,p0[r],p0[r+1]);b=max3f(b,p0[r+2],p0[r+3]);a=max3f(a,p1[r],p1[r+1]);b=max3f(b,p1[r+2],p1[r+3]);}
  const float m=max2f(a,b);
  auto rr=__builtin_amdgcn_permlane32_swap(__float_as_uint(m),__float_as_uint(m),false,false);
  return max2f(__uint_as_float(rr[0]),__uint_as_float(rr[1]));
}
__device__ __forceinline__ void pv(f32x16*o,int vb,bf16x8 pa0,bf16x8 pa1,bf16x8 pa2,bf16x8 pa3){
  #pragma unroll
  for(int d0=0;d0<2;++d0){s16x4 lo[4],hi[4];
    #pragma unroll
    for(int ks=0;ks<4;++ks){
      asm volatile("ds_read_b64_tr_b16 %0,%1 offset:%c2":"=&v"(lo[ks]):"v"(vb),"i"(d0*4096+ks*1024):"memory");
      asm volatile("ds_read_b64_tr_b16 %0,%1 offset:%c2":"=&v"(hi[ks]):"v"(vb),"i"(d0*4096+ks*1024+512):"memory");}
    asm volatile("s_waitcnt lgkmcnt(0)":::"memory");SBAR();
    #define PK(k) (bf16x8){lo[k][0],lo[k][1],lo[k][2],lo[k][3],hi[k][0],hi[k][1],hi[k][2],hi[k][3]}
    o[d0]=__builtin_amdgcn_mfma_f32_32x32x16_bf16(pa0,PK(0),o[d0],0,0,0);
    o[d0]=__builtin_amdgcn_mfma_f32_32x32x16_bf16(pa1,PK(1),o[d0],0,0,0);
    o[d0]=__builtin_amdgcn_mfma_f32_32x32x16_bf16(pa2,PK(2),o[d0],0,0,0);
    o[d0]=__builtin_amdgcn_mfma_f32_32x32x16_bf16(pa3,PK(3),o[d0],0,0,0);
    #undef PK
  }
}

#ifndef ATTN_STORE16
#define ATTN_STORE16(p,v) (*(u32x4*)(p)=(v))
#endif
__device__ __forceinline__ unsigned bfbits(float f){unsigned u=__builtin_bit_cast(unsigned,f);return (u+0x7fffu+((u>>16)&1u))>>16;}
__device__ __forceinline__ void split3(float x,unsigned&h1,unsigned&h2,unsigned&h3){h1=bfbits(x);const float r1=x-__uint_as_float(h1<<16);h2=bfbits(r1);const float r2=r1-__uint_as_float(h2<<16);h3=bfbits(r2);}
template<int THRL> __device__ __forceinline__ void attn_unit(int b,int h,int qb,const bf16*Q,const bf16*__restrict__ K,const bf16*__restrict__ V,bf16*O,const float*cumbh,const float*gnorm,char*shm,const int wid){
  const int lane=lane_id(),tid=wid*64+lane,r32=lane&31,hi=lane>>5;
  const long rowbase=(long)b*SEQ; const int q0=qb*QB;
  const bf16*Qw=Q+(rowbase+q0+wid*QBLK)*DM+h*D;
  const bf16*Kh=K+rowbase*DM+h*D,*Vh=V+rowbase*DM+h*D;
  const unsigned lds0=(unsigned)(uintptr_t)shm;
  float*wsf=(float*)(shm+LDS_WS)+wid*64;
  { const float cref=cumbh[q0]; u32x4*kbw=(u32x4*)(shm+LDS_KB);
    for(int i=tid;i<q0+QB;i+=NW*64){ const float kb=(cref-cumbh[i])*1.4426950408889634f; unsigned h1,h2,h3; split3(kb,h1,h2,h3); kbw[i]=(u32x4){h1|(h2<<16),h3|0x3F800000u,0x3F803F80u,0u}; } }
  const bf16*ksrc=Kh+(long)lane*DM+wid*8;
  const bf16*vsrc=Vh+(long)(16*(wid&3)+(lane>>2))*DM+(wid>>2)*32+(lane&3)*8;
  const unsigned kdst=lds0+LDS_K+wid*1024, vdst=lds0+LDS_V+wid*1024;
  #define DMA_K(t,slot) glds16(ksrc+(long)(t)*KVBLK*DM,(unsigned)__builtin_amdgcn_readfirstlane(kdst+(slot)))
  #define DMA_V(t,slot) glds16(vsrc+(long)(t)*KVBLK*DM,(unsigned)__builtin_amdgcn_readfirstlane(vdst+(slot)))
  const int vb0=(int)(lds0+LDS_V)+((lane>>4)&1)*32+(lane&3)*8+(4*hi+((lane&15)>>2))*64;
  const char*Kbase=shm+LDS_K; bf16x8 kf[8];
  const lds_cptr shm3=(lds_cptr)shm; const lds_cptr kp0=shm3+LDS_K+hi*1024+r32*16; const lds_cptr vp0=shm3+LDS_V+((lane>>4)&1)*32+(lane&3)*8+(4*hi+((lane&15)>>2))*64;
  const int NT=(q0+QB)/KVBLK;
  DMA_K(0,0);DMA_V(0,0);DMA_K(1,SLOTB);
  bf16x8 qr[4];
  #pragma unroll
  for(int d0=0;d0<4;++d0)qr[d0]=*reinterpret_cast<const bf16x8*>(&Qw[(long)r32*DM+d0*16+hi*8]);
  float mhat=0.f,l_reg=0.f;f32x16 o[2];o[0]=f32x16{};o[1]=f32x16{};u32x4 qbw=(u32x4){hi?0u:0x3F803F80u,hi?0u:0x3F80u,0u,0u};
  const lds_cptr kbp0=(lds_cptr)shm+LDS_KB+r32*16;
  #define QBF __builtin_bit_cast(bf16x8,qbw)
  #define KBLD(t,p) (*(const __attribute__((address_space(3))) bf16x8*)(kbp0+((t)*64+(p)*32)*16))
  #define SETQB() do{ unsigned h1_,h2_,h3_; split3(-mhat,h1_,h2_,h3_); qbw[1]=hi?0u:(0x3F80u|(h1_<<16)); qbw[2]=hi?0u:(h2_|(h3_<<16)); asm volatile("":"+v"(qbw)); }while(0)
  const int qrel=wid*QBLK+r32;
  #define CMASK(P0,P1,t) do{int jb_=(t)-(NT-4); if(jb_>=0)cmask(P0,P1,jb_,qrel,hi);}while(0)
  bool resc=false;
  #define START(P0,P1) do{ const float rm=rowmax(P0,P1); resc=false; \
    { const float dl=rm; mhat=fadd_s(mhat,dl); \
      _Pragma("unroll") for(int r=0;r<16;++r){P0[r]=fsub_s(P0[r],dl);P1[r]=fsub_s(P1[r],dl);} \
      SETQB(); } \
    _Pragma("unroll") for(int r=0;r<16;++r)P0[r]=__builtin_amdgcn_exp2f(P0[r]); }while(0)
  #define RESC() do{ if(resc){ asm volatile("s_waitcnt lgkmcnt(0)":::"memory"); \
      _Pragma("unroll") for(int d_=0;d_<2;++d_) _Pragma("unroll") for(int r=0;r<16;++r)o[d_][r]*=wsf[crow(r,hi)]; } }while(0)
  f32x16 pA0,pA1,pB0,pB1;
  int sl_prev=0,sl_cur=0,sl_next=SLOTB;
  #define ROT() do{sl_prev=sl_cur;sl_cur=sl_next;sl_next=(sl_next==(NSLOT-1)*SLOTB)?0:sl_next+SLOTB;}while(0)
  DMA_K(2,2*SLOTB);
  WAIT_BAR(3);
  qkt(pA0,pA1,Kbase,qr,KBLD(0,0),KBLD(0,1),QBF,r32,hi);asm volatile("s_nop 15\n\ts_nop 7":"+v"(pA0),"+v"(pA1));CMASK(pA0,pA1,0);
  START(pA0,pA1);
  _Pragma("unroll") for(int r=0;r<16;++r)pA1[r]=__builtin_amdgcn_exp2f(pA1[r]);
  WAIT_BAR(0);
  DMA_K(3,0);DMA_V(1,SLOTB);
  ROT();
  kload8(kf,kp0+sl_cur);
  WAIT_BAR(2);
  s16x4 vlo[8],vhi[8]; u32x4 pw0,pw1,pw2,pw3;
  #define PKW(P,B) cvtpk_s(P[B],P[B+1])
  #define PAF(k) __builtin_bit_cast(bf16x8,pw##k)
  #define VFR(i) (bf16x8){vlo[i][0],vlo[i][1],vlo[i][2],vlo[i][3],vhi[i][0],vhi[i][1],vhi[i][2],vhi[i][3]}
  #define PIN(x) asm volatile("":"+v"(x))
  #define MX3(a,b,c) __builtin_fmaxf(__builtin_fmaxf((a),(b)),(c))
  #define GAPA(MF,A0,A1,A2,A3,W0,W1,PW) do{ MF; sacc+=A0; sacc+=A1; sacc+=A2; sacc+=A3; PIN(sacc); W0; W1; PIN(PW); SBAR(); }while(0)
  #define EX(v) __builtin_amdgcn_exp2f(v)
  #define GAPB(MF,X,B) do{ MF; X[B]=EX(X[B]); X[B+1]=EX(X[B+1]); X[B+2]=EX(X[B+2]); X[B+3]=EX(X[B+3]); PIN(X); SBAR(); }while(0)
  #define VRD(i) do{ vlo[i]=vtr(vp_+(((i)>>2)*4096+((i)&3)*1024)); vhi[i]=vtr(vp_+(((i)>>2)*4096+((i)&3)*1024+512)); }while(0)
  #define KRD(G,j) do{ if(G){ kload2(kf,kp0+sl_next,j); SBAR(); } }while(0)
  #define STEP(C0,C1,P0,P1,t,GK,GV,GL) do{ SBAR(); \
    const lds_cptr vp_=vp0+sl_prev; \
    { const bf16x8 ka0_=KBLD(t,0), ka1_=KBLD(t,1); VRD(0); SBAR(); \
      C0=__builtin_amdgcn_mfma_f32_32x32x16_bf16(ka0_,QBF,f32x16{},0,0,0); C1=__builtin_amdgcn_mfma_f32_32x32x16_bf16(ka1_,QBF,f32x16{},0,0,0); SBAR(); } \
    float sacc=(P0[0]+P0[1]); \
    GAPA(C0=__builtin_amdgcn_mfma_f32_32x32x16_bf16(kf[0],qr[0],C0,0,0,0), P0[2],P0[3],P0[4],P0[5],     pw0[0]=PKW(P0,0), pw0[1]=PKW(P0,2), pw0); \
    VRD(4); SBAR(); GAPA(C1=__builtin_amdgcn_mfma_f32_32x32x16_bf16(kf[1],qr[0],C1,0,0,0), P0[6],P0[7],P0[8],P0[9],     pw0[2]=PKW(P0,4), pw0[3]=PKW(P0,6), pw0); \
    VRD(1); SBAR(); GAPA(C0=__builtin_amdgcn_mfma_f32_32x32x16_bf16(kf[2],qr[1],C0,0,0,0),   P0[10],P0[11],P0[12],P0[13], pw1[0]=PKW(P0,8), pw1[1]=PKW(P0,10), pw1); \
    VRD(5); SBAR(); GAPA(C1=__builtin_amdgcn_mfma_f32_32x32x16_bf16(kf[3],qr[1],C1,0,0,0),   P0[14],P0[15],P1[0],P1[1],   pw1[2]=PKW(P0,12),pw1[3]=PKW(P0,14), pw1); \
    VRD(2); SBAR(); GAPA(C0=__builtin_amdgcn_mfma_f32_32x32x16_bf16(kf[4],qr[2],C0,0,0,0),   P1[2],P1[3],P1[4],P1[5],     pw2[0]=PKW(P1,0), pw2[1]=PKW(P1,2), pw2); \
    VRD(6); SBAR(); GAPA(C1=__builtin_amdgcn_mfma_f32_32x32x16_bf16(kf[5],qr[2],C1,0,0,0),   P1[6],P1[7],P1[8],P1[9],     pw2[2]=PKW(P1,4), pw2[3]=PKW(P1,6), pw2); \
    VRD(3); SBAR(); GAPA(C0=__builtin_amdgcn_mfma_f32_32x32x16_bf16(kf[6],qr[3],C0,0,0,0),   P1[10],P1[11],P1[12],P1[13], pw3[0]=PKW(P1,8), pw3[1]=PKW(P1,10), pw3); \
    VRD(7); SBAR(); GAPA(C1=__builtin_amdgcn_mfma_f32_32x32x16_bf16(kf[7],qr[3],C1,0,0,0),   P1[14],P1[15],0.f,0.f,       pw3[2]=PKW(P1,12),pw3[3]=PKW(P1,14), pw3); \
    l_reg+=sacc; \
    if(GK){DMA_K((t)+3,sl_cur);} if(GV){DMA_V((t)+1,sl_next);} \
    CMASK(C0,C1,t); \
    { float a=MX3(C0[0],C0[1],C1[0]),b=MX3(C0[2],C0[3],C1[1]); a=MX3(a,C1[2],C1[3]); \
      _Pragma("unroll") for(int r=4;r<16;r+=4){a=MX3(a,C0[r],C0[r+1]);b=MX3(b,C0[r+2],C0[r+3]);a=MX3(a,C1[r],C1[r+1]);b=MX3(b,C1[r+2],C1[r+3]);} \
      float rm=__builtin_fmaxf(a,b); { auto rr=__builtin_amdgcn_permlane32_swap(__float_as_uint(rm),__float_as_uint(rm),false,false); rm=__builtin_fmaxf(__uint_as_float(rr[0]),__uint_as_float(rr[1])); } \
      resc=false; \
      if(__builtin_expect(__any(rm>(float)THRL),0)){ const float dl=__builtin_fmaxf(rm,0.f); mhat+=dl; \
        _Pragma("unroll") for(int r=0;r<16;++r){C0[r]-=dl;C1[r]-=dl;} \
        SETQB(); \
        const float f=__builtin_amdgcn_exp2f(-dl); l_reg*=f; if(hi==0)wsf[r32]=f; resc=true; } } \
    SBAR(); \
    GAPB(o[0]=__builtin_amdgcn_mfma_f32_32x32x16_bf16(PAF(0),VFR(0),o[0],0,0,0), C0,0); \
    GAPB(o[1]=__builtin_amdgcn_mfma_f32_32x32x16_bf16(PAF(0),VFR(4),o[1],0,0,0), C0,4); \
    KRD(GL,0); GAPB(o[0]=__builtin_amdgcn_mfma_f32_32x32x16_bf16(PAF(1),VFR(1),o[0],0,0,0), C0,8); \
    KRD(GL,1); GAPB(o[1]=__builtin_amdgcn_mfma_f32_32x32x16_bf16(PAF(1),VFR(5),o[1],0,0,0), C0,12); \
    KRD(GL,2); GAPB(o[0]=__builtin_amdgcn_mfma_f32_32x32x16_bf16(PAF(2),VFR(2),o[0],0,0,0), C1,0); \
    KRD(GL,3); GAPB(o[1]=__builtin_amdgcn_mfma_f32_32x32x16_bf16(PAF(2),VFR(6),o[1],0,0,0), C1,4); \
    GAPB(o[0]=__builtin_amdgcn_mfma_f32_32x32x16_bf16(PAF(3),VFR(3),o[0],0,0,0), C1,8); \
    GAPB(o[1]=__builtin_amdgcn_mfma_f32_32x32x16_bf16(PAF(3),VFR(7),o[1],0,0,0), C1,12); \
    }while(0)
  int t=1;
  #undef CMASK
  #define CMASK(P0,P1,t) do{}while(0)
  for(;t+5<NT;t+=2){
    STEP(pB0,pB1,pA0,pA1,t,true,true,true);     WAIT_BAR(2); RESC(); ROT();
    STEP(pA0,pA1,pB0,pB1,t+1,true,true,true);   WAIT_BAR(2); RESC(); ROT();
  }
  #undef CMASK
  #define CMASK(P0,P1,t) do{int jb_=(t)-(NT-4); if(jb_>=0)cmask(P0,P1,jb_,qrel,hi);}while(0)
  #define ENDW(tt) do{ if((tt)+3<NT){WAIT_BAR(2);} else if((tt)+2<NT){WAIT_BAR(1);} else {WAIT_BAR(0);} }while(0)
  for(;t+1<NT;t+=2){
    STEP(pB0,pB1,pA0,pA1,t,(t+3<NT),(t+1<NT),(t+1<NT));       ENDW(t);   RESC(); ROT();
    STEP(pA0,pA1,pB0,pB1,t+1,(t+4<NT),(t+2<NT),(t+2<NT));     ENDW(t+1); RESC(); ROT();
  }
  STEP(pB0,pB1,pA0,pA1,NT-1,false,false,false); RESC();
  { float sacc=pB0[0]+pB0[1]; _Pragma("unroll") for(int r=2;r<16;++r)sacc+=pB0[r]; _Pragma("unroll") for(int r=0;r<16;++r)sacc+=pB1[r]; l_reg+=sacc;
    pw0=(u32x4){PKW(pB0,0),PKW(pB0,2),PKW(pB0,4),PKW(pB0,6)};pw1=(u32x4){PKW(pB0,8),PKW(pB0,10),PKW(pB0,12),PKW(pB0,14)};pw2=(u32x4){PKW(pB1,0),PKW(pB1,2),PKW(pB1,4),PKW(pB1,6)};pw3=(u32x4){PKW(pB1,8),PKW(pB1,10),PKW(pB1,12),PKW(pB1,14)};
    SBAR(); pv(o,vb0+sl_cur,PAF(0),PAF(1),PAF(2),PAF(3)); }
  #undef PKW
  #undef PAF
  #undef VFR
  #undef PIN
  #undef MX3
  #undef GAPA
  #undef GAPB
  #undef EX
  #undef VRD
  #undef KRD
  #undef STEP
  #undef ENDW
  {auto rr=__builtin_amdgcn_permlane32_swap(__float_as_uint(l_reg),__float_as_uint(l_reg),false,false);l_reg=__uint_as_float(rr[0])+__uint_as_float(rr[1]);}
  if(hi==0)wsf[32+r32]=l_reg;asm volatile("s_waitcnt lgkmcnt(0)":::"memory");
  float rli[16];
  #pragma unroll
  for(int r=0;r<16;++r)rli[r]=__builtin_amdgcn_rcpf(wsf[32+crow(r,hi)]);
  bf16*Ow=O+(rowbase+q0+wid*QBLK)*OPITCH+h*D;
  float gn[8];
  #pragma unroll
  for(int j=0;j<8;++j)gn[j]=gnorm[(lane&7)*8+j];
  { bf16*stg=(bf16*)(shm+LDS_OST)+wid*2048;
    #pragma unroll
    for(int r=0;r<16;++r){const int orow=crow(r,hi);
      #pragma unroll
      for(int d0=0;d0<2;++d0)stg[orow*64+d0*32+r32]=__float2bfloat16(o[d0][r]*rli[r]);}
    asm volatile("s_waitcnt lgkmcnt(0)":::"memory");
    #pragma unroll
    for(int i=0;i<4;++i){const int row=i*8+(lane>>3),ch=lane&7; const u32x4 v=*(const u32x4*)(stg+row*64+ch*8);
      float f[8];
      #pragma unroll
      for(int j=0;j<4;++j){f[2*j]=__uint_as_float(v[j]<<16);f[2*j+1]=__uint_as_float(v[j]&0xffff0000u);}
      float ss=0.f;
      #pragma unroll
      for(int j=0;j<8;++j)ss+=f[j]*f[j];
      ss+=__shfl_xor(ss,1);ss+=__shfl_xor(ss,2);ss+=__shfl_xor(ss,4);
      const float rs=__builtin_amdgcn_rsqf(ss*(1.f/64.f)+1e-6f);
      u32x4 w;
      #pragma unroll
      for(int j=0;j<4;++j)w[j]=cvtpk_s(f[2*j]*rs*gn[2*j],f[2*j+1]*rs*gn[2*j+1]);
      ATTN_STORE16(Ow+(long)row*OPITCH+ch*8,w);} }
  asm volatile("s_waitcnt lgkmcnt(0)\n\ts_barrier":::"memory");
  #undef DMA_K
  #undef DMA_V
  #undef QBF
  #undef KBLD
  #undef SETQB
  #undef CMASK
  #undef START
  #undef RESC
  #undef ROT
}
constexpr int ATTN_LDS_BYTES=LDS_BYTES;
struct AttnTensors { const bf16* Q; const bf16* K; const bf16* V; bf16* O; const float* cum; const float* gnorm; };
struct AttnUnit { int bh; int qb; };
struct StaticOrder {
  int vcu;
  __device__ __forceinline__ explicit StaticOrder(int grid,int block):vcu((block%8)*(grid/8)+block/8){}
  __device__ __forceinline__ bool next(int i,AttnUnit&u)const{ if(i>=2)return false; const int s=vcu&3; u.bh=vcu>>2; u.qb=(i==0)?7-s:s; return true; }
  __device__ __forceinline__ void a_ready(const AttnUnit&)const{}
  __device__ __forceinline__ void done(const AttnUnit&)const{}
};
struct QueueOrder {
  unsigned* ctr; volatile __attribute__((address_space(3))) unsigned* slot; int grp; int wv;
  __device__ __forceinline__ bool next(int,AttnUnit&u)const{
    if(wv==0&&lane_id()==0)slot[0]=__hip_atomic_fetch_add(ctr+64*grp,1u,__ATOMIC_RELAXED,__HIP_MEMORY_SCOPE_AGENT);
    __syncthreads(); const unsigned i=slot[0]; __syncthreads();
    if(i>=64u)return false; u.qb=7-(int)(i>>3); u.bh=(int)((i&7u)<<3)|grp; return true; }
  __device__ __forceinline__ void a_ready(const AttnUnit&)const{}
  __device__ __forceinline__ void done(const AttnUnit&)const{}
};
template<class Sched,int THRL=8> __device__ __forceinline__ void attn_phase(char*lds,const AttnTensors&T,const Sched&S,const int wv){
  AttnUnit u;
  for(int i=0;S.next(i,u);++i){ S.a_ready(u); attn_unit<THRL>(u.bh/NHEAD,u.bh%NHEAD,u.qb,T.Q,T.K,T.V,T.O,T.cum+(long)u.bh*SEQ,T.gnorm,lds,wv); S.done(u); }
}
#undef SBAR
#undef WAIT_BAR
}
namespace gdn {
typedef unsigned short bf16_t;
typedef short bf16x8 __attribute__((ext_vector_type(8)));
typedef float f32x16 __attribute__((ext_vector_type(16)));
typedef float f32x4 __attribute__((ext_vector_type(4)));
typedef float f32x2 __attribute__((ext_vector_type(2)));
typedef unsigned u32x4 __attribute__((ext_vector_type(4)));
typedef unsigned u32x2 __attribute__((ext_vector_type(2)));
typedef __bf16 bf16x2_t __attribute__((ext_vector_type(2)));
#define GLAS __attribute__((address_space(3)))
constexpr int CH = 64, DK = 128, NCH = 32, NITEM = 8 * 4 * NCH, FRAGS = 56, ITEM_ELEMS = FRAGS * 512;
constexpr float L2E = 1.4426950408889634f;
__device__ __forceinline__ int crow(int r, int hi) { return (r & 3) + 8 * (r >> 2) + 4 * hi; }
__device__ __forceinline__ float bf2f(unsigned short u) { return __uint_as_float((unsigned)u << 16); }
__device__ __forceinline__ unsigned cvtpk(float lo, float hi) { f32x2 v = {lo, hi}; bf16x2_t b = __builtin_convertvector(v, bf16x2_t); return __builtin_bit_cast(unsigned, b); }
__device__ __forceinline__ unsigned short f2bf1(float x) { return (unsigned short)(cvtpk(x, 0.f) & 0xffffu); }
__device__ __forceinline__ int frag_off(int r, int kl) { return ((((kl >> 2) & 1) * 32 + r) << 3) + ((kl >> 3) << 2) + (kl & 3); }
__device__ __forceinline__ float silu_f(float y) { return y * __builtin_amdgcn_rcpf(1.f + __expf(-y)); }

constexpr int L_QS = 0, L_KS = 16384, L_VS = 32768, L_MT = 49152, MT_LD = 68, L_SC = L_MT + CH * MT_LD * 4, SLOT_BYTES = 73728;
static_assert(L_SC + 6 * 64 * 4 <= SLOT_BYTES, "gdn LDS slot");
__device__ __forceinline__ int swz(int row, int c16) { return row * 256 + ((c16 ^ (row & 15)) << 4); }

struct G1Args { const bf16_t *GQ, *GK, *GV; const float *small, *cw, *a_log, *dt_bias; float* U; bf16_t* FR; float* GL; };

__device__ __forceinline__ void g1_pair(const G1Args& A, int pair, GLAS unsigned char* lds0, const int wave) {
    const int lane = lane_id(), isl = wave >> 2, lw = wave & 3, lt = lw * 64 + lane;
    const int item = pair * 2 + isl, bh = item >> 5, n = item & 31, b = bh >> 2, h = bh & 3;
    const size_t m0 = (size_t)b * 2048 + (size_t)n * 64;
    GLAS unsigned char* lds = lds0 + isl * SLOT_BYTES;
    GLAS float* SC = (GLAS float*)(lds + L_SC);
    GLAS float* MT = (GLAS float*)(lds + L_MT);
    bf16_t* fr = A.FR + (size_t)item * ITEM_ELEMS;
    if (lw < 3) {
        const int c16 = lane & 15, r0 = (lane >> 4) * 16;
        const bf16_t* src = (lw == 0 ? A.GQ : (lw == 1 ? A.GK : A.GV)) + (m0 + r0) * 512 + h * 128 + c16 * 8;
        const float* cwp = A.cw + lw * 512 + h * 128 + c16 * 8;
        float wt[4][8];
#pragma unroll
        for (int j = 0; j < 4; ++j) { const f32x4 a = *(const f32x4*)(cwp + j * 1536), bq = *(const f32x4*)(cwp + j * 1536 + 4);
            wt[j][0] = a[0]; wt[j][1] = a[1]; wt[j][2] = a[2]; wt[j][3] = a[3]; wt[j][4] = bq[0]; wt[j][5] = bq[1]; wt[j][6] = bq[2]; wt[j][7] = bq[3]; }
        const bool halo = !(n == 0 && r0 == 0);
        u32x4 x[19];
#pragma unroll
        for (int rr = 0; rr < 19; ++rr) { x[rr] = (u32x4){0u, 0u, 0u, 0u}; if (rr >= 3 || halo) x[rr] = *(const u32x4*)(src + (rr - 3) * 512); }
        GLAS unsigned char* img = lds + (lw == 0 ? L_QS : (lw == 1 ? L_KS : L_VS));
#pragma unroll
        for (int ro = 0; ro < 16; ++ro) {
            float o[8];
#pragma unroll
            for (int e = 0; e < 8; ++e) {
                float acc = 0.f;
#pragma unroll
                for (int j = 0; j < 4; ++j) { const unsigned wrd = x[ro + j][e >> 1]; acc += wt[j][e] * ((e & 1) ? __uint_as_float(wrd & 0xffff0000u) : __uint_as_float(wrd << 16)); }
                o[e] = silu_f(acc);
            }
            u32x4 w; w.x = cvtpk(o[0], o[1]); w.y = cvtpk(o[2], o[3]); w.z = cvtpk(o[4], o[5]); w.w = cvtpk(o[6], o[7]);
            *(GLAS u32x4*)(img + swz(r0 + ro, c16)) = w;
        }
    } else {
        const float gb = A.small[(m0 + lane) * 16 + 8 + h], ga = A.small[(m0 + lane) * 16 + 12 + h] + A.dt_bias[h];
        const float sp = fmaxf(ga, 0.f) + log1pf(__expf(-fabsf(ga)));
        float g = -__expf(A.a_log[h]) * sp;
#pragma unroll
        for (int o = 1; o < 64; o <<= 1) { const float t = __shfl_up(g, o); if (lane >= o) g += t; }
        const float glast = __shfl(g, 63);
        SC[128 + lane] = 1.f / (1.f + __expf(-gb));
        SC[192 + lane] = g;
        SC[256 + lane] = __builtin_amdgcn_exp2f(g * L2E);
        SC[320 + lane] = __builtin_amdgcn_exp2f((glast - g) * L2E);
        if (lane == 63) A.GL[item] = __builtin_amdgcn_exp2f(g * L2E);
    }
    __syncthreads();
    {
        const int r = lt >> 2, qd = lt & 3; float sq = 0.f, sk = 0.f;
#pragma unroll
        for (int jj = 0; jj < 4; ++jj) {
            const u32x4 vq = *(const GLAS u32x4*)(lds + L_QS + swz(r, qd * 4 + jj)), vk = *(const GLAS u32x4*)(lds + L_KS + swz(r, qd * 4 + jj));
#pragma unroll
            for (int e = 0; e < 4; ++e) { const float a0 = __uint_as_float(vq[e] << 16), a1 = __uint_as_float(vq[e] & 0xffff0000u), b0 = __uint_as_float(vk[e] << 16), b1 = __uint_as_float(vk[e] & 0xffff0000u);
                sq += a0 * a0 + a1 * a1; sk += b0 * b0 + b1 * b1; }
        }
        sq += __shfl_xor(sq, 1); sq += __shfl_xor(sq, 2); sk += __shfl_xor(sk, 1); sk += __shfl_xor(sk, 2);
        if (qd == 0) { SC[r] = rsqrtf(sq + 1e-6f) * 0.08838834764831845f; SC[64 + r] = rsqrtf(sk + 1e-6f); }
    }
    __syncthreads();
    {
        const int ti = lw >> 1, tj = lw & 1, r32 = lane & 31, hi = lane >> 5;
        f32x16 kk = {}, qk = {};
#pragma unroll
        for (int s = 0; s < 8; ++s) {
            const bf16x8 aK = *(const GLAS bf16x8*)(lds + L_KS + swz(32 * ti + r32, 2 * s + hi)), aQ = *(const GLAS bf16x8*)(lds + L_QS + swz(32 * ti + r32, 2 * s + hi));
            const bf16x8 bK = *(const GLAS bf16x8*)(lds + L_KS + swz(32 * tj + r32, 2 * s + hi));
            kk = __builtin_amdgcn_mfma_f32_32x32x16_bf16(aK, bK, kk, 0, 0, 0); qk = __builtin_amdgcn_mfma_f32_32x32x16_bf16(aQ, bK, qk, 0, 0, 0);
        }
        const int C = 32 * tj + r32; const float rkC = SC[64 + C], gcC = SC[192 + C], bC = SC[128 + C];
        bf16_t* af = fr + (32 + ti * 4 + (C >> 4)) * 512;
#pragma unroll
        for (int r = 0; r < 16; ++r) {
            const int il = crow(r, hi), R = 32 * ti + il;
            const float d = SC[192 + R] - gcC;
            const float mv = (C > R) ? bC * rkC * SC[64 + R] * kk[r] * __builtin_amdgcn_exp2f(fminf(-d, 0.f) * L2E) : 0.f;
            const float av = (R >= C) ? SC[R] * rkC * qk[r] * __builtin_amdgcn_exp2f(fminf(d, 0.f) * L2E) : 0.f;
            MT[R * MT_LD + C] = mv;
            af[frag_off(il, C & 15)] = f2bf1(av);
        }
    }
    __syncthreads();
    {
        const int c = (lw & 1) * 64 + lane;
        float y[64];
        {
            const GLAS unsigned char* img = lds + (lw < 2 ? L_VS : L_KS) + (c & 7) * 2;
#pragma unroll
            for (int i = 0; i < 64; ++i) y[i] = bf2f(*(const GLAS bf16_t*)(img + swz(i, c >> 3)));
        }
        if (lw >= 2) {
            const int T = c >> 5, r = c & 31;
#pragma unroll
            for (int ks = 0; ks < 4; ++ks)
#pragma unroll
                for (int hh = 0; hh < 2; ++hh) {
                    float kd[8];
#pragma unroll
                    for (int a = 0; a < 2; ++a)
#pragma unroll
                        for (int bq = 0; bq < 4; ++bq) { const int i = 16 * ks + 8 * a + 4 * hh + bq; kd[4 * a + bq] = y[i] * SC[64 + i] * SC[320 + i]; }
                    u32x4 w; w.x = cvtpk(kd[0], kd[1]); w.y = cvtpk(kd[2], kd[3]); w.z = cvtpk(kd[4], kd[5]); w.w = cvtpk(kd[6], kd[7]);
                    *(u32x4*)(fr + (40 + T * 4 + ks) * 512 + ((hh * 32 + r) << 3)) = w;
                }
#pragma unroll
            for (int i = 0; i < 64; ++i) y[i] = y[i] * SC[64 + i] * SC[128 + i] * SC[256 + i];
        } else {
#pragma unroll
            for (int i = 0; i < 64; ++i) y[i] *= SC[128 + i];
        }
        f32x4 cur[16];
#pragma unroll
        for (int q = 0; q < 16; ++q) cur[q] = *(const GLAS f32x4*)(MT + 4 * q);
#pragma unroll
        for (int j = 0; j < 63; ++j) {
            f32x4 nxt[16];
#pragma unroll
            for (int q = 0; q < 16; ++q) { nxt[q] = (f32x4){0.f, 0.f, 0.f, 0.f}; if (j + 1 < 63 && 4 * q + 3 > j + 1) nxt[q] = *(const GLAS f32x4*)(MT + (j + 1) * MT_LD + 4 * q); }
            __builtin_amdgcn_sched_barrier(0);
            const float yj = y[j];
#pragma unroll
            for (int i = j + 1; i < 64; ++i) y[i] -= cur[i >> 2][i & 3] * yj;
            __builtin_amdgcn_sched_barrier(0);
#pragma unroll
            for (int q = 0; q < 16; ++q) cur[q] = nxt[q];
        }
        if (lw >= 2) {
            GLAS unsigned char* img = lds + L_KS + (c & 7) * 2;
#pragma unroll
            for (int i = 0; i < 64; ++i) *(GLAS bf16_t*)(img + swz(i, c >> 3)) = f2bf1(-y[i]);
        } else {
            float* up = A.U + (size_t)item * 8192 + (size_t)(c >> 5) * 2048 + (c & 31) * 4;
#pragma unroll
            for (int I = 0; I < 2; ++I)
#pragma unroll
                for (int g = 0; g < 4; ++g)
#pragma unroll
                    for (int hh = 0; hh < 2; ++hh) { const int i0 = 32 * I + 8 * g + 4 * hh; *(f32x4*)(up + ((I * 4 + g) * 64 + hh * 32) * 4) = (f32x4){y[i0], y[i0 + 1], y[i0 + 2], y[i0 + 3]}; }
        }
    }
    __syncthreads();
    {
        const int L = lt & 63, r = L & 31, hh = L >> 5;
#pragma unroll
        for (int q = 0; q < 4; ++q) {
            const int f = (lt >> 6) + 4 * q, I = f >> 3, ks = f & 7, i = 32 * I + r;
            const u32x2 w0 = *(const GLAS u32x2*)(lds + L_KS + swz(i, 2 * ks) + 8 * hh), w1 = *(const GLAS u32x2*)(lds + L_KS + swz(i, 2 * ks + 1) + 8 * hh);
            *(u32x4*)(fr + f * 512 + L * 8) = (u32x4){w0.x, w0.y, w1.x, w1.y};
            const u32x2 q0 = *(const GLAS u32x2*)(lds + L_QS + swz(i, 2 * ks) + 8 * hh), q1 = *(const GLAS u32x2*)(lds + L_QS + swz(i, 2 * ks + 1) + 8 * hh);
            const float sc = SC[i] * SC[256 + i];
            u32x4 o;
            o.x = cvtpk(__uint_as_float(q0.x << 16) * sc, __uint_as_float(q0.x & 0xffff0000u) * sc); o.y = cvtpk(__uint_as_float(q0.y << 16) * sc, __uint_as_float(q0.y & 0xffff0000u) * sc);
            o.z = cvtpk(__uint_as_float(q1.x << 16) * sc, __uint_as_float(q1.x & 0xffff0000u) * sc); o.w = cvtpk(__uint_as_float(q1.y << 16) * sc, __uint_as_float(q1.y & 0xffff0000u) * sc);
            *(u32x4*)(fr + (16 + f) * 512 + L * 8) = o;
        }
    }
    __syncthreads();
}

__device__ __forceinline__ void glds16(const void* gsrc, unsigned lds_dst) { unsigned keep;
    asm volatile("s_mov_b32 %0, m0\n\ts_mov_b32 m0, %2\n\ts_nop 0\n\tglobal_load_lds_dwordx4 %1, off\n\ts_mov_b32 m0, %0" : "=&s"(keep) : "v"(gsrc), "s"(lds_dst) : "memory"); }
__device__ __forceinline__ void scan_block(int bh, float* U, const bf16_t* FR, const float* GL, GLAS unsigned char* lds, const int wave) {
    const int lane = lane_id(), lw = wave & 3, r32 = lane & 31, hi = lane >> 5;
    const bool loader = wave >= 4;
    const int b = bh >> 2, h = bh & 3;
    const unsigned lds0 = (unsigned)(uintptr_t)lds;
    const bf16_t* frl = FR + (size_t)bh * NCH * ITEM_ELEMS + lane * 8;
#define SCAN_BAR() asm volatile("s_waitcnt vmcnt(0) lgkmcnt(0)\n\ts_barrier" ::: "memory")
    { const bf16_t* src = frl + wave * 7 * 512; unsigned dst = (unsigned)__builtin_amdgcn_readfirstlane(lds0 + wave * 7 * 1024);
#pragma unroll 1
      for (int p = 0; p < 7; ++p) { glds16(src, dst); src += 512; dst += 1024; } }
    f32x16 S[4], UN[2];
    float* ub = U + (size_t)bh * NCH * 8192 + (size_t)lw * 2048 + lane * 4;
    if (!loader) {
#pragma unroll
        for (int T = 0; T < 4; ++T) S[T] = f32x16{};
#pragma unroll
        for (int I = 0; I < 2; ++I)
#pragma unroll
            for (int g = 0; g < 4; ++g) { const f32x4 t = *(const f32x4*)(ub + (I * 4 + g) * 256); UN[I][4 * g] = t[0]; UN[I][4 * g + 1] = t[1]; UN[I][4 * g + 2] = t[2]; UN[I][4 * g + 3] = t[3]; }
    }
    SCAN_BAR();
    for (int n = 0; n < NCH; ++n) {
        if (loader) {
            if (n + 1 < NCH) {
                const bf16_t* src = frl + (size_t)(n + 1) * ITEM_ELEMS + lw * 14 * 512; unsigned dst = (unsigned)__builtin_amdgcn_readfirstlane(lds0 + ((n + 1) & 1) * (FRAGS * 1024) + lw * 14 * 1024);
#pragma unroll 1
                for (int p = 0; p < 14; ++p) { glds16(src, dst); src += 512; dst += 1024; }
            }
        } else {
            const GLAS bf16x8* fb = (const GLAS bf16x8*)(lds + (n & 1) * (FRAGS * 1024)) + lane;
            float* ut = ub + (size_t)n * 8192;
            const float gl = GL[bh * NCH + n];
            bf16x8 sf[4][2];
#pragma unroll
            for (int T = 0; T < 4; ++T)
#pragma unroll
                for (int s = 0; s < 2; ++s) { u32x4 p;
#pragma unroll
                    for (int e = 0; e < 4; ++e) p[e] = cvtpk(S[T][8 * s + 2 * e], S[T][8 * s + 2 * e + 1]);
                    sf[T][s] = __builtin_bit_cast(bf16x8, p); }
            f32x16 VN[2];
#pragma unroll
            for (int I = 0; I < 2; ++I) {
                VN[I] = UN[I];
#pragma unroll
                for (int ks = 0; ks < 8; ++ks) VN[I] = __builtin_amdgcn_mfma_f32_32x32x16_bf16(fb[(I * 8 + ks) * 64], sf[ks >> 1][ks & 1], VN[I], 0, 0, 0);
            }
            if (n + 1 < NCH) {
#pragma unroll
                for (int I = 0; I < 2; ++I)
#pragma unroll
                    for (int g = 0; g < 4; ++g) { const f32x4 t = *(const f32x4*)(ut + 8192 + (I * 4 + g) * 256); UN[I][4 * g] = t[0]; UN[I][4 * g + 1] = t[1]; UN[I][4 * g + 2] = t[2]; UN[I][4 * g + 3] = t[3]; }
            }
            bf16x8 vf[2][2];
#pragma unroll
            for (int J = 0; J < 2; ++J)
#pragma unroll
                for (int s = 0; s < 2; ++s) { u32x4 p;
#pragma unroll
                    for (int e = 0; e < 4; ++e) p[e] = cvtpk(VN[J][8 * s + 2 * e], VN[J][8 * s + 2 * e + 1]);
                    vf[J][s] = __builtin_bit_cast(bf16x8, p); }
#pragma unroll
            for (int I = 0; I < 2; ++I) {
                f32x16 O = {};
#pragma unroll
                for (int ks = 0; ks < 8; ++ks) O = __builtin_amdgcn_mfma_f32_32x32x16_bf16(fb[(16 + I * 8 + ks) * 64], sf[ks >> 1][ks & 1], O, 0, 0, 0);
#pragma unroll
                for (int ks = 0; ks < 2 * (I + 1); ++ks) O = __builtin_amdgcn_mfma_f32_32x32x16_bf16(fb[(32 + I * 4 + ks) * 64], vf[ks >> 1][ks & 1], O, 0, 0, 0);
#pragma unroll
                for (int g = 0; g < 4; ++g) *(f32x4*)(ut + (I * 4 + g) * 256) = (f32x4){O[4 * g], O[4 * g + 1], O[4 * g + 2], O[4 * g + 3]};
            }
#pragma unroll
            for (int T = 0; T < 4; ++T) {
                S[T] = S[T] * gl;
#pragma unroll
                for (int ks = 0; ks < 4; ++ks) S[T] = __builtin_amdgcn_mfma_f32_32x32x16_bf16(fb[(40 + T * 4 + ks) * 64], vf[ks >> 1][ks & 1], S[T], 0, 0, 0);
            }
        }
        SCAN_BAR();
    }
#undef SCAN_BAR
}
#undef GLAS
}
#ifndef PG8_SP2
#define PG8_SP2 true
#endif
#ifndef PG8_ALIGN
#define PG8_ALIGN true
#endif
constexpr int NWAVES = 8;
constexpr int NB = 8, SEQ = 2048, D = 1024, M = NB * SEQ, FF = 4096;
constexpr int HF = 8, HG = 4;
constexpr int DPROJ = 3600, NPROJ = 3840;
constexpr float EPS = 1e-6f;
constexpr float LOG2E = 1.4426950408889634f;
constexpr float QSCALE = 0.125f * LOG2E;
constexpr int C_FF = 1536, C_GQ = 1544, C_GB = 3080, C_GA = 3084, C_GZ = 3088;
constexpr size_t MiB = 1u << 20;
constexpr size_t WS_CTL = 0, CTL_ZERO_BYTES = 1 * MiB;
constexpr size_t WS_WIN = 2 * MiB, WS_WOUT = 10 * MiB, WS_WUP = 12 * MiB, WS_WDN = 20 * MiB;
constexpr size_t WS_X = 28 * MiB;
constexpr size_t WS_XN = 32 * MiB;
constexpr size_t WS_FQ = 64 * MiB, WS_G512 = 16 * MiB;
constexpr size_t WS_SMALL = 176 * MiB;
constexpr size_t WS_CUM = 177 * MiB;
constexpr size_t WS_GU = 32 * MiB;
constexpr size_t WS_GL = 179 * MiB;
constexpr size_t WS_BETA = 178 * MiB, WS_GDEC = 178 * MiB + 512 * 1024;
constexpr size_t WS_MIXED = 192 * MiB;
constexpr size_t WS_H = 64 * MiB;
constexpr size_t WS_MIXOUT = 64 * MiB;
constexpr size_t WS_Y = 192 * MiB;
constexpr size_t WS_END = 256 * MiB;
constexpr int CW_TMO = 0, CW_CODE = 1;
constexpr int CW_BAR = 4096;
constexpr int CW_QUEUE = 12288;
constexpr int CW_SEAM = 16384, SEAM_BANK = 128 * 64;
constexpr int RING_OFF = 0, RING_BYTES = 147456;
constexpr int LDSCTL_OFF = RING_BYTES, MISC_OFF = LDSCTL_OFF + 320;
constexpr int LDS_BYTES = 149504;
#define GAS __attribute__((address_space(1)))
#define LAS __attribute__((address_space(3)))
typedef unsigned short bf16;
typedef unsigned v4u __attribute__((ext_vector_type(4)));
typedef float f32x4 __attribute__((ext_vector_type(4)));
typedef short bf16x8 __attribute__((ext_vector_type(8)));
typedef GAS unsigned gu32;
typedef GAS unsigned long long gu64;
#define RLX_AGENT __ATOMIC_RELAXED, __HIP_MEMORY_SCOPE_AGENT
#define LDS_WAIT() asm volatile("s_waitcnt lgkmcnt(0)" ::: "memory")
#define VM_WAIT() asm volatile("s_waitcnt vmcnt(0)" ::: "memory")
__device__ __forceinline__ unsigned long long rt() { return __builtin_amdgcn_s_memrealtime(); }
__device__ __forceinline__ unsigned f2bf(float f) { unsigned u = __builtin_bit_cast(unsigned, f); return (u + 0x7fffu + ((u >> 16) & 1u)) >> 16; }
__device__ __forceinline__ unsigned pk2(float lo, float hi) { return f2bf(lo) | (f2bf(hi) << 16); }

#define XB_TMO      128
#define XB_XCNT(j)  (256  + 64 * (j))
#define XB_XSUB(j)  (1280 + 64 * (j))
#define XB_XGEN(j)  (2304 + 64 * (j))
#define XB_TOP      3328
#define XB_TOPGEN   3392
#define XCD_BAR_WORDS 3456
#define XB_SPIN_CAP (1u << 18)

__device__ __forceinline__ unsigned xb_ld(unsigned* p)              { return __hip_atomic_load(p, __ATOMIC_RELAXED, __HIP_MEMORY_SCOPE_AGENT); }
__device__ __forceinline__ unsigned xb_add(unsigned* p, unsigned v) { return __hip_atomic_fetch_add(p, v, __ATOMIC_RELAXED, __HIP_MEMORY_SCOPE_AGENT); }
__device__ __forceinline__ unsigned xb_xcc_id() { return (unsigned)__builtin_amdgcn_s_getreg((3 << 11) | 20) & 0xFu; }
#define XB_SPIN(cond, bar) do { unsigned _sp = 0; while (cond) { __builtin_amdgcn_s_sleep(1); \
    if ((++_sp & 255u) == 0u) { if (xb_ld(&(bar)[XB_TMO])) break; if (_sp > XB_SPIN_CAP) { atomicAdd(&(bar)[XB_TMO], 1u); break; } } } } while (0)

struct XcdBarrier {
    unsigned* bar; unsigned x;
    volatile LAS unsigned* st;
};

__device__ __forceinline__ XcdBarrier xcd_barrier_post(unsigned* bar, volatile LAS unsigned* st, const bool t0) {
    XcdBarrier b; b.bar = bar; b.x = xb_xcc_id(); b.st = st;
    if (t0) (void)xb_add(&bar[XB_XCNT(b.x)], 1u);
    return b;
}
__device__ __forceinline__ void xcd_barrier_complete(unsigned* bar, unsigned x, unsigned& nloc, unsigned& nx) {
    const unsigned G = gridDim.x * gridDim.y * gridDim.z;
    unsigned sum, cnt, mine, sp = 0u;
    for (;;) {
        sum = 0u; cnt = 0u; mine = 0u;
#pragma unroll
        for (unsigned j = 0; j < 16; ++j) { const unsigned c = xb_ld(&bar[XB_XCNT(j)]); sum += c; cnt += (c > 0u) ? 1u : 0u; mine = (j == x) ? c : mine; }
        if (sum == G) break;
        __builtin_amdgcn_s_sleep(1);
        if ((++sp & 255u) == 0u) { if (xb_ld(&bar[XB_TMO])) break; if (sp > XB_SPIN_CAP) { atomicAdd(&bar[XB_TMO], 1u); break; } }
    }
    nloc = mine > 0u ? mine : 1u; nx = cnt > 0u ? cnt : 1u;
}

__device__ __forceinline__ void xcd_barrier(const XcdBarrier& b, const bool t0) {
    asm volatile("s_waitcnt vmcnt(0)" ::: "memory");
    __syncthreads();
    if (t0) {
        unsigned* bar = b.bar;
        __builtin_amdgcn_s_waitcnt(0);
        unsigned nloc = b.st[0], nx = b.st[1];
        if (nloc == 0u) { xcd_barrier_complete(bar, b.x, nloc, nx); b.st[0] = nloc; b.st[1] = nx; }
        const unsigned old = xb_add(&bar[XB_XSUB(b.x)], 1u);
        const unsigned gen = old / nloc;
        if (old + 1u == (gen + 1u) * nloc) {
            __builtin_amdgcn_fence(__ATOMIC_RELEASE, "agent");
            asm volatile("s_waitcnt vmcnt(0)" ::: "memory");
            const unsigned og = xb_add(&bar[XB_TOP], 1u);
            const unsigned tg = og / nx;
            if (og + 1u == (tg + 1u) * nx) xb_add(&bar[XB_TOPGEN], 1u);
            else XB_SPIN(xb_ld(&bar[XB_TOPGEN]) == tg, bar);
            __builtin_amdgcn_fence(__ATOMIC_ACQUIRE, "agent");
            xb_add(&bar[XB_XGEN(b.x)], 1u);
            asm volatile("s_waitcnt vmcnt(0)" ::: "memory");
        } else {
            XB_SPIN(xb_ld(&bar[XB_XGEN(b.x)]) == gen, bar);
            __builtin_amdgcn_fence(__ATOMIC_ACQUIRE, "agent");
            asm volatile("s_waitcnt vmcnt(0)" ::: "memory");
        }
    }
    __syncthreads();
}
struct Frame {
    LAS unsigned char* lds;
    volatile LAS unsigned* MISC;
    gu32* ctl;
    int wave;
    int vcu, G;
};
__device__ __forceinline__ float wave_sum(float v) {
#pragma unroll
    for (int o = 1; o < 64; o <<= 1) v += __shfl_xor(v, o);
    return v;
}
__device__ __forceinline__ float bf2f(unsigned short u) { return __uint_as_float((unsigned)u << 16); }
__device__ __forceinline__ int proj_src_col(int n) {
    if (n < 1536) return n;
    if (n < 3072) return n + 8;
    if (n < 3584) return n + 16;
    if (n < 3592) return C_FF + (n - 3584);
    if (n < 3596) return C_GB + (n - 3592);
    if (n < 3600) return C_GA + (n - 3596);
    return -1;
}
template <bool REMAP>
__device__ __forceinline__ void p0_transpose_item(const float* W, int K, int N, int Ndst, bf16* WT, LAS float* scr, int item, int lane) {
    const int nblk = Ndst / 32, kb = item / nblk, nb = item % nblk, k0 = 64 * kb, n0 = 32 * nb;
    const int sc = REMAP ? proj_src_col(n0 + (lane & 31)) : n0 + (lane & 31);
#pragma unroll 8
    for (int i = 0; i < 32; ++i) { const int kk = 2 * i + (lane >> 5); scr[kk * 33 + (lane & 31)] = (sc >= 0) ? W[(size_t)(k0 + kk) * N + sc] : 0.f; }
    LDS_WAIT(); asm volatile("" ::: "memory");
    const int c = lane & 7;
#pragma unroll
    for (int j = 0; j < 4; ++j) { const int n = (lane >> 3) + 8 * j; const LAS float* s = scr + (8 * c) * 33 + n;
        v4u o; o.x = pk2(s[0 * 33], s[1 * 33]); o.y = pk2(s[2 * 33], s[3 * 33]); o.z = pk2(s[4 * 33], s[5 * 33]); o.w = pk2(s[6 * 33], s[7 * 33]);
        *(GAS v4u*)(WT + (size_t)(n0 + n) * K + k0 + 8 * c) = o; }
    LDS_WAIT(); asm volatile("" ::: "memory");
}
__device__ __forceinline__ void rms_row_to_bf16(int lane, const float* xrow, const float* g, bf16* orow) {
    const GAS f32x4* xr = (const GAS f32x4*)xrow + lane; const GAS f32x4* gr = (const GAS f32x4*)g + lane;
    f32x4 v[4]; float s = 0.f;
#pragma unroll
    for (int j = 0; j < 4; ++j) { v[j] = xr[64 * j]; s += (v[j].x * v[j].x + v[j].y * v[j].y) + (v[j].z * v[j].z + v[j].w * v[j].w); }
    const float r = rsqrtf(wave_sum(s) * (1.f / D) + EPS);
    GAS unsigned long long* o8 = (GAS unsigned long long*)orow + lane;
#pragma unroll
    for (int j = 0; j < 4; ++j) { const f32x4 gg = gr[64 * j];
        o8[64 * j] = (unsigned long long)pk2(v[j].x * r * gg.x, v[j].y * r * gg.y) | ((unsigned long long)pk2(v[j].z * r * gg.z, v[j].w * r * gg.w) << 32); }
}
__device__ __forceinline__ void resnorm_row(int lane, const float* yrow, const float* g1, const float* baserow, float* outrow, const float* g2, bf16* xnrow) {
    const GAS f32x4* yr = (const GAS f32x4*)yrow + lane; const GAS f32x4* gr = (const GAS f32x4*)g1 + lane; const GAS f32x4* br = (const GAS f32x4*)baserow + lane;
    f32x4 v[4]; float s = 0.f;
#pragma unroll
    for (int j = 0; j < 4; ++j) { v[j] = yr[64 * j]; s += (v[j].x * v[j].x + v[j].y * v[j].y) + (v[j].z * v[j].z + v[j].w * v[j].w); }
    const float r = rsqrtf(wave_sum(s) * (1.f / D) + EPS);
    float s2 = 0.f;
#pragma unroll
    for (int j = 0; j < 4; ++j) { const f32x4 gg = gr[64 * j], bb = br[64 * j]; v[j] = bb + v[j] * r * gg; s2 += (v[j].x * v[j].x + v[j].y * v[j].y) + (v[j].z * v[j].z + v[j].w * v[j].w);
        ((GAS f32x4*)outrow + lane)[64 * j] = v[j]; }
    if (xnrow) {
        const float r2 = rsqrtf(wave_sum(s2) * (1.f / D) + EPS); const GAS f32x4* g2r = (const GAS f32x4*)g2 + lane;
        GAS unsigned long long* o8 = (GAS unsigned long long*)xnrow + lane;
#pragma unroll
        for (int j = 0; j < 4; ++j) { const f32x4 gg = g2r[64 * j];
            o8[64 * j] = (unsigned long long)pk2(v[j].x * r2 * gg.x, v[j].y * r2 * gg.y) | ((unsigned long long)pk2(v[j].z * r2 * gg.z, v[j].w * r2 * gg.w) << 32); }
    }
}

typedef float f32x2v __attribute__((ext_vector_type(2)));
__device__ __forceinline__ void cum_item(int bh, const float* small, const float* fbias, float* cum, LAS float* part, int tid, int lane, int wave) {
    const int b = bh >> 3, h = bh & 7; const float bz = fbias[h];
    float loc[4]; float s = 0.f;
#pragma unroll
    for (int e = 0; e < 4; ++e) { const float z = small[((size_t)b * SEQ + tid * 4 + e) * 16 + h] + bz; s += fminf(z, 0.f) - log1pf(__expf(-fabsf(z))); loc[e] = s; }
    float inc = s;
#pragma unroll
    for (int o = 1; o < 64; o <<= 1) { const float t = __shfl_up(inc, o); if (lane >= o) inc += t; }
    if (lane == 63) part[wave] = inc;
    __syncthreads();
    float base = inc - s;
    for (int w = 0; w < wave; ++w) base += part[w];
#pragma unroll
    for (int e = 0; e < 4; ++e) cum[(size_t)bh * SEQ + tid * 4 + e] = loc[e] + base;
    __syncthreads();
}

__device__ __forceinline__ int opaque_lane() { return lane_id(); }
struct Args { const float* in[15]; float* out; unsigned char* ws; int ph_lo, ph_hi, li, pad; };
enum { PH_PRO = 0, PH_PROJ = 1, PH_MIX = 2, PH_WO = 3, PH_N1 = 4, PH_UP = 5, PH_DOWN = 6, PH_N2 = 7, PH_END = 8 };

__global__ void __launch_bounds__(NWAVES * 64, 2) skel_fwd(Args args) {
    extern __shared__ __attribute__((aligned(16))) unsigned char lds[];
    Frame F;
    F.lds = (LAS unsigned char*)lds;
    F.MISC = (volatile LAS unsigned*)(F.lds + MISC_OFF);
    F.wave = __builtin_amdgcn_readfirstlane((int)threadIdx.x >> 6);
    F.G = gridDim.x; { const int bx = blockIdx.x; F.vcu = (F.G % 8 == 0) ? (bx % 8) * (F.G / 8) + bx / 8 : bx; }
    unsigned char* ws = args.ws;
    F.ctl = (gu32*)(ws + WS_CTL);
    const float* x = args.in[0]; const float* g_premix = args.in[1]; const float* w_in = args.in[2];
    const float* w_out = args.in[9]; const float* g_postmix = args.in[10]; const float* g_premlp = args.in[11];
    const float* w_up = args.in[12]; const float* w_down = args.in[13]; const float* g_postmlp = args.in[14];
    bf16* Win_t = (bf16*)(ws + WS_WIN); bf16* Wout_t = (bf16*)(ws + WS_WOUT); bf16* Wup_t = (bf16*)(ws + WS_WUP); bf16* Wdn_t = (bf16*)(ws + WS_WDN);
    bf16* XN = (bf16*)(ws + WS_XN); bf16* FQ = (bf16*)(ws + WS_FQ); bf16* MIXED = (bf16*)(ws + WS_MIXED); bf16* HB = (bf16*)(ws + WS_H);
    float* SMALL = (float*)(ws + WS_SMALL); float* MIXOUT = (float*)(ws + WS_MIXOUT); float* Y = (float*)(ws + WS_Y);
    for (int u = F.wave * 64 + lane_id(); u < (LDS_BYTES - LDSCTL_OFF) / 4; u += NWAVES * 64) ((LAS unsigned*)(F.lds + LDSCTL_OFF))[u] = 0u;
    __syncthreads();
#define T0 (F.wave == 0 && lane_id() == 0)
    XcdBarrier bar = xcd_barrier_post((unsigned*)(F.ctl + CW_BAR) + args.li * XCD_BAR_WORDS, F.MISC + 8, T0);
    const int lo = args.ph_lo, hi = args.ph_hi;
#define IN(k) (lo <= (k) && (k) < hi)
#define BOTH(k) (IN(k) && IN((k) + 1))
#define GRID_BAR() xcd_barrier(bar, T0)
    const int gw = F.vcu * NWAVES + F.wave, NGW = F.G * NWAVES;

    if (IN(PH_PRO)) {
        LAS float* scr = (LAS float*)(F.lds + RING_OFF + F.wave * 16384);
        constexpr int I_IN = (D / 64) * (NPROJ / 32), I_O = (D / 64) * (D / 32), I_1 = (D / 64) * (FF / 32), I_2 = (FF / 64) * (D / 32);
        constexpr int NITEMS = I_IN + I_O + I_1 + I_2;
        for (int it = gw; it < NITEMS; it += NGW) {
            int r = it;
            if (r < I_IN) { p0_transpose_item<true>(w_in, D, DPROJ, NPROJ, Win_t, scr, r, lane_id()); continue; } r -= I_IN;
            if (r < I_O) { p0_transpose_item<false>(w_out, D, D, D, Wout_t, scr, r, lane_id()); continue; } r -= I_O;
            if (r < I_1) { p0_transpose_item<false>(w_up, D, FF, FF, Wup_t, scr, r, lane_id()); continue; } r -= I_1;
            p0_transpose_item<false>(w_down, FF, D, D, Wdn_t, scr, r, lane_id());
        }
        { const int ln = opaque_lane(); for (int m = gw; m < M; m += NGW) rms_row_to_bf16(ln, x + (size_t)m * D, g_premix, XN + (size_t)m * D); }
        if (BOTH(PH_PRO)) GRID_BAR();
    }
    if (IN(PH_PROJ)) {
        pg8::Gemm g{XN, Win_t, M, NPROJ, D}; pg8::StaticOrder S; S.init(M, NPROJ, F.G, (int)blockIdx.x);
        pg8::EpiProj E{FQ, (size_t)(WS_G512 / 2), SMALL, QSCALE};
        pg8::gemm_phase<pg8::EpiProj, pg8::StaticOrder, PG8_ALIGN, PG8_SP2>(F.lds + RING_OFF, g, S, E, F.wave);
        if (BOTH(PH_PROJ)) GRID_BAR();
    }
    if (IN(PH_MIX)) {
        float* CUM = (float*)(ws + WS_CUM); float* GU = (float*)(ws + WS_GU); float* GLp = (float*)(ws + WS_GL); bf16* FR = (bf16*)args.out;
        if (F.vcu < NB * HF) cum_item(F.vcu, SMALL, args.in[3], CUM, (LAS float*)(F.lds + RING_OFF), F.wave * 64 + lane_id(), lane_id(), F.wave);
        {
            const gdn::G1Args GA{FQ + 3 * (WS_G512 / 2), FQ + 4 * (WS_G512 / 2), FQ + 5 * (WS_G512 / 2), SMALL, args.in[5], args.in[6], args.in[7], GU, FR, GLp};
_Pragma("nounroll")
            for (int k = 0; k < 2 * ((gdn::NITEM / 2 + 2 * F.G - 1) / (2 * F.G)); ++k) { const int pr = (k >> 1) * 2 * F.G + F.vcu * 2 + (k & 1); if (pr < gdn::NITEM / 2) gdn::g1_pair(GA, pr, F.lds + RING_OFF, F.wave); }
        }
        GRID_BAR();
        if ((int)blockIdx.x < NB * HG) gdn::scan_block((int)blockIdx.x, GU, FR, GLp, F.lds + RING_OFF, F.wave);
        {
            static_assert(attn_body::ATTN_LDS_BYTES <= RING_BYTES, "attention LDS");
            const attn_body::AttnTensors AT{(const attn_body::bf16*)FQ, (const attn_body::bf16*)(FQ + WS_G512 / 2), (const attn_body::bf16*)(FQ + 2 * (WS_G512 / 2)), (attn_body::bf16*)MIXED, CUM, args.in[4]};
            const attn_body::QueueOrder S{(unsigned*)(F.ctl + CW_QUEUE), F.MISC + 12, (int)(blockIdx.x & 7), F.wave};
            attn_body::attn_phase<attn_body::QueueOrder>((char*)lds + RING_OFF, AT, S, F.wave);
        }
        GRID_BAR();
        {
            const bf16* GZ = FQ + 6 * (WS_G512 / 2); const float* gno = args.in[8]; const int ln = opaque_lane(), lc = ln & 31, hh = ln >> 5;
            for (int it = gw; it < gdn::NITEM * 8; it += NGW) {
                const int item = it >> 3, I = (it >> 2) & 1, g = it & 3, bh = item >> 5, n = item & 31, b = bh >> 2, h = bh & 3;
                const float* src = GU + (size_t)item * 8192 + ((I * 4 + g) * 64 + ln) * 4;
                f32x4 v[4]; float ss[4] = {0.f, 0.f, 0.f, 0.f};
#pragma unroll
                for (int w = 0; w < 4; ++w) { v[w] = *(const GAS f32x4*)(src + w * 2048);
#pragma unroll
                    for (int e = 0; e < 4; ++e) ss[e] += v[w][e] * v[w][e]; }
#pragma unroll
                for (int e = 0; e < 4; ++e) {
#pragma unroll
                    for (int o = 1; o < 32; o <<= 1) ss[e] += __shfl_xor(ss[e], o);
                    ss[e] = rsqrtf(ss[e] * (1.f / 128.f) + EPS); }
                const size_t m0 = (size_t)b * SEQ + n * 64 + 32 * I + 8 * g + 4 * hh;
#pragma unroll
                for (int w = 0; w < 4; ++w) { const int col = h * 128 + 32 * w + lc; const float gg = gno[32 * w + lc];
#pragma unroll
                    for (int e = 0; e < 4; ++e) { const float z = bf2f(GZ[(m0 + e) * 512 + col]);
                        MIXED[(m0 + e) * D + 512 + col] = (bf16)f2bf(v[w][e] * ss[e] * gg * z / (1.f + __expf(-z))); } }
            }
        }
        if (BOTH(PH_MIX)) GRID_BAR();
    }
    if (IN(PH_WO)) {
        pg8::Gemm g{MIXED, Wout_t, M, D, D}; pg8::StaticOrder S; S.init(M, D, F.G, (int)blockIdx.x);
        pg8::EpiF32 E{MIXOUT, D};
        pg8::gemm_phase<pg8::EpiF32, pg8::StaticOrder, false, PG8_SP2>(F.lds + RING_OFF, g, S, E, F.wave);
        if (BOTH(PH_WO)) GRID_BAR();
    }
    if (IN(PH_N1)) {
        { const int ln = opaque_lane(); for (int m = gw; m < M; m += NGW) resnorm_row(ln, MIXOUT + (size_t)m * D, g_postmix, x + (size_t)m * D, args.out + (size_t)m * D, g_premlp, XN + (size_t)m * D); }
        if (BOTH(PH_N1)) GRID_BAR();
    }
    if (IN(PH_UP)) {
        pg8::Gemm g{XN, Wup_t, M, FF, D}; pg8::StaticOrder S; S.init(M, FF, F.G, (int)blockIdx.x);
        pg8::EpiRelu2 E{HB, FF};
        pg8::gemm_phase<pg8::EpiRelu2, pg8::StaticOrder, PG8_ALIGN, PG8_SP2>(F.lds + RING_OFF, g, S, E, F.wave);
        if (BOTH(PH_UP)) GRID_BAR();
    }
    if (IN(PH_DOWN)) {
        pg8::Gemm g{HB, Wdn_t, M, D, FF}; pg8::StaticOrder S; S.init(M, D, F.G, (int)blockIdx.x);
        pg8::EpiF32 E{Y, D};
        pg8::gemm_phase<pg8::EpiF32, pg8::StaticOrder, false, PG8_SP2>(F.lds + RING_OFF, g, S, E, F.wave);
        if (BOTH(PH_DOWN)) GRID_BAR();
    }
    if (IN(PH_N2)) {
        { const int ln = opaque_lane(); for (int m = gw; m < M; m += NGW) resnorm_row(ln, Y + (size_t)m * D, g_postmlp, args.out + (size_t)m * D, args.out + (size_t)m * D, nullptr, nullptr); }
    }
#undef IN
#undef BOTH
#undef GRID_BAR
#undef T0
}
static void launch_skel(int grid, hipStream_t stream, Args a, int lo, int hi, int li) {
    a.ph_lo = lo; a.ph_hi = hi; a.li = li;
    hipLaunchKernelGGL(skel_fwd, dim3(grid), dim3(NWAVES * 64), LDS_BYTES, stream, a);
    const hipError_t le = hipPeekAtLastError();
    if (le != hipSuccess) fprintf(stderr, "kernel_launch: launch %d failed: %s\n", li, hipGetErrorName(le));
}
extern "C" void kernel_launch(void* const* d_in, const int* in_sizes, int n_in, void* d_out, int out_size, void* d_ws, size_t ws_size, hipStream_t stream) {
    static int grid = 0;
    if (grid == 0) {
        if (n_in != 15 || in_sizes[0] != M * D || out_size != M * D || ws_size < WS_END) { fprintf(stderr, "kernel_launch: unexpected shapes (n_in %d, in0 %d, out %d, ws %zu); nothing launched\n", n_in, n_in > 0 ? in_sizes[0] : -1, out_size, ws_size); grid = -1; return; }
        int dev = 0, cus = 0, per_cu = 0;
        if (hipGetDevice(&dev) != hipSuccess || hipDeviceGetAttribute(&cus, hipDeviceAttributeMultiprocessorCount, dev) != hipSuccess) { grid = -1; return; }
        if (hipFuncSetAttribute((const void*)skel_fwd, hipFuncAttributeMaxDynamicSharedMemorySize, LDS_BYTES) != hipSuccess) { fprintf(stderr, "kernel_launch: hipFuncSetAttribute failed\n"); grid = -1; return; }
        if (hipOccupancyMaxActiveBlocksPerMultiprocessor(&per_cu, (const void*)skel_fwd, NWAVES * 64, LDS_BYTES) != hipSuccess || per_cu < 1)
            fprintf(stderr, "kernel_launch: note: occupancy query reports %d workgroups per CU\n", per_cu);
        (void)hipGetLastError();
        grid = cus;
    }
    if (grid < 0) return;
    if (hipMemsetAsync((char*)d_ws + WS_CTL, 0, CTL_ZERO_BYTES, stream) != hipSuccess) { fprintf(stderr, "kernel_launch: hipMemsetAsync failed\n"); return; }
    Args a{};
    for (int i = 0; i < 15; ++i) a.in[i] = (const float*)d_in[i];
    a.out = (float*)d_out; a.ws = (unsigned char*)d_ws;
    HOST_LAUNCH_PROGRAM
}
```
